# Optimizing an MI355X kernel written in HIP

```python
import math
import jax
import jax.numpy as jnp
from jax import lax
import numpy as np

D_MODEL = 1024
BATCH = 8
SEQ = 2048
DEPTH = 1

GRID_W = 64
CTX_LEN = 256

RET_HEADS = 4
RET_DV = D_MODEL // (2 * RET_HEADS)
RET_DK = RET_DV // 2
HG_HEADS = 4
HG_DV = D_MODEL // (2 * HG_HEADS)
HG_DK = HG_DV
RET_QK_W = RET_HEADS * RET_DK
RET_V_W = RET_HEADS * RET_DV
HG_K_W = HG_HEADS * HG_DK
HG_V_W = HG_HEADS * HG_DV
PROJ_WIDTHS = (RET_QK_W, RET_QK_W, RET_V_W, RET_V_W, HG_K_W, HG_K_W, HG_K_W, HG_V_W, HG_V_W)
PROJ_W = sum(PROJ_WIDTHS)

CHUNK = 64
ROPE_BASE = 10000.0
EPS = 1e-6

N_EXPERTS = 32
TOP_K = 4
D_FF = D_MODEL
SWIGLU_LIMIT = 7.0
SWIGLU_ALPHA = 1.702
MOE_BLOCK = 128

kernel_name = "hybrid_retention_hgrn2_moe_dit"


def _rms(x):
    xf = x.astype(jnp.float32)
    return xf * lax.rsqrt(jnp.mean(xf * xf, axis=-1, keepdims=True) + EPS)


def rms_norm(x, w):
    return _rms(x) * w.astype(jnp.float32)


def to_heads(t, n_heads):
    b, n, _ = t.shape
    return t.reshape(b, n, n_heads, -1).transpose(0, 2, 1, 3)


def from_heads(t):
    b, h, n, d = t.shape
    return t.transpose(0, 2, 1, 3).reshape(b, n, h * d)


def axial_rope_tables(row, col):
    n_freq = RET_DK // 4
    inv = ROPE_BASE ** (-jnp.arange(n_freq, dtype=jnp.float32) / n_freq)
    ang = jnp.concatenate([row[:, None] * inv, col[:, None] * inv], axis=-1)
    return jnp.cos(ang), jnp.sin(ang)


def apply_rope(t, cos, sin):
    half = t.shape[-1] // 2
    t1, t2 = t[..., :half], t[..., half:]
    return jnp.concatenate([t1 * cos - t2 * sin, t1 * sin + t2 * cos], axis=-1)


def chunk_recurrence(q, k, v, log_a, s0):
    B, H, N, dk = q.shape
    dv = v.shape[-1]
    nc = N // CHUNK

    def to_chunks(t):
        return t.astype(jnp.float32).reshape(B, H, nc, CHUNK, t.shape[-1]).transpose(2, 0, 1, 3, 4)

    causal = jnp.tril(jnp.ones((CHUNK, CHUNK), dtype=bool))[:, :, None]

    def step(state, blk):
        qc, kc, vc, la = blk
        b = jnp.cumsum(la, axis=2)
        rel = b[:, :, :, None, :] - b[:, :, None, :, :]
        decay = jnp.exp(jnp.where(causal, rel, -jnp.inf))
        if la.shape[-1] == 1:
            scores = jnp.einsum('bhtd,bhsd->bhts', qc, kc) * decay[..., 0]
        else:
            scores = jnp.einsum('bhtsd,bhsd->bhts', qc[:, :, :, None, :] * decay, kc)
        out = (jnp.einsum('bhts,bhsv->bhtv', scores, vc)
               + jnp.einsum('bhtd,bhdv->bhtv', qc * jnp.exp(b), state))
        b_end = b[:, :, -1:, :]
        new_state = (jnp.exp(b_end[:, :, 0, :])[..., None] * state
                     + jnp.einsum('bhsd,bhsv->bhdv', kc * jnp.exp(b_end - b), vc))
        return new_state, out

    state, out = lax.scan(step, s0, (to_chunks(q), to_chunks(k), to_chunks(v), to_chunks(log_a)))
    return out.transpose(1, 2, 0, 3, 4).reshape(B, H, N, dv), state


def _flip(t):
    return jnp.flip(t, axis=2)


def bidirectional_scan(c_fwd, c_bwd, x_fwd, x_bwd):
    B, H, _, dk = c_fwd[0].shape
    dv = c_fwd[2].shape[-1]
    s0 = jnp.zeros((B, H, dk, dv), jnp.float32)
    oc_f, sc_f = chunk_recurrence(*c_fwd, s0)
    oc_b, sc_b = chunk_recurrence(*tuple(_flip(t) for t in c_bwd), s0)
    ox_f, _ = chunk_recurrence(*x_fwd, sc_f)
    ox_b, _ = chunk_recurrence(*tuple(_flip(t) for t in x_bwd), sc_b)
    return ox_f + _flip(ox_b), oc_f + _flip(oc_b)


def hybrid_mixer(u_x, u_c, w_in_l, w_out_l, lb_l, hg_norm_w_l, cos, sin, ctx_out):
    B, N, _ = u_x.shape
    C = u_c.shape[1]
    split_pts = [int(p) for p in np.cumsum(PROJ_WIDTHS)[:-1]]
    px = jnp.split(u_x @ w_in_l, split_pts, axis=-1)
    pc = jnp.split(u_c @ w_in_l, split_pts, axis=-1)

    hidx = jnp.arange(RET_HEADS, dtype=jnp.float32)
    lg_f = jnp.log1p(-(2.0 ** (-5.0 - 2.0 * hidx)))
    lg_b = jnp.log1p(-(2.0 ** (-6.0 - 2.0 * hidx)))

    def ret_qkv(p, rope):
        q = to_heads(p[0], RET_HEADS)
        k = to_heads(p[1], RET_HEADS) * (RET_DK ** -0.5)
        if rope:
            q = apply_rope(q, cos, sin)
            k = apply_rope(k, cos, sin)
        return q, k, to_heads(p[2], RET_HEADS)

    def dec(lg, n):
        return jnp.broadcast_to(lg[None, :, None, None], (B, RET_HEADS, n, 1))

    rqx, rkx, rvx = ret_qkv(px, True)
    rqc, rkc, rvc = ret_qkv(pc, False)
    ret_x, ret_c = bidirectional_scan((rqc, rkc, rvc, dec(lg_f, C)), (rqc, rkc, rvc, dec(lg_b, C)),
                                      (rqx, rkx, rvx, dec(lg_f, N)), (rqx, rkx, rvx, dec(lg_b, N)))

    def hg_dir(p, z, lb):
        q = jax.nn.silu(to_heads(p[4], HG_HEADS))
        lbh = lb.reshape(1, HG_HEADS, 1, HG_DK)
        f = lbh + (1.0 - lbh) * jax.nn.sigmoid(to_heads(z, HG_HEADS).astype(jnp.float32))
        return q, 1.0 - f, to_heads(p[7], HG_HEADS), jnp.log(f)

    hg_x, hg_c = bidirectional_scan(hg_dir(pc, pc[5], lb_l[0]), hg_dir(pc, pc[6], lb_l[1]),
                                    hg_dir(px, px[5], lb_l[0]), hg_dir(px, px[6], lb_l[1]))

    def merge(o_ret, o_hg, p):
        a = from_heads(_rms(o_ret)) * jax.nn.silu(p[3])
        b = from_heads(rms_norm(o_hg, hg_norm_w_l)) * jax.nn.silu(p[8])
        return jnp.concatenate([a, b], axis=-1) @ w_out_l

    y_x = merge(ret_x, hg_x, px)
    if ctx_out:
        return y_x, merge(ret_c, hg_c, pc)
    return y_x, None


def moe_ffn(h, router_w, router_b, w1, b1, w2, b2):
    T, D = h.shape
    logits = (h @ router_w + router_b).astype(jnp.float32)
    top_logit, top_idx = lax.top_k(logits, TOP_K)
    gates = jax.nn.softmax(top_logit, axis=-1)
    A = T * TOP_K
    flat_e = top_idx.reshape(A)
    flat_tok = jnp.arange(A, dtype=jnp.int32) // TOP_K
    order = jnp.argsort(flat_e)
    se, stok, sg = flat_e[order], flat_tok[order], gates.reshape(A)[order]
    counts = jnp.bincount(flat_e, length=N_EXPERTS)
    padded = (counts + MOE_BLOCK - 1) // MOE_BLOCK * MOE_BLOCK
    start = jnp.cumsum(counts) - counts
    pend = jnp.cumsum(padded)
    pstart = pend - padded
    dest = pstart[se] + jnp.arange(A, dtype=jnp.int32) - start[se]
    n_blocks = -(-A // MOE_BLOCK) + N_EXPERTS
    R = n_blocks * MOE_BLOCK
    row_tok = jnp.full((R,), T, jnp.int32).at[dest].set(stok)
    row_gate = jnp.zeros((R,), jnp.float32).at[dest].set(sg)
    block_e = jnp.minimum(jnp.searchsorted(pend, jnp.arange(n_blocks, dtype=jnp.int32) * MOE_BLOCK,
                                           side='right'), N_EXPERTS - 1)
    h_pad = jnp.concatenate([h, jnp.zeros((1, D), h.dtype)], axis=0)
    xb = h_pad[row_tok].reshape(n_blocks, MOE_BLOCK, D)

    def run_block(args):
        xblk, e = args
        hu = xblk @ w1[e] + b1[e]
        x_glu = jnp.minimum(hu[:, :D_FF], SWIGLU_LIMIT)
        x_lin = jnp.clip(hu[:, D_FF:], -SWIGLU_LIMIT, SWIGLU_LIMIT)
        act = x_glu * jax.nn.sigmoid(SWIGLU_ALPHA * x_glu) * (x_lin + 1.0)
        return act @ w2[e] + b2[e]

    yb = lax.map(run_block, (xb, block_e))
    y = jnp.zeros((T + 1, D), jnp.float32).at[row_tok].add(yb.reshape(R, D) * row_gate[:, None])
    return y[:T]


def setup_inputs(seed: int = 0) -> dict:
    key = jax.random.key(seed)
    ks = jax.random.split(key, 20)
    f32 = jnp.float32
    sd = D_MODEL ** -0.5
    nrm = lambda k, s: jax.random.normal(k, s, f32)
    return {
        "x": nrm(ks[0], (BATCH, SEQ, D_MODEL)),
        "c": nrm(ks[1], (BATCH, D_MODEL)),
        "ctx": nrm(ks[2], (BATCH, CTX_LEN, D_MODEL)),
        "c_ctx": nrm(ks[3], (D_MODEL,)),
        "w_ada": nrm(ks[4], (DEPTH, D_MODEL, 6 * D_MODEL)) * sd,
        "b_ada": nrm(ks[5], (DEPTH, 6 * D_MODEL)) * 0.02,
        "norm_mix_w": 1.0 + 0.02 * nrm(ks[6], (DEPTH, D_MODEL)),
        "norm_ffn_w": 1.0 + 0.02 * nrm(ks[7], (DEPTH, D_MODEL)),
        "w_in": nrm(ks[8], (DEPTH, D_MODEL, PROJ_W)) * sd,
        "w_out": nrm(ks[9], (DEPTH, D_MODEL, D_MODEL)) * sd,
        "hg_lb": nrm(ks[10], (DEPTH + 1, 2, HG_K_W)) * 0.5,
        "hg_norm_w": 1.0 + 0.02 * nrm(ks[11], (DEPTH, HG_DV)),
        "router_w": nrm(ks[12], (DEPTH, D_MODEL, N_EXPERTS)) * sd,
        "router_b": nrm(ks[13], (DEPTH, N_EXPERTS)) * 0.01,
        "w1": nrm(ks[14], (DEPTH, N_EXPERTS, D_MODEL, 2 * D_FF)) * sd,
        "b1": nrm(ks[15], (DEPTH, N_EXPERTS, 2 * D_FF)) * 0.02,
        "w2": nrm(ks[16], (DEPTH, N_EXPERTS, D_FF, D_MODEL)) * (D_FF ** -0.5),
        "b2": nrm(ks[17], (DEPTH, N_EXPERTS, D_MODEL)) * 0.02,
        "norm_final_w": 1.0 + 0.02 * nrm(ks[18], (D_MODEL,)),
    }


def reference(x, c, ctx, c_ctx, w_ada, b_ada, norm_mix_w, norm_ffn_w, w_in, w_out, hg_lb,
              hg_norm_w, router_w, router_b, w1, b1, w2, b2, norm_final_w):
    B, N, D = x.shape
    C = ctx.shape[1]
    ROWS = N // GRID_W
    row = jnp.repeat(jnp.arange(ROWS, dtype=jnp.float32), GRID_W)
    col = jnp.tile(jnp.arange(GRID_W, dtype=jnp.float32), ROWS)
    cos, sin = axial_rope_tables(row, col)
    lb_all = jnp.cumsum(jax.nn.softmax(hg_lb.astype(jnp.float32), axis=0), axis=0)
    s_c = jax.nn.silu(c.astype(jnp.float32))
    s_cc = jax.nn.silu(c_ctx.astype(jnp.float32))
    h_lat, h_ctx = x, ctx
    for l in range(DEPTH):
        last = l == DEPTH - 1
        sh1, sc1, g1, sh2, sc2, g2 = jnp.split(s_c @ w_ada[l] + b_ada[l], 6, axis=-1)
        csh1, csc1, cg1, csh2, csc2, cg2 = jnp.split(s_cc @ w_ada[l] + b_ada[l], 6, axis=-1)
        u_x = rms_norm(h_lat, norm_mix_w[l]) * (1.0 + sc1[:, None]) + sh1[:, None]
        u_c = rms_norm(h_ctx, norm_mix_w[l]) * (1.0 + csc1) + csh1
        y_x, y_c = hybrid_mixer(u_x, u_c, w_in[l], w_out[l], lb_all[l], hg_norm_w[l], cos, sin,
                                not last)
        h_lat = h_lat + g1[:, None] * y_x
        v_x = (rms_norm(h_lat, norm_ffn_w[l]) * (1.0 + sc2[:, None]) + sh2[:, None]).reshape(B * N, D)
        if last:
            y = moe_ffn(v_x, router_w[l], router_b[l], w1[l], b1[l], w2[l], b2[l])
        else:
            h_ctx = h_ctx + cg1 * y_c
            v_c = (rms_norm(h_ctx, norm_ffn_w[l]) * (1.0 + csc2) + csh2).reshape(B * C, D)
            y_all = moe_ffn(jnp.concatenate([v_c, v_x], axis=0), router_w[l], router_b[l],
                            w1[l], b1[l], w2[l], b2[l])
            h_ctx = h_ctx + cg2 * y_all[:B * C].reshape(B, C, D)
            y = y_all[B * C:]
        h_lat = h_lat + g2[:, None] * y.reshape(B, N, D)
    return rms_norm(h_lat, norm_final_w)
```

```cpp
#include <hip/hip_runtime.h>
#include <cstdio>
#include <cstdint>
namespace pg8 {
#define PG8_LAS __attribute__((address_space(3)))
typedef unsigned short bf16_t;
typedef short bf16x8 __attribute__((ext_vector_type(8)));
typedef float f32x4 __attribute__((ext_vector_type(4)));
typedef unsigned u32x4 __attribute__((ext_vector_type(4)));
constexpr int BM = 256, BK = 64, HALF = 128, HTB = HALF * BK * 2  , STAGE_BYTES = 8 * HTB, NXCD = 8, WGM = 8;

__host__ __device__ __forceinline__ int lds_byte(int r, int c) { const int st = (r >> 4) * 2 + (c >> 5), rr = r & 15, cc = c & 31, ob = rr * 64 + cc * 2; return st * 1024 + (ob ^ (((ob >> 9) & 1) << 5)); }
__host__ __device__ __forceinline__ void stage_rc(int b, int& R, int& C) { const int st = b / 1024, sb = b % 1024, swz = sb ^ (((sb >> 9) & 1) << 5); R = (st >> 1) * 16 + swz / 64; C = (st & 1) * 32 + (swz % 64) / 2; }
__host__ __device__ __forceinline__ int perm32(int rho) { const int n = rho >> 4, i = rho & 15; return 8 * (i >> 2) + 4 * n + (i & 3); }

struct Unit { int pm, pn; };
struct Gemm { const bf16_t* A; const bf16_t* Bt; int M, N, K; };

struct StaticOrder {
    int nM, nN, nwg, G, c;
    __host__ __device__ void init(int M, int N, int G_, int c_) { nM = M / BM; nN = N / BM; nwg = nM * nN; G = G_; c = c_; }
    __host__ __device__ bool next(int i, Unit& u) const {
        const long L = (long)i * G + c; if (L >= nwg) return false;
        int wgid = (int)L; { const int q = nwg / NXCD, r = nwg % NXCD, xcd = wgid % NXCD, off = wgid / NXCD; wgid = (xcd < r ? xcd * (q + 1) : r * (q + 1) + (xcd - r) * q) + off; }
        const int nig = WGM * nN, gid = wgid / nig, fm = gid * WGM, gsz = (nM - fm) < WGM ? (nM - fm) : WGM;
        u.pm = fm + ((wgid % nig) % gsz); u.pn = (wgid % nig) / gsz; return true;
    }
    __device__ __forceinline__ void a_ready(const Unit&) const {}
    __device__ __forceinline__ void done(const Unit&) const {}
};

template <class Epi, class Sched, bool ALIGN_EPI = false, bool SP2 = false>
__device__ __forceinline__ void gemm_phase(PG8_LAS unsigned char* lds, const Gemm g, const Sched& S, const Epi& E) {
    const int tid = threadIdx.x, wid = __builtin_amdgcn_readfirstlane(tid >> 6), lane = tid & 63, wr = wid >> 2, wc = wid & 3, fr = lane & 15, fq = lane >> 4;
    const int K = g.K, nt = K / BK;
    unsigned voffA[2], voffB[2];
#pragma unroll
    for (int i = 0; i < 2; ++i) { int R, C; stage_rc(tid * 16 + i * 8192, R, C); const int Rb = Epi::PERM ? ((R & ~31) + perm32(R & 31)) : R;
        voffA[i] = (unsigned)(R * K + C) * 2u; voffB[i] = (unsigned)(Rb * K + C) * 2u; }
    const size_t kstep = (size_t)(BK * 2);
    const size_t hstep = (size_t)HALF * K * 2;
    const size_t tstep = 2 * hstep;
    const unsigned ldsw = (unsigned)wid * 1024u;
    const int aoff = lds_byte(wr * 64 + fr, fq * 8), boff = lds_byte(wc * 32 + fr, fq * 8);
#define PG8_SA(b, h) (((b) * 2 + (h)) * HTB)
#define PG8_SB(b, h) ((4 + (b) * 2 + (h)) * HTB)
#define PG8_STAGE(bufoff, gbase, voff) do { _Pragma("unroll") for (int _i = 0; _i < 2; ++_i) \
        __builtin_amdgcn_global_load_lds((const unsigned*)((const char*)(gbase) + (voff)[_i]), (PG8_LAS unsigned*)(lds + (bufoff) + ldsw + _i * 8192), 16, 0, 0); } while (0)
#define PG8_LDA(dst, b, h) do { _Pragma("unroll") for (int m = 0; m < 4; ++m) _Pragma("unroll") for (int k = 0; k < 2; ++k) dst[m][k] = *(const PG8_LAS bf16x8*)(lds + PG8_SA(b, h) + aoff + m * 2048 + k * 1024); } while (0)
#define PG8_LDB(dst, b, h) do { _Pragma("unroll") for (int n = 0; n < 2; ++n) _Pragma("unroll") for (int k = 0; k < 2; ++k) dst[n][k] = *(const PG8_LAS bf16x8*)(lds + PG8_SB(b, h) + boff + n * 2048 + k * 1024); } while (0)
#define PG8_MMA(ai, bj, At, Bt) do { __builtin_amdgcn_s_setprio(1); _Pragma("unroll") for (int m = 0; m < 4; ++m) _Pragma("unroll") for (int n = 0; n < 2; ++n) _Pragma("unroll") for (int k = 0; k < 2; ++k) \
        acc[ai][bj][m][n] = __builtin_amdgcn_mfma_f32_16x16x32_bf16(Bt[n][k], At[m][k], acc[ai][bj][m][n], 0, 0, 0); __builtin_amdgcn_s_setprio(0); } while (0)
#define PG8_WAIT_V(n) asm volatile("s_waitcnt vmcnt(" #n ")" ::: "memory")
#define PG8_WAIT_L(n) asm volatile("s_waitcnt lgkmcnt(" #n ")" ::: "memory")
#define PG8_BAR __builtin_amdgcn_s_barrier()
#define PG8_SCHED __builtin_amdgcn_sched_barrier(0)
    Unit cur, nxt; int ui = 0;
    if (!S.next(0, cur)) return;
    f32x4 acc[2][2][4][2];
#pragma unroll
    for (int a = 0; a < 2; ++a)
#pragma unroll
        for (int b = 0; b < 2; ++b)
#pragma unroll
            for (int m = 0; m < 4; ++m)
#pragma unroll
                for (int n = 0; n < 2; ++n) acc[a][b][m][n] = (f32x4){0.f, 0.f, 0.f, 0.f};
    bf16x8 At[4][2], B0[2][2], B1[2][2];
    const char* cA = (const char*)g.A + (size_t)cur.pm * tstep; const char* cB = (const char*)g.Bt + (size_t)cur.pn * tstep;
    S.a_ready(cur);
    if constexpr (SP2) {
        PG8_STAGE(PG8_SB(0, 0), cB, voffB); PG8_STAGE(PG8_SB(0, 1), cB + hstep, voffB); PG8_STAGE(PG8_SA(0, 0), cA, voffA); PG8_STAGE(PG8_SA(0, 1), cA + hstep, voffA);
        if (wr == 1) PG8_BAR;
        PG8_WAIT_V(2); PG8_BAR;
        PG8_STAGE(PG8_SB(1, 0), cB + kstep, voffB); PG8_STAGE(PG8_SA(1, 0), cA + kstep, voffA); PG8_STAGE(PG8_SB(1, 1), cB + hstep + kstep, voffB);
        PG8_WAIT_V(6); PG8_BAR;
    } else {
        PG8_STAGE(PG8_SB(0, 0), cB, voffB); PG8_STAGE(PG8_SA(0, 0), cA, voffA); PG8_STAGE(PG8_SB(0, 1), cB + hstep, voffB); PG8_STAGE(PG8_SA(0, 1), cA + hstep, voffA);
        if (wr == 1) PG8_BAR;
        PG8_WAIT_V(4); PG8_BAR;
        PG8_STAGE(PG8_SB(1, 0), cB + kstep, voffB); PG8_STAGE(PG8_SA(1, 0), cA + kstep, voffA); PG8_STAGE(PG8_SB(1, 1), cB + hstep + kstep, voffB);
        PG8_WAIT_V(6); PG8_BAR;
    }
    for (;;) {
        const bool has_next = S.next(ui + 1, nxt);
        const char* nA = has_next ? (const char*)g.A + (size_t)nxt.pm * tstep : cA; const char* nB = has_next ? (const char*)g.Bt + (size_t)nxt.pn * tstep : cB;
        for (int t = 0; t < nt; t += 2) {
            const bool last = (t == nt - 2);
            const char* a1 = cA + (size_t)(t + 1) * kstep;
            const char* a2 = last ? nA : cA + (size_t)(t + 2) * kstep; const char* b2 = last ? nB : cB + (size_t)(t + 2) * kstep;
            const char* a3 = a2 + kstep; const char* b3 = b2 + kstep;
            if (last && has_next) S.a_ready(nxt);
            if constexpr (SP2) {
            PG8_LDB(B0, 0, 0); PG8_LDB(B1, 0, 1); PG8_SCHED; PG8_LDA(At, 0, 0); PG8_STAGE(PG8_SA(1, 1), a1 + hstep, voffA);
            PG8_WAIT_V(8); PG8_WAIT_L(0); PG8_BAR; PG8_MMA(0, 0, At, B0); PG8_MMA(0, 1, At, B1); PG8_BAR; PG8_SCHED;
            PG8_LDA(At, 0, 1); PG8_STAGE(PG8_SB(0, 0), b2, voffB); PG8_STAGE(PG8_SB(0, 1), b2 + hstep, voffB); PG8_STAGE(PG8_SA(0, 0), a2, voffA);
            PG8_WAIT_V(8); PG8_WAIT_L(0); PG8_BAR; PG8_MMA(1, 0, At, B0); PG8_MMA(1, 1, At, B1); PG8_BAR; PG8_SCHED;
            PG8_LDB(B0, 1, 0); PG8_LDB(B1, 1, 1); PG8_SCHED; PG8_LDA(At, 1, 0); PG8_STAGE(PG8_SA(0, 1), a2 + hstep, voffA);
            PG8_WAIT_V(8); PG8_WAIT_L(0); PG8_BAR; PG8_MMA(0, 0, At, B0); PG8_MMA(0, 1, At, B1); PG8_BAR; PG8_SCHED;
            PG8_LDA(At, 1, 1); PG8_STAGE(PG8_SB(1, 0), b3, voffB); PG8_STAGE(PG8_SB(1, 1), b3 + hstep, voffB); PG8_STAGE(PG8_SA(1, 0), a3, voffA);
            PG8_WAIT_V(8); PG8_WAIT_L(0); PG8_BAR; PG8_MMA(1, 0, At, B0); PG8_MMA(1, 1, At, B1); PG8_BAR; PG8_SCHED;
            } else {
            PG8_LDB(B0, 0, 0); PG8_SCHED; PG8_LDA(At, 0, 0); PG8_STAGE(PG8_SA(1, 1), a1 + hstep, voffA);
            PG8_WAIT_L(8); PG8_BAR; PG8_WAIT_L(0); PG8_MMA(0, 0, At, B0); PG8_BAR; PG8_SCHED;
            PG8_LDB(B1, 0, 1); PG8_STAGE(PG8_SB(0, 0), b2, voffB);
            PG8_BAR; PG8_WAIT_L(0); PG8_MMA(0, 1, At, B1); PG8_BAR;
            PG8_LDA(At, 0, 1); PG8_STAGE(PG8_SA(0, 0), a2, voffA);
            PG8_BAR; PG8_WAIT_L(0); PG8_MMA(1, 0, At, B0); PG8_BAR; PG8_SCHED;
            PG8_STAGE(PG8_SB(0, 1), b2 + hstep, voffB);
            PG8_WAIT_V(6); PG8_BAR; PG8_MMA(1, 1, At, B1); PG8_BAR;
            PG8_LDB(B0, 1, 0); PG8_SCHED; PG8_LDA(At, 1, 0); PG8_STAGE(PG8_SA(0, 1), a2 + hstep, voffA);
            PG8_WAIT_L(8); PG8_BAR; PG8_WAIT_L(0); PG8_MMA(0, 0, At, B0); PG8_BAR; PG8_SCHED;
            PG8_LDB(B1, 1, 1); PG8_STAGE(PG8_SB(1, 0), b3, voffB);
            PG8_BAR; PG8_WAIT_L(0); PG8_MMA(0, 1, At, B1); PG8_BAR;
            PG8_LDA(At, 1, 1); PG8_STAGE(PG8_SA(1, 0), a3, voffA);
            PG8_BAR; PG8_WAIT_L(0); PG8_MMA(1, 0, At, B0); PG8_BAR; PG8_SCHED;
            PG8_STAGE(PG8_SB(1, 1), b3 + hstep, voffB);
            PG8_WAIT_V(6); PG8_BAR; PG8_MMA(1, 1, At, B1); PG8_BAR;
            }
        }
        if constexpr (ALIGN_EPI) { if (wr == 0) PG8_BAR; }
        if constexpr (!Epi::AFTER_DRAIN) { E(acc, cur, wr, wc, fr, fq); S.done(cur); }
        if (!has_next) break;
#pragma unroll
        for (int a = 0; a < 2; ++a)
#pragma unroll
            for (int b = 0; b < 2; ++b)
#pragma unroll
                for (int m = 0; m < 4; ++m)
#pragma unroll
                    for (int n = 0; n < 2; ++n) acc[a][b][m][n] = (f32x4){0.f, 0.f, 0.f, 0.f};
        cur = nxt; cA = nA; cB = nB; ++ui;
        if constexpr (ALIGN_EPI) { if (wr == 1) PG8_BAR; }
    }
    PG8_WAIT_V(0);
    if constexpr (!ALIGN_EPI) { if (wr == 0) PG8_BAR; }
    PG8_BAR;
    if constexpr (Epi::AFTER_DRAIN) { E.fused(acc, cur, wr, wc, fr, fq, lds, wid, lane); S.done(cur); }
#undef PG8_SA
#undef PG8_SB
#undef PG8_STAGE
#undef PG8_LDA
#undef PG8_LDB
#undef PG8_MMA
#undef PG8_WAIT_V
#undef PG8_WAIT_L
#undef PG8_BAR
#undef PG8_SCHED
}
}

constexpr int NWAVES = 8;
constexpr int NPHASE = 11;
#ifndef MK_N_LAUNCHES
#define MK_N_LAUNCHES 1
#endif
constexpr int N_LAUNCHES = MK_N_LAUNCHES;

constexpr int D = 1024, BATCH = 8, SEQ = 2048, CTX = 256;
constexpr int NX = BATCH * SEQ, NC = BATCH * CTX, NROWS = NX + NC;
constexpr int PW = 4096;
constexpr int NEXP = 32, TOPK = 4, DFF = 1024;
constexpr int MAXRT = 288;
constexpr float EPS = 1e-6f;

constexpr size_t MiB = 1u << 20;
constexpr size_t WS_CTL = 0, CTL_ZERO_BYTES = 1 * MiB;
constexpr size_t WS_MOD = 1 * MiB;
constexpr size_t WS_LB = 1 * MiB + 512 * 1024;
constexpr size_t WS_COS = WS_LB + 4096, WS_SIN = WS_COS + 2048 * 32 * 4;
constexpr size_t WS_TOKE = 2 * MiB, WS_TOKPOS = WS_TOKE + 256 * 1024, WS_TOKGATE = WS_TOKPOS + 256 * 1024, WS_TOKROW = WS_TOKGATE + 256 * 1024, WS_ROWGATE = WS_TOKROW + 256 * 1024;
constexpr size_t WS_WIN = 4 * MiB, WS_WOUT = 12 * MiB, WS_W1 = 14 * MiB, WS_W2 = 142 * MiB;
constexpr size_t WS_XN = 206 * MiB, WS_P = 242 * MiB, WS_XG = WS_P, WS_OF = 386 * MiB, WS_OB = 418 * MiB, WS_AO = 450 * MiB;
constexpr size_t WS_H = 482 * MiB, WS_VX = 546 * MiB, WS_ACT = 578 * MiB, WS_YB = 722 * MiB, WS_END = 866 * MiB;
constexpr int CW_TMO = 0, CW_CODE = 1, CW_BAR = 4096, CW_CNT = 8192;

constexpr int LCTL_BYTES = 2048, SCR_OFF = LCTL_BYTES, LDS_BYTES = 147456;
constexpr int L_MISC = 0;
constexpr int L_TSTART = 128;
constexpr int L_TILEE = 384;
constexpr int L_LCNT = 1600;
constexpr int L_GBASE = 1728;

#define GAS __attribute__((address_space(1)))
#define LAS __attribute__((address_space(3)))
typedef unsigned short bf16;
typedef unsigned v4u __attribute__((ext_vector_type(4)));
typedef unsigned v2u __attribute__((ext_vector_type(2)));
typedef float f32x4 __attribute__((ext_vector_type(4)));
typedef float f32x2 __attribute__((ext_vector_type(2)));
typedef short bf16x8 __attribute__((ext_vector_type(8)));
typedef GAS unsigned gu32;
#define RLX_AGENT __ATOMIC_RELAXED, __HIP_MEMORY_SCOPE_AGENT
#define LDS_WAIT() asm volatile("s_waitcnt lgkmcnt(0)" ::: "memory")
#define VM_WAIT() asm volatile("s_waitcnt vmcnt(0)" ::: "memory")
#define LBAR() do { asm volatile("s_waitcnt lgkmcnt(0)" ::: "memory"); __builtin_amdgcn_s_barrier(); asm volatile("" ::: "memory"); } while (0)
__device__ __forceinline__ unsigned f2bf(float f) { unsigned u = __builtin_bit_cast(unsigned, f); return (u + 0x7fffu + ((u >> 16) & 1u)) >> 16; }
__device__ __forceinline__ unsigned pk2(float lo, float hi) { return f2bf(lo) | (f2bf(hi) << 16); }
__device__ __forceinline__ float bflo(unsigned u) { return __builtin_bit_cast(float, u << 16); }
__device__ __forceinline__ float bfhi(unsigned u) { return __builtin_bit_cast(float, u & 0xffff0000u); }
__device__ __forceinline__ float wave_sum(float v) {
#pragma unroll
    for (int o = 1; o < 64; o <<= 1) v += __shfl_xor(v, o);
    return v;
}
__device__ __forceinline__ float sigmoidf_(float x) { return 1.f / (1.f + __expf(-x)); }
__device__ __forceinline__ float siluf_(float x) { return x / (1.f + __expf(-x)); }

#define XB_TMO      128
#define XB_XCNT(j)  (256  + 64 * (j))
#define XB_XSUB(j)  (1280 + 64 * (j))
#define XB_XGEN(j)  (2304 + 64 * (j))
#define XB_TOP      3328
#define XB_TOPGEN   3392
#define XCD_BAR_WORDS 3456
#define XB_SPIN_CAP (1u << 18)

__device__ __forceinline__ unsigned xb_ld(unsigned* p)              { return __hip_atomic_load(p, __ATOMIC_RELAXED, __HIP_MEMORY_SCOPE_AGENT); }
__device__ __forceinline__ unsigned xb_add(unsigned* p, unsigned v) { return __hip_atomic_fetch_add(p, v, __ATOMIC_RELAXED, __HIP_MEMORY_SCOPE_AGENT); }
__device__ __forceinline__ unsigned xb_xcc_id() { return (unsigned)__builtin_amdgcn_s_getreg((3 << 11) | 20) & 0xFu; }
#define XB_SPIN(cond, bar) do { unsigned _sp = 0; while (cond) { __builtin_amdgcn_s_sleep(1); \
    if ((++_sp & 255u) == 0u) { if (xb_ld(&(bar)[XB_TMO])) break; if (_sp > XB_SPIN_CAP) { atomicAdd(&(bar)[XB_TMO], 1u); break; } } } } while (0)

struct XcdBarrier {
    unsigned* bar; unsigned x;
    volatile LAS unsigned* st;
};

__device__ __forceinline__ XcdBarrier xcd_barrier_post(unsigned* bar, volatile LAS unsigned* st) {
    XcdBarrier b; b.bar = bar; b.x = xb_xcc_id(); b.st = st;
    if (threadIdx.x == 0) (void)xb_add(&bar[XB_XCNT(b.x)], 1u);
    return b;
}
__device__ __forceinline__ void xcd_barrier_complete(unsigned* bar, unsigned x, unsigned& nloc, unsigned& nx) {
    const unsigned G = gridDim.x * gridDim.y * gridDim.z;
    unsigned sum, cnt, mine, sp = 0u;
    for (;;) {
        sum = 0u; cnt = 0u; mine = 0u;
#pragma unroll
        for (unsigned j = 0; j < 16; ++j) { const unsigned c = xb_ld(&bar[XB_XCNT(j)]); sum += c; cnt += (c > 0u) ? 1u : 0u; mine = (j == x) ? c : mine; }
        if (sum == G) break;
        __builtin_amdgcn_s_sleep(1);
        if ((++sp & 255u) == 0u) { if (xb_ld(&bar[XB_TMO])) break; if (sp > XB_SPIN_CAP) { atomicAdd(&bar[XB_TMO], 1u); break; } }
    }
    nloc = mine > 0u ? mine : 1u; nx = cnt > 0u ? cnt : 1u;
}

__device__ __forceinline__ void xcd_barrier(const XcdBarrier& b) {
    asm volatile("s_waitcnt vmcnt(0)" ::: "memory");
    __syncthreads();
    if (threadIdx.x == 0) {
        unsigned* bar = b.bar;
        __builtin_amdgcn_s_waitcnt(0);
        unsigned nloc = b.st[0], nx = b.st[1];
        if (nloc == 0u) { xcd_barrier_complete(bar, b.x, nloc, nx); b.st[0] = nloc; b.st[1] = nx; }
        const unsigned old = xb_add(&bar[XB_XSUB(b.x)], 1u);
        const unsigned gen = old / nloc;
        if (old + 1u == (gen + 1u) * nloc) {
            __builtin_amdgcn_fence(__ATOMIC_RELEASE, "agent");
            asm volatile("s_waitcnt vmcnt(0)" ::: "memory");
            const unsigned og = xb_add(&bar[XB_TOP], 1u);
            const unsigned tg = og / nx;
            if (og + 1u == (tg + 1u) * nx) xb_add(&bar[XB_TOPGEN], 1u);
            else XB_SPIN(xb_ld(&bar[XB_TOPGEN]) == tg, bar);
            __builtin_amdgcn_fence(__ATOMIC_ACQUIRE, "agent");
            xb_add(&bar[XB_XGEN(b.x)], 1u);
            asm volatile("s_waitcnt vmcnt(0)" ::: "memory");
        } else {
            XB_SPIN(xb_ld(&bar[XB_XGEN(b.x)]) == gen, bar);
            __builtin_amdgcn_fence(__ATOMIC_ACQUIRE, "agent");
            asm volatile("s_waitcnt vmcnt(0)" ::: "memory");
        }
    }
    __syncthreads();
}


struct Frame {
    LAS unsigned char* lds;
    gu32* ctl;
    int tid, lane, wave, vcu, G;
    const float* in[19];
    float* out;
    unsigned char* ws;
};
#define IN_X 0
#define IN_C 1
#define IN_CTX 2
#define IN_CCTX 3
#define IN_WADA 4
#define IN_BADA 5
#define IN_NMIX 6
#define IN_NFFN 7
#define IN_WIN 8
#define IN_WOUT 9
#define IN_HGLB 10
#define IN_HGNW 11
#define IN_RW 12
#define IN_RB 13
#define IN_W1 14
#define IN_B1 15
#define IN_W2 16
#define IN_B2 17
#define IN_NFIN 18

__device__ __forceinline__ void transpose_item(const float* W, int ldw, bf16* WT, int ldt, int k0, int n0, int prow0, LAS float* scr, int lane) {
#pragma unroll 8
    for (int i = 0; i < 32; ++i) { const int kk = 2 * i + (lane >> 5); scr[kk * 33 + (lane & 31)] = W[(size_t)(k0 + kk) * ldw + n0 + (lane & 31)]; }
    LDS_WAIT(); asm volatile("" ::: "memory");
    const int c = lane & 7;
#pragma unroll
    for (int j = 0; j < 4; ++j) { const int n = (lane >> 3) + 8 * j; const LAS float* s = scr + (8 * c) * 33 + n;
        v4u o; o.x = pk2(s[0 * 33], s[1 * 33]); o.y = pk2(s[2 * 33], s[3 * 33]); o.z = pk2(s[4 * 33], s[5 * 33]); o.w = pk2(s[6 * 33], s[7 * 33]);
        *(GAS v4u*)(WT + (size_t)(prow0 + n) * ldt + k0 + 8 * c) = o; }
    LDS_WAIT(); asm volatile("" ::: "memory");
}
__device__ __forceinline__ void p0_prologue(Frame& F) {
    LAS float* scr = (LAS float*)(F.lds + SCR_OFF + F.wave * 8448);
    const int gw = F.vcu * NWAVES + F.wave, NGW = F.G * NWAVES;
    float* MOD = (float*)(F.ws + WS_MOD);
    if (F.vcu < 12) {
        LAS float* sl = (LAS float*)(F.lds + SCR_OFF + 8 * 8448);
        for (int i = F.tid; i < 9 * 1024; i += NWAVES * 64) { const int b = i >> 10, k = i & 1023; const float cv = b < 8 ? F.in[IN_C][b * 1024 + k] : F.in[IN_CCTX][k]; sl[i] = siluf_(cv); }
        __syncthreads();
        const int j = 64 * gw + F.lane;
        const float* wa = F.in[IN_WADA] + j;
        float acc[9];
#pragma unroll
        for (int b = 0; b < 9; ++b) acc[b] = 0.f;
        for (int k = 0; k < 1024; k += 8) {
            float w[8];
#pragma unroll
            for (int i = 0; i < 8; ++i) w[i] = wa[(size_t)(k + i) * 6144];
#pragma unroll
            for (int b = 0; b < 9; ++b) { const f32x4 s0 = *(const LAS f32x4*)(sl + b * 1024 + k), s1 = *(const LAS f32x4*)(sl + b * 1024 + k + 4);
                acc[b] += s0[0] * w[0] + s0[1] * w[1] + s0[2] * w[2] + s0[3] * w[3] + s1[0] * w[4] + s1[1] * w[5] + s1[2] * w[6] + s1[3] * w[7]; }
        }
        const float bb = F.in[IN_BADA][j];
#pragma unroll
        for (int b = 0; b < 9; ++b) MOD[b * 6144 + j] = acc[b] + bb;
        __syncthreads();
    }
    if (F.vcu == F.G - 1) {
        float* LB = (float*)(F.ws + WS_LB); float* COS = (float*)(F.ws + WS_COS); float* SIN = (float*)(F.ws + WS_SIN);
        for (int i = F.tid; i < 1024; i += NWAVES * 64) { const float a0 = F.in[IN_HGLB][i], a1 = F.in[IN_HGLB][1024 + i]; LB[i] = 1.f / (1.f + expf(a1 - a0)); }
        for (int i = F.tid; i < 2048 * 32; i += NWAVES * 64) { const int n = i >> 5, j = i & 31, fi = j & 15; const float pos = (float)(j < 16 ? (n >> 6) : (n & 63));
            const float inv = powf(10000.f, -(float)fi / 16.f); const float ang = pos * inv; COS[i] = cosf(ang); SIN[i] = sinf(ang); }
    }
    constexpr int I_IN = 16 * 128, I_OUT = 16 * 32, I_W1 = 32 * 16 * 64, I_W2 = 32 * 16 * 32, NITEMS = I_IN + I_OUT + I_W1 + I_W2;
    bf16* WinT = (bf16*)(F.ws + WS_WIN); bf16* WoutT = (bf16*)(F.ws + WS_WOUT); bf16* W1T = (bf16*)(F.ws + WS_W1); bf16* W2T = (bf16*)(F.ws + WS_W2);
    for (int it = gw; it < NITEMS; it += NGW) {
        int r = it;
        if (r < I_IN) { const int kb = r >> 7, nb = r & 127, n0 = nb * 32; int prow0 = n0;
            if (n0 < 512) { const int l = n0 & 255, head = l >> 6, half = (l >> 5) & 1; prow0 = (n0 & ~255) + 128 * half + 32 * head; }
            transpose_item(F.in[IN_WIN], PW, WinT, D, kb * 64, n0, prow0, scr, F.lane); continue; }
        r -= I_IN;
        if (r < I_OUT) { const int kb = r >> 5, nb = r & 31; transpose_item(F.in[IN_WOUT], D, WoutT, D, kb * 64, nb * 32, nb * 32, scr, F.lane); continue; }
        r -= I_OUT;
        if (r < I_W1) { const int e = r >> 10, q = r & 1023, kb = q >> 6, nb = q & 63, n0 = nb * 32; const int half = n0 >> 10, rr = n0 & 1023, tile = rr >> 7, jj = rr & 127;
            transpose_item(F.in[IN_W1] + (size_t)e * 1024 * 2048, 2048, W1T + (size_t)e * 2048 * 1024, 1024, kb * 64, n0, 256 * tile + 128 * half + jj, scr, F.lane); continue; }
        r -= I_W1;
        { const int e = r >> 9, q = r & 511, kb = q >> 5, nb = q & 31; transpose_item(F.in[IN_W2] + (size_t)e * 1024 * 1024, 1024, W2T + (size_t)e * 1024 * 1024, 1024, kb * 64, nb * 32, nb * 32, scr, F.lane); }
    }
}

__device__ __forceinline__ void p1_xn(Frame& F) {
    const int gw = F.vcu * NWAVES + F.wave, NGW = F.G * NWAVES;
    const float* MOD = (const float*)(F.ws + WS_MOD); bf16* XN = (bf16*)(F.ws + WS_XN);
    for (int m = gw; m < NROWS; m += NGW) {
        const float* src = m < NX ? F.in[IN_X] + (size_t)m * D : F.in[IN_CTX] + (size_t)(m - NX) * D; const int b = m < NX ? (m >> 11) : 8;
        const GAS f32x4* xr = (const GAS f32x4*)src + F.lane; f32x4 v[4]; float s = 0.f;
#pragma unroll
        for (int j = 0; j < 4; ++j) { v[j] = xr[64 * j]; s += (v[j].x * v[j].x + v[j].y * v[j].y) + (v[j].z * v[j].z + v[j].w * v[j].w); }
        const float rinv = 1.f / sqrtf(wave_sum(s) * (1.f / D) + EPS);
        GAS v2u* o8 = (GAS v2u*)(XN + (size_t)m * D) + F.lane;
#pragma unroll
        for (int j = 0; j < 4; ++j) { const int k = 4 * F.lane + 256 * j;
            const f32x4 nw = *(const f32x4*)(F.in[IN_NMIX] + k), sh = *(const f32x4*)(MOD + b * 6144 + k), sc = *(const f32x4*)(MOD + b * 6144 + 1024 + k);
            const f32x4 u = v[j] * rinv * nw * (sc + 1.f) + sh; v2u w; w.x = pk2(u.x, u.y); w.y = pk2(u.z, u.w); o8[64 * j] = w; }
    }
}

struct InProjOrder {
    int G, c;
    __device__ __forceinline__ bool next(int i, pg8::Unit& u) const {
        const int L = i * G + c;
        if (L < 1024) { pg8::StaticOrder S; S.init(NX, PW, 1 << 30, L); return S.next(0, u); }
        if (L < 1024 + 72) { const int j = L - 1024, ti = j >> 3; u.pm = 64 + (j & 7); u.pn = ti < 3 ? 1 + ti : 5 + ti; return true; }
        return false;
    }
    __device__ __forceinline__ void a_ready(const pg8::Unit&) const {}
    __device__ __forceinline__ void done(const pg8::Unit&) const {}
};
struct EpiInProj {
    static constexpr bool PERM = true, AFTER_DRAIN = false;
    bf16* P; const float* LB; const float* COS; const float* SIN;
    __device__ __forceinline__ void operator()(const f32x4 (&acc)[2][2][4][2], const pg8::Unit& u, int wr, int wc, int fr, int fq) const {
        const int t = u.pn; const int row0 = u.pm * 256 + wr * 64 + fr; const int cb = wc * 32 + 8 * fq;
        if (t < 2) {
            const bool isx = u.pm < 64; const float sc = t == 1 ? 0.125f : 1.f;
#pragma unroll
            for (int ai = 0; ai < 2; ++ai)
#pragma unroll
                for (int m = 0; m < 4; ++m) { const int r = row0 + ai * 128 + m * 16; f32x4 c0, c1, s0, s1;
                    if (isx) { const int pos = r & 2047; c0 = *(const f32x4*)(COS + pos * 32 + 8 * fq); c1 = *(const f32x4*)(COS + pos * 32 + 8 * fq + 4); s0 = *(const f32x4*)(SIN + pos * 32 + 8 * fq); s1 = *(const f32x4*)(SIN + pos * 32 + 8 * fq + 4); }
                    else { c0 = (f32x4){1.f, 1.f, 1.f, 1.f}; c1 = c0; s0 = (f32x4){0.f, 0.f, 0.f, 0.f}; s1 = s0; }
                    const f32x4 a0 = acc[ai][0][m][0] * sc, a1 = acc[ai][0][m][1] * sc, b0 = acc[ai][1][m][0] * sc, b1 = acc[ai][1][m][1] * sc;
                    const f32x4 o10 = a0 * c0 - b0 * s0, o11 = a1 * c1 - b1 * s1, o20 = a0 * s0 + b0 * c0, o21 = a1 * s1 + b1 * c1;
                    bf16* rp = P + (size_t)r * PW + 256 * t + 64 * wc + 8 * fq;
                    v4u w; w.x = pk2(o10[0], o10[1]); w.y = pk2(o10[2], o10[3]); w.z = pk2(o11[0], o11[1]); w.w = pk2(o11[2], o11[3]); *(v4u*)rp = w;
                    w.x = pk2(o20[0], o20[1]); w.y = pk2(o20[2], o20[3]); w.z = pk2(o21[0], o21[1]); w.w = pk2(o21[2], o21[3]); *(v4u*)(rp + 32) = w; }
            return;
        }
        const int mode = (t == 2 || t == 3 || t == 12 || t == 13) ? 0 : ((t >= 8 && t < 12) ? 2 : 1);
        f32x4 lb[2][2];
        if (mode == 2) {
#pragma unroll
            for (int bj = 0; bj < 2; ++bj)
#pragma unroll
                for (int n = 0; n < 2; ++n) lb[bj][n] = *(const f32x4*)(LB + ((t - 8) >> 1) * 512 + ((t & 1) << 8) + 128 * bj + cb + 4 * n);
        }
#pragma unroll
        for (int ai = 0; ai < 2; ++ai)
#pragma unroll
            for (int m = 0; m < 4; ++m) { const int r = row0 + ai * 128 + m * 16; bf16* rp = P + (size_t)r * PW + 256 * t + cb;
#pragma unroll
                for (int bj = 0; bj < 2; ++bj) { f32x4 v0 = acc[ai][bj][m][0], v1 = acc[ai][bj][m][1];
                    if (mode == 1) {
#pragma unroll
                        for (int i = 0; i < 4; ++i) { v0[i] = siluf_(v0[i]); v1[i] = siluf_(v1[i]); } }
                    else if (mode == 2) {
#pragma unroll
                        for (int i = 0; i < 4; ++i) { const float l0 = lb[bj][0][i], l1 = lb[bj][1][i]; v0[i] = __logf(l0 + (1.f - l0) * sigmoidf_(v0[i])); v1[i] = __logf(l1 + (1.f - l1) * sigmoidf_(v1[i])); } }
                    v4u w; w.x = pk2(v0[0], v0[1]); w.y = pk2(v0[2], v0[3]); w.z = pk2(v1[0], v1[1]); w.w = pk2(v1[2], v1[3]); *(v4u*)(rp + 128 * bj) = w; } }
    }
};

__device__ __forceinline__ bf16x8 ldfrag(const LAS unsigned char* base, int stride, int row0, int kb, int lane) {
    return *(const LAS bf16x8*)(base + (row0 + (lane & 15)) * stride + kb + 16 * (lane >> 4));
}
#define MFMA16(a, b, c) __builtin_amdgcn_mfma_f32_16x16x32_bf16((a), (b), (c), 0, 0, 0)
template <bool HG>
__device__ __forceinline__ void scan_chain(Frame& F, int b, int h, int dir, int dvh) {
    constexpr int DK = HG ? 128 : 64;
    constexpr int QS = DK * 2 + 16, SS = 64 * 2 + 16;
    constexpr int KROWS = HG ? 160 : 64;
    constexpr int O_QI = 0, O_QT = O_QI + 64 * QS, O_KIJ = O_QT + 64 * QS, O_KTT = O_KIJ + KROWS * QS, O_VT = O_KTT + DK * SS, O_PM = O_VT + 64 * SS, O_ST = O_PM + 64 * SS, O_T = O_ST + 64 * QS, O_GD = O_T + 4096, O_END = O_GD + 512;
    static_assert(SCR_OFF + O_END <= LDS_BYTES, "scan LDS");
    LAS unsigned char* L = F.lds + SCR_OFF;
    LAS unsigned char* Qi = L + O_QI; LAS unsigned char* Qt = L + O_QT; LAS unsigned char* Kij = L + O_KIJ; LAS unsigned char* Ktt = L + O_KTT;
    LAS unsigned char* Vt = L + O_VT; LAS unsigned char* Pm = L + O_PM; LAS unsigned char* St = L + O_ST;
    LAS float* T = (LAS float*)(L + O_T); LAS float* GD = (LAS float*)(L + O_GD);
    const int tid = F.tid, lane = F.lane, w = F.wave;
    const bf16* P = (const bf16*)(F.ws + WS_P);
    bf16* O = (bf16*)(F.ws + (dir ? WS_OB : WS_OF));
    const int qcol = HG ? 1536 + 128 * h : 64 * h;
    const int kcol = HG ? 2048 + 512 * dir + 128 * h : 256 + 64 * h;
    const int vcol = (HG ? 3072 : 512) + 128 * h + 64 * dvh;
    const int ocol = (HG ? 512 : 0) + 128 * h + 64 * dvh;
    const float lg = HG ? 0.f : log1pf(-exp2f(-(float)(dir ? 6 : 5) - 2.f * (float)h));
    for (int i = tid; i < (64 * SS) / 4; i += NWAVES * 64) ((LAS unsigned*)Pm)[i] = 0u;
    for (int i = tid; i < (64 * QS) / 4; i += NWAVES * 64) ((LAS unsigned*)St)[i] = 0u;
    constexpr int NVB = HG ? 4 : 2;
    f32x4 accS[NVB];
#pragma unroll
    for (int i = 0; i < NVB; ++i) accS[i] = (f32x4){0.f, 0.f, 0.f, 0.f};
    const int db = HG ? w : (w & 3);
    const int tb = w & 3, vb0 = 2 * (w >> 2);
    constexpr int TPT = HG ? 8 : 4;
    const int cp = HG ? lane : (tid & 31);
    const int tg = HG ? w : (tid >> 5);
    const int vp = tid >> 3, vs = tid & 7;
    unsigned qreg[TPT], kreg[TPT]; v4u vreg;
#define SCAN_ROW0(s) ((s) < 4 ? (NX + b * CTX + (dir ? 255 - 64 * (s) : 64 * (s))) : (b * SEQ + (dir ? 2047 - 64 * ((s) - 4) : 64 * ((s) - 4))))
#define SCAN_LOAD(s) do { const int r0_ = SCAN_ROW0(s); const int sg_ = dir ? -1 : 1; \
        _Pragma("unroll") for (int j = 0; j < TPT; ++j) { const bf16* rp_ = P + (size_t)(r0_ + sg_ * (TPT * tg + j)) * PW; \
            kreg[j] = *(const unsigned*)(rp_ + kcol + 2 * cp); qreg[j] = ((s) >= 4) ? *(const unsigned*)(rp_ + qcol + 2 * cp) : 0u; } \
        vreg = *(const v4u*)(P + (size_t)(r0_ + sg_ * vp) * PW + vcol + 8 * vs); } while (0)
    SCAN_LOAD(0);
    LBAR();
    for (int s = 0; s < 36; ++s) {
        const bool isx = s >= 4;
        const int r0 = SCAN_ROW0(s); const int sg = dir ? -1 : 1;
        {
            const unsigned vv[4] = {vreg.x, vreg.y, vreg.z, vreg.w};
#pragma unroll
            for (int e = 0; e < 4; ++e) { *(LAS unsigned short*)(Vt + (8 * vs + 2 * e) * SS + 2 * vp) = (unsigned short)(vv[e] & 0xffffu); *(LAS unsigned short*)(Vt + (8 * vs + 2 * e + 1) * SS + 2 * vp) = (unsigned short)(vv[e] >> 16); }
        }
        if constexpr (HG) {
            float c0[8], c1[8]; float run0 = 0.f, run1 = 0.f;
#pragma unroll
            for (int j = 0; j < 8; ++j) { run0 += bflo(kreg[j]); run1 += bfhi(kreg[j]); c0[j] = run0; c1[j] = run1; }
            *(LAS f32x2*)(T + w * 128 + 2 * cp) = (f32x2){run0, run1};
            LBAR();
            float pre0 = 0.f, pre1 = 0.f, base0 = 0.f, base1 = 0.f, bm0 = 0.f, bm1 = 0.f; float bs0[4], bs1[4];
            const int i_sub = w >> 1;
#pragma unroll
            for (int o = 0; o < 8; ++o) { const f32x2 tt = *(const LAS f32x2*)(T + o * 128 + 2 * cp);
                if (o == w) { base0 = pre0; base1 = pre1; }
                if ((o & 1) == 0) { bs0[o >> 1] = pre0; bs1[o >> 1] = pre1; if ((o >> 1) == i_sub) { bm0 = pre0; bm1 = pre1; } }
                pre0 += tt.x; pre1 += tt.y; }
            const float bend0 = pre0, bend1 = pre1;
            const float eBi0 = __expf(bm0), eBi1 = __expf(bm1), eEnd0 = __expf(bend0 - bm0), eEnd1 = __expf(bend1 - bm1);
            float gI0[4], gI1[4];
#pragma unroll
            for (int ii = 0; ii < 4; ++ii) { gI0[ii] = __expf(fminf(bs0[ii] - bm0, 0.f)); gI1[ii] = __expf(fminf(bs1[ii] - bm1, 0.f)); }
            if (w == 0) *(LAS f32x2*)(GD + 2 * cp) = (f32x2){__expf(bend0), __expf(bend1)};
            unsigned kt0[4], kt1[4];
#pragma unroll
            for (int j = 0; j < 8; ++j) {
                const int p = 8 * w + j;
                const float d0 = base0 + c0[j] - bm0, d1 = base1 + c1[j] - bm1;
                const float E0 = __expf(d0), E1 = __expf(d1), R0 = __expf(-d0), R1 = __expf(-d1);
                const float k0 = 1.f - __expf(bflo(kreg[j])), k1 = 1.f - __expf(bfhi(kreg[j]));
                const float kr0 = k0 * R0, kr1 = k1 * R1;
                const unsigned ktp = pk2(kr0 * eEnd0, kr1 * eEnd1);
                if ((j & 1) == 0) { kt0[j >> 1] = ktp & 0xffffu; kt1[j >> 1] = ktp >> 16; } else { kt0[j >> 1] |= ktp << 16; kt1[j >> 1] |= ktp & 0xffff0000u; }
                if (isx) {
                    const float q0 = bflo(qreg[j]), q1 = bfhi(qreg[j]);
                    const float qi0 = q0 * E0, qi1 = q1 * E1;
                    *(LAS unsigned*)(Qi + p * QS + 4 * cp) = pk2(qi0, qi1);
                    *(LAS unsigned*)(Qt + p * QS + 4 * cp) = pk2(qi0 * eBi0, qi1 * eBi1);
#pragma unroll
                    for (int ii = 0; ii < 4; ++ii) if (ii >= i_sub) { const int blk = ii * (ii + 1) / 2 + i_sub;
                        *(LAS unsigned*)(Kij + (blk * 16 + (p & 15)) * QS + 4 * cp) = pk2(kr0 * gI0[ii], kr1 * gI1[ii]); }
                }
            }
            *(LAS v4u*)(Ktt + (2 * cp) * SS + 16 * w) = (v4u){kt0[0], kt0[1], kt0[2], kt0[3]};
            *(LAS v4u*)(Ktt + (2 * cp + 1) * SS + 16 * w) = (v4u){kt1[0], kt1[1], kt1[2], kt1[3]};
        } else {
            unsigned kt0[2], kt1[2];
#pragma unroll
            for (int j = 0; j < 4; ++j) {
                const int p = 4 * tg + j;
                const float kd = __expf(lg * (float)(63 - p));
                const unsigned ktp = pk2(bflo(kreg[j]) * kd, bfhi(kreg[j]) * kd);
                if ((j & 1) == 0) { kt0[j >> 1] = ktp & 0xffffu; kt1[j >> 1] = ktp >> 16; } else { kt0[j >> 1] |= ktp << 16; kt1[j >> 1] |= ktp & 0xffff0000u; }
                if (isx) {
                    const float qd = __expf(lg * (float)(p + 1));
                    *(LAS unsigned*)(Qi + p * QS + 4 * cp) = qreg[j];
                    *(LAS unsigned*)(Qt + p * QS + 4 * cp) = pk2(bflo(qreg[j]) * qd, bfhi(qreg[j]) * qd);
                    *(LAS unsigned*)(Kij + p * QS + 4 * cp) = kreg[j];
                }
            }
            *(LAS v2u*)(Ktt + (2 * cp) * SS + 8 * tg) = (v2u){kt0[0], kt0[1]};
            *(LAS v2u*)(Ktt + (2 * cp + 1) * SS + 8 * tg) = (v2u){kt1[0], kt1[1]};
        }
        if (s + 1 < 36) SCAN_LOAD(s + 1);
        LBAR();
        f32x4 oT[2];
        oT[0] = (f32x4){0.f, 0.f, 0.f, 0.f}; oT[1] = oT[0];
        if (isx) {
#pragma unroll
            for (int rep = 0; rep < 2; ++rep) { const int bi = w + 8 * rep; if (bi < 10) {
                const int i = bi >= 6 ? 3 : (bi >= 3 ? 2 : (bi >= 1 ? 1 : 0)), j = bi - i * (i + 1) / 2;
                f32x4 sc = (f32x4){0.f, 0.f, 0.f, 0.f};
#pragma unroll
                for (int ks = 0; ks < DK / 32; ++ks) { const bf16x8 a = ldfrag(Kij, QS, HG ? 16 * bi : 16 * j, 64 * ks, lane), bq = ldfrag(Qi, QS, 16 * i, 64 * ks, lane); sc = MFMA16(a, bq, sc); }
#pragma unroll
                for (int r = 0; r < 4; ++r) { const int dt = (16 * i + (lane & 15)) - (16 * j + 4 * (lane >> 4) + r);
                    if constexpr (HG) { if (dt < 0) sc[r] = 0.f; } else { sc[r] = dt >= 0 ? sc[r] * __expf(lg * (float)dt) : 0.f; } }
                *(LAS v2u*)(Pm + (16 * i + (lane & 15)) * SS + 2 * (16 * j + 4 * (lane >> 4))) = (v2u){pk2(sc[0], sc[1]), pk2(sc[2], sc[3])}; } }
#pragma unroll
            for (int vi = 0; vi < 2; ++vi)
#pragma unroll
                for (int ks = 0; ks < DK / 32; ++ks) { const bf16x8 a = ldfrag(St, QS, 16 * (vb0 + vi), 64 * ks, lane), bq = ldfrag(Qt, QS, 16 * tb, 64 * ks, lane); oT[vi] = MFMA16(a, bq, oT[vi]); }
        }
        {
            f32x4 gv;
            if constexpr (HG) gv = *(const LAS f32x4*)(GD + 16 * db + 4 * (lane >> 4)); else { const float g64 = __expf(lg * 64.f); gv = (f32x4){g64, g64, g64, g64}; }
#pragma unroll
            for (int vi = 0; vi < NVB; ++vi) { const int vb = HG ? vi : vb0 + vi; accS[vi] = accS[vi] * gv;
#pragma unroll
                for (int ks = 0; ks < 2; ++ks) { const bf16x8 a = ldfrag(Ktt, SS, 16 * db, 64 * ks, lane), bv = ldfrag(Vt, SS, 16 * vb, 64 * ks, lane); accS[vi] = MFMA16(a, bv, accS[vi]); } }
        }
        LBAR();
        if (isx) {
#pragma unroll
            for (int vi = 0; vi < 2; ++vi) {
#pragma unroll
                for (int ks = 0; ks < 2; ++ks) { const bf16x8 a = ldfrag(Vt, SS, 16 * (vb0 + vi), 64 * ks, lane), bp = ldfrag(Pm, SS, 16 * tb, 64 * ks, lane); oT[vi] = MFMA16(a, bp, oT[vi]); }
                const int t = 16 * tb + (lane & 15);
                *(v2u*)(O + (size_t)(r0 + sg * t) * D + ocol + 16 * (vb0 + vi) + 4 * (lane >> 4)) = (v2u){pk2(oT[vi][0], oT[vi][1]), pk2(oT[vi][2], oT[vi][3])};
            }
        }
#pragma unroll
        for (int vi = 0; vi < NVB; ++vi) { const int vb = HG ? vi : vb0 + vi;
            *(LAS v2u*)(St + (16 * vb + (lane & 15)) * QS + 2 * (16 * db + 4 * (lane >> 4))) = (v2u){pk2(accS[vi][0], accS[vi][1]), pk2(accS[vi][2], accS[vi][3])}; }
        LBAR();
    }
#undef SCAN_LOAD
#undef SCAN_ROW0
}
__device__ __forceinline__ void p3_scan(Frame& F) {
    for (int id = F.vcu; id < 256; id += F.G) {
        const int dvh = id & 1, mixer = (id >> 1) & 1, dir = (id >> 2) & 1, h = (id >> 3) & 3, b = id >> 5;
        if (mixer) scan_chain<true>(F, b, h, dir, dvh); else scan_chain<false>(F, b, h, dir, dvh);
        __syncthreads();
    }
}

__device__ __forceinline__ void p4_merge(Frame& F) {
    const int gw = F.vcu * NWAVES + F.wave, NGW = F.G * NWAVES;
    const bf16* P = (const bf16*)(F.ws + WS_P); const bf16* OF = (const bf16*)(F.ws + WS_OF); const bf16* OB = (const bf16*)(F.ws + WS_OB); bf16* AO = (bf16*)(F.ws + WS_AO);
    const int lane = F.lane; const bool ishg = lane >= 32;
    float nw[16];
#pragma unroll
    for (int i = 0; i < 16; ++i) nw[i] = ishg ? F.in[IN_HGNW][16 * (lane & 7) + i] : 1.f;
    for (int t = gw; t < NX; t += NGW) {
        const v4u* pf = (const v4u*)(OF + (size_t)t * D + 16 * lane); const v4u* pb = (const v4u*)(OB + (size_t)t * D + 16 * lane);
        const v4u* pg = (const v4u*)(P + (size_t)t * PW + (ishg ? 3584 + 16 * (lane - 32) : 1024 + 16 * lane));
        const v4u f0 = pf[0], f1 = pf[1], b0 = pb[0], b1 = pb[1], g0 = pg[0], g1 = pg[1];
        const unsigned fu[8] = {f0.x, f0.y, f0.z, f0.w, f1.x, f1.y, f1.z, f1.w}, bu[8] = {b0.x, b0.y, b0.z, b0.w, b1.x, b1.y, b1.z, b1.w}, gu[8] = {g0.x, g0.y, g0.z, g0.w, g1.x, g1.y, g1.z, g1.w};
        float x[16]; float ss = 0.f;
#pragma unroll
        for (int i = 0; i < 8; ++i) { x[2 * i] = bflo(fu[i]) + bflo(bu[i]); x[2 * i + 1] = bfhi(fu[i]) + bfhi(bu[i]); ss += x[2 * i] * x[2 * i] + x[2 * i + 1] * x[2 * i + 1]; }
        ss += __shfl_xor(ss, 1); ss += __shfl_xor(ss, 2); ss += __shfl_xor(ss, 4);
        const float rinv = 1.f / sqrtf(ss * (1.f / 128.f) + EPS);
        unsigned o[8];
#pragma unroll
        for (int i = 0; i < 8; ++i) o[i] = pk2(x[2 * i] * rinv * nw[2 * i] * bflo(gu[i]), x[2 * i + 1] * rinv * nw[2 * i + 1] * bfhi(gu[i]));
        v4u* po = (v4u*)(AO + (size_t)t * D + 16 * lane); po[0] = (v4u){o[0], o[1], o[2], o[3]}; po[1] = (v4u){o[4], o[5], o[6], o[7]};
    }
}

struct EpiResid {
    static constexpr bool PERM = false, AFTER_DRAIN = false;
    const float* X; const float* MOD; float* H;
    __device__ __forceinline__ void operator()(const f32x4 (&acc)[2][2][4][2], const pg8::Unit& u, int wr, int wc, int fr, int fq) const {
        const int row0 = u.pm * 256 + wr * 64 + fr, col0 = u.pn * 256 + wc * 32 + 4 * fq; const int b = (u.pm * 256) >> 11;
        f32x4 g[2][2];
#pragma unroll
        for (int bj = 0; bj < 2; ++bj)
#pragma unroll
            for (int n = 0; n < 2; ++n) g[bj][n] = *(const f32x4*)(MOD + b * 6144 + 2048 + col0 + bj * 128 + n * 16);
#pragma unroll
        for (int ai = 0; ai < 2; ++ai)
#pragma unroll
            for (int m = 0; m < 4; ++m) { const size_t off = (size_t)(row0 + ai * 128 + m * 16) * D + col0;
#pragma unroll
                for (int bj = 0; bj < 2; ++bj)
#pragma unroll
                    for (int n = 0; n < 2; ++n) { const f32x4 xv = *(const f32x4*)(X + off + bj * 128 + n * 16); *(f32x4*)(H + off + bj * 128 + n * 16) = xv + g[bj][n] * acc[ai][bj][m][n]; } }
    }
};

__device__ __forceinline__ void p6_router(Frame& F) {
    LAS float* Wl = (LAS float*)(F.lds + SCR_OFF);
    LAS int* le = (LAS int*)(F.lds + SCR_OFF + 131072);
    LAS int* lp = le + 256;
    LAS float* lgt = (LAS float*)(lp + 256);
    LAS int* lcnt = (LAS int*)(F.lds + L_LCNT); LAS int* gbase = (LAS int*)(F.lds + L_GBASE);
    const int tid = F.tid, lane = F.lane, w = F.wave;
    const float* MOD = (const float*)(F.ws + WS_MOD); const float* H = (const float*)(F.ws + WS_H); bf16* VX = (bf16*)(F.ws + WS_VX);
    int* TOKE = (int*)(F.ws + WS_TOKE); int* TOKPOS = (int*)(F.ws + WS_TOKPOS); float* TOKGATE = (float*)(F.ws + WS_TOKGATE);
    for (int it = 0; it < 16; ++it) { const int idx = tid + 512 * it, k = idx >> 3, c = idx & 7; const f32x4 v = ((const f32x4*)F.in[IN_RW])[idx]; *(LAS f32x4*)(Wl + k * 32 + 4 * (c ^ (k & 7))) = v; }
    const float rb = F.in[IN_RB][lane >> 1];
    for (int tok0 = F.vcu * 64; tok0 < NX; tok0 += F.G * 64) {
        if (tid < 32) lcnt[tid] = 0;
        __syncthreads();
        const int b = tok0 >> 11;
        for (int pr = 0; pr < 4; ++pr) {
            const int tl = 8 * w + 2 * pr;
            float acc[2][32]; float rinv[2];
            const float* hr0 = H + (size_t)(tok0 + tl) * D + lane; const float* hr1 = hr0 + D;
#pragma unroll
            for (int tk = 0; tk < 2; ++tk) { const float* hr = tk ? hr1 : hr0; float ss = 0.f;
#pragma unroll
                for (int jj = 0; jj < 16; ++jj) { const float x = hr[64 * jj]; ss += x * x; }
                rinv[tk] = 1.f / sqrtf(wave_sum(ss) * (1.f / D) + EPS);
#pragma unroll
                for (int e = 0; e < 32; ++e) acc[tk][e] = 0.f; }
#pragma unroll 1
            for (int jj = 0; jj < 16; ++jj) { const int k = lane + 64 * jj;
                const float cm = F.in[IN_NFFN][k] * (1.f + MOD[b * 6144 + 4096 + k]), sh = MOD[b * 6144 + 3072 + k];
                const float v0 = hr0[64 * jj] * rinv[0] * cm + sh, v1 = hr1[64 * jj] * rinv[1] * cm + sh;
                VX[(size_t)(tok0 + tl) * D + k] = (bf16)f2bf(v0); VX[(size_t)(tok0 + tl + 1) * D + k] = (bf16)f2bf(v1);
#pragma unroll
                for (int c = 0; c < 8; ++c) { const f32x4 w4 = *(const LAS f32x4*)(Wl + k * 32 + 4 * (c ^ (k & 7)));
#pragma unroll
                    for (int i = 0; i < 4; ++i) { acc[0][4 * c + i] += v0 * w4[i]; acc[1][4 * c + i] += v1 * w4[i]; } } }
#pragma unroll
            for (int tk = 0; tk < 2; ++tk) {
#pragma unroll
                for (int st = 0; st < 5; ++st) { const int off = 32 >> st, half = 16 >> st; const bool up = (lane & off) != 0;
#pragma unroll
                    for (int i = 0; i < half; ++i) { const float a = acc[tk][i], bb = acc[tk][i + half]; const float send = up ? a : bb, keep = up ? bb : a; acc[tk][i] = keep + __shfl_xor(send, off); } }
                float logit = acc[tk][0] + __shfl_xor(acc[tk][0], 1) + rb;
                const int myE = lane >> 1;
                float tv[4]; int ti[4];
#pragma unroll
                for (int r = 0; r < 4; ++r) { float bv = logit; int bi = myE;
#pragma unroll
                    for (int o = 1; o < 64; o <<= 1) { const float pv = __shfl_xor(bv, o); const int pi = __shfl_xor(bi, o); if (pv > bv || (pv == bv && pi < bi)) { bv = pv; bi = pi; } }
                    tv[r] = bv; ti[r] = bi; if (myE == bi) logit = -INFINITY; }
                const float e1 = __expf(tv[1] - tv[0]), e2 = __expf(tv[2] - tv[0]), e3 = __expf(tv[3] - tv[0]); const float inv = 1.f / (1.f + e1 + e2 + e3);
                if (lane == 0) { const float gg[4] = {inv, e1 * inv, e2 * inv, e3 * inv};
#pragma unroll
                    for (int r = 0; r < 4; ++r) { le[(tl + tk) * 4 + r] = ti[r]; lgt[(tl + tk) * 4 + r] = gg[r]; lp[(tl + tk) * 4 + r] = __hip_atomic_fetch_add(lcnt + ti[r], 1, __ATOMIC_RELAXED, __HIP_MEMORY_SCOPE_WORKGROUP); } }
            }
        }
        __syncthreads();
        if (tid < 32) gbase[tid] = (int)__hip_atomic_fetch_add((unsigned*)(F.ctl + CW_CNT + tid), (unsigned)lcnt[tid], RLX_AGENT);
        __syncthreads();
        if (tid < 256) { const int e = le[tid]; TOKE[tok0 * 4 + tid] = e; TOKPOS[tok0 * 4 + tid] = gbase[e] + lp[tid]; TOKGATE[tok0 * 4 + tid] = lgt[tid]; }
        __syncthreads();
    }
}

__device__ __forceinline__ void moe_tables(Frame& F) {
    LAS int* TS = (LAS int*)(F.lds + L_TSTART); LAS int* TE = (LAS int*)(F.lds + L_TILEE);
    if (F.wave == 0) {
        const int e = F.lane; int nt = 0;
        if (e < 32) { const int c = (int)__hip_atomic_load((unsigned*)(F.ctl + CW_CNT + e), RLX_AGENT); nt = (c + 255) >> 8; }
        int incl = nt;
#pragma unroll
        for (int o = 1; o < 32; o <<= 1) { const int y = __shfl_up(incl, o); if ((F.lane & 31) >= o) incl += y; }
        const int st = incl - nt;
        if (e < 32) { TS[e] = st; for (int i = 0; i < nt; ++i) TE[st + i] = e; if (e == 31) TS[32] = incl; }
    }
    __syncthreads();
}
__device__ __forceinline__ void p7_gather(Frame& F) {
    moe_tables(F);
    const LAS int* TS = (const LAS int*)(F.lds + L_TSTART);
    const int gw = F.vcu * NWAVES + F.wave, NGW = F.G * NWAVES;
    const int* TOKE = (const int*)(F.ws + WS_TOKE); const int* TOKPOS = (const int*)(F.ws + WS_TOKPOS); const float* TOKGATE = (const float*)(F.ws + WS_TOKGATE);
    int* TOKROW = (int*)(F.ws + WS_TOKROW); float* ROWGATE = (float*)(F.ws + WS_ROWGATE);
    const bf16* VX = (const bf16*)(F.ws + WS_VX); bf16* XG = (bf16*)(F.ws + WS_XG);
    for (int item = gw; item < NX * TOPK; item += NGW) {
        const int e = TOKE[item], pos = TOKPOS[item]; const int row = 256 * TS[e] + pos; const int t = item >> 2;
        const v4u* src = (const v4u*)(VX + (size_t)t * D) + F.lane; v4u* dst = (v4u*)(XG + (size_t)row * D) + F.lane;
        const v4u a = src[0], b2 = src[64]; dst[0] = a; dst[64] = b2;
        if (F.lane == 0) { ROWGATE[row] = TOKGATE[item]; TOKROW[item] = row; }
    }
}
struct MoeOrder {
    int G, c, nct; const LAS int* TS; const LAS int* TE;
    __device__ __forceinline__ bool next(int i, pg8::Unit& u) const {
        const int L = i * G + c; const int NT = TS[32];
        if (L >= NT * nct) return false;
        const int rt = L / nct, ct = L - rt * nct; const int e = TE[rt];
        u.pm = __builtin_amdgcn_readfirstlane(rt); u.pn = __builtin_amdgcn_readfirstlane(e * nct + ct); return true;
    }
    __device__ __forceinline__ void a_ready(const pg8::Unit&) const {}
    __device__ __forceinline__ void done(const pg8::Unit&) const {}
};
struct EpiGlu {
    static constexpr bool PERM = true, AFTER_DRAIN = false;
    bf16* ACT; const float* B1;
    __device__ __forceinline__ void operator()(const f32x4 (&acc)[2][2][4][2], const pg8::Unit& u, int wr, int wc, int fr, int fq) const {
        const int e = u.pn >> 3, ct = u.pn & 7; const int row0 = u.pm * 256 + wr * 64 + fr; const int cb = wc * 32 + 8 * fq;
        f32x4 bg[2], bl[2];
#pragma unroll
        for (int n = 0; n < 2; ++n) { bg[n] = *(const f32x4*)(B1 + e * 2048 + 128 * ct + cb + 4 * n); bl[n] = *(const f32x4*)(B1 + e * 2048 + 1024 + 128 * ct + cb + 4 * n); }
#pragma unroll
        for (int ai = 0; ai < 2; ++ai)
#pragma unroll
            for (int m = 0; m < 4; ++m) { const int r = row0 + ai * 128 + m * 16; unsigned o[4];
#pragma unroll
                for (int n = 0; n < 2; ++n) { float a[4];
#pragma unroll
                    for (int i = 0; i < 4; ++i) { const float xg = fminf(acc[ai][0][m][n][i] + bg[n][i], 7.f); const float xl = fminf(fmaxf(acc[ai][1][m][n][i] + bl[n][i], -7.f), 7.f);
                        a[i] = xg * sigmoidf_(1.702f * xg) * (xl + 1.f); }
                    o[2 * n] = pk2(a[0], a[1]); o[2 * n + 1] = pk2(a[2], a[3]); }
                *(v4u*)(ACT + (size_t)r * DFF + 128 * ct + cb) = (v4u){o[0], o[1], o[2], o[3]}; }
    }
};
struct EpiDown {
    static constexpr bool PERM = true, AFTER_DRAIN = false;
    bf16* YB; const float* B2; const float* ROWGATE;
    __device__ __forceinline__ void operator()(const f32x4 (&acc)[2][2][4][2], const pg8::Unit& u, int wr, int wc, int fr, int fq) const {
        const int e = u.pn >> 2, ct = u.pn & 3; const int row0 = u.pm * 256 + wr * 64 + fr; const int cb = 256 * ct + wc * 32 + 8 * fq;
        f32x4 bv[2][2];
#pragma unroll
        for (int bj = 0; bj < 2; ++bj)
#pragma unroll
            for (int n = 0; n < 2; ++n) bv[bj][n] = *(const f32x4*)(B2 + e * 1024 + cb + 128 * bj + 4 * n);
#pragma unroll
        for (int ai = 0; ai < 2; ++ai)
#pragma unroll
            for (int m = 0; m < 4; ++m) { const int r = row0 + ai * 128 + m * 16; const float gt = ROWGATE[r];
#pragma unroll
                for (int bj = 0; bj < 2; ++bj) { const f32x4 v0 = (acc[ai][bj][m][0] + bv[bj][0]) * gt, v1 = (acc[ai][bj][m][1] + bv[bj][1]) * gt;
                    *(v4u*)(YB + (size_t)r * D + cb + 128 * bj) = (v4u){pk2(v0[0], v0[1]), pk2(v0[2], v0[3]), pk2(v1[0], v1[1]), pk2(v1[2], v1[3])}; } }
    }
};
__device__ __forceinline__ void p10_final(Frame& F) {
    const int gw = F.vcu * NWAVES + F.wave, NGW = F.G * NWAVES;
    const float* MOD = (const float*)(F.ws + WS_MOD); const float* H = (const float*)(F.ws + WS_H); const bf16* YB = (const bf16*)(F.ws + WS_YB); const int* TOKROW = (const int*)(F.ws + WS_TOKROW);
    for (int t = gw; t < NX; t += NGW) {
        const int b = t >> 11; int rows[4];
#pragma unroll
        for (int k = 0; k < 4; ++k) rows[k] = TOKROW[t * 4 + k];
        f32x4 hv[4]; float ss = 0.f;
#pragma unroll
        for (int j = 0; j < 4; ++j) { const int k0 = 4 * F.lane + 256 * j; f32x4 y = (f32x4){0.f, 0.f, 0.f, 0.f};
#pragma unroll
            for (int k = 0; k < 4; ++k) { const v2u yy = *(const v2u*)(YB + (size_t)rows[k] * D + k0); y += (f32x4){bflo(yy.x), bfhi(yy.x), bflo(yy.y), bfhi(yy.y)}; }
            const f32x4 h4 = *(const f32x4*)(H + (size_t)t * D + k0), g2 = *(const f32x4*)(MOD + b * 6144 + 5120 + k0);
            hv[j] = h4 + g2 * y; ss += (hv[j].x * hv[j].x + hv[j].y * hv[j].y) + (hv[j].z * hv[j].z + hv[j].w * hv[j].w); }
        const float rinv = 1.f / sqrtf(wave_sum(ss) * (1.f / D) + EPS);
#pragma unroll
        for (int j = 0; j < 4; ++j) { const int k0 = 4 * F.lane + 256 * j; const f32x4 nw = *(const f32x4*)(F.in[IN_NFIN] + k0); *(f32x4*)(F.out + (size_t)t * D + k0) = hv[j] * rinv * nw; }
    }
}

struct Args { const float* in[19]; float* out; unsigned char* ws; int ph_lo, ph_hi, li, pad; };
__global__ void __launch_bounds__(NWAVES * 64, 2) fwd_kernel(Args args) {
    extern __shared__ __attribute__((aligned(16))) unsigned char lds[];
    Frame F;
    F.lds = (LAS unsigned char*)lds;
    F.tid = threadIdx.x; F.lane = F.tid & 63; F.wave = __builtin_amdgcn_readfirstlane(F.tid >> 6);
    F.G = gridDim.x; { const int bx = blockIdx.x; F.vcu = (F.G % 8 == 0) ? (bx % 8) * (F.G / 8) + bx / 8 : bx; }
    F.ws = args.ws; F.ctl = (gu32*)(args.ws + WS_CTL); F.out = args.out;
#pragma unroll
    for (int i = 0; i < 19; ++i) F.in[i] = args.in[i];
    for (int u = F.tid; u < LCTL_BYTES / 4; u += NWAVES * 64) ((LAS unsigned*)F.lds)[u] = 0u;
    __syncthreads();
    XcdBarrier bar; bar.bar = (unsigned*)(F.ctl + CW_BAR); bar.x = 0; bar.st = nullptr;
    if (N_LAUNCHES == 1) bar = xcd_barrier_post((unsigned*)(F.ctl + CW_BAR), (volatile LAS unsigned*)(F.lds + L_MISC) + 8);
    const int lo = args.ph_lo, hi = args.ph_hi;
#ifndef PH_MASK
#define PH_MASK 0x7ff
#endif
#define IN(k) (((PH_MASK >> (k)) & 1) && lo <= (k) && (k) < hi)
#define SEAM(k) do { if (IN(k) && IN((k) + 1)) xcd_barrier(bar); } while (0)
    LAS unsigned char* ring = F.lds + SCR_OFF;
    if (IN(0)) { p0_prologue(F); SEAM(0); }
    if (IN(1)) { p1_xn(F); SEAM(1); }
    if (IN(2)) {
        pg8::Gemm g{(const bf16*)(F.ws + WS_XN), (const bf16*)(F.ws + WS_WIN), NROWS, PW, D};
        InProjOrder S{F.G, (int)blockIdx.x};
        EpiInProj E{(bf16*)(F.ws + WS_P), (const float*)(F.ws + WS_LB), (const float*)(F.ws + WS_COS), (const float*)(F.ws + WS_SIN)};
        pg8::gemm_phase<EpiInProj, InProjOrder, true, true>(ring, g, S, E);
        SEAM(2);
    }
    if (IN(3)) { p3_scan(F); SEAM(3); }
    if (IN(4)) { p4_merge(F); SEAM(4); }
    if (IN(5)) {
        pg8::Gemm g{(const bf16*)(F.ws + WS_AO), (const bf16*)(F.ws + WS_WOUT), NX, D, D};
        pg8::StaticOrder S; S.init(NX, D, F.G, (int)blockIdx.x);
        EpiResid E{F.in[IN_X], (const float*)(F.ws + WS_MOD), (float*)(F.ws + WS_H)};
        pg8::gemm_phase<EpiResid, pg8::StaticOrder, true, true>(ring, g, S, E);
        SEAM(5);
    }
    if (IN(6)) { p6_router(F); SEAM(6); }
    if (IN(7)) { p7_gather(F); SEAM(7); }
    if (IN(8)) {
        moe_tables(F);
        pg8::Gemm g{(const bf16*)(F.ws + WS_XG), (const bf16*)(F.ws + WS_W1), MAXRT * 256, NEXP * 2048, D};
        MoeOrder S{F.G, (int)blockIdx.x, 8, (const LAS int*)(F.lds + L_TSTART), (const LAS int*)(F.lds + L_TILEE)};
        EpiGlu E{(bf16*)(F.ws + WS_ACT), F.in[IN_B1]};
        pg8::gemm_phase<EpiGlu, MoeOrder, true, true>(ring, g, S, E);
        SEAM(8);
    }
    if (IN(9)) {
        moe_tables(F);
        pg8::Gemm g{(const bf16*)(F.ws + WS_ACT), (const bf16*)(F.ws + WS_W2), MAXRT * 256, NEXP * 1024, DFF};
        MoeOrder S{F.G, (int)blockIdx.x, 4, (const LAS int*)(F.lds + L_TSTART), (const LAS int*)(F.lds + L_TILEE)};
        EpiDown E{(bf16*)(F.ws + WS_YB), F.in[IN_B2], (const float*)(F.ws + WS_ROWGATE)};
        pg8::gemm_phase<EpiDown, MoeOrder, true, true>(ring, g, S, E);
        SEAM(9);
    }
    if (IN(10)) { p10_final(F); }
#undef IN
#undef SEAM
}

extern "C" void kernel_launch(void* const* d_in, const int* in_sizes, int n_in, void* d_out, int out_size, void* d_ws, size_t ws_size, hipStream_t stream) {
    static int grid = 0;
    if (grid == 0) {
        if (n_in != 19 || in_sizes[0] != NX * D || out_size != NX * D || ws_size < WS_END) { fprintf(stderr, "kernel_launch: unexpected shapes (n_in %d, in0 %d, out %d, ws %zu; need ws >= %zu)\n", n_in, n_in > 0 ? in_sizes[0] : -1, out_size, ws_size, (size_t)WS_END); grid = -1; return; }
        int dev = 0, cus = 0, per_cu = 0;
        if (hipGetDevice(&dev) != hipSuccess || hipDeviceGetAttribute(&cus, hipDeviceAttributeMultiprocessorCount, dev) != hipSuccess) { fprintf(stderr, "kernel_launch: device query failed\n"); grid = -1; return; }
        if (hipFuncSetAttribute((const void*)fwd_kernel, hipFuncAttributeMaxDynamicSharedMemorySize, LDS_BYTES) != hipSuccess) { fprintf(stderr, "kernel_launch: hipFuncSetAttribute failed\n"); grid = -1; return; }
        if (hipOccupancyMaxActiveBlocksPerMultiprocessor(&per_cu, (const void*)fwd_kernel, NWAVES * 64, LDS_BYTES) != hipSuccess || per_cu < 1)
            fprintf(stderr, "kernel_launch: note: occupancy query reports %d workgroups per CU\n", per_cu);
        (void)hipGetLastError();
        grid = cus;
    }
    if (grid < 0) return;
    if (hipMemsetAsync((char*)d_ws + WS_CTL, 0, CTL_ZERO_BYTES, stream) != hipSuccess) { fprintf(stderr, "kernel_launch: hipMemsetAsync failed\n"); return; }
    Args a{};
    for (int i = 0; i < 19; ++i) a.in[i] = (const float*)d_in[i];
    a.out = (float*)d_out; a.ws = (unsigned char*)d_ws;
    for (int li = 0; li < N_LAUNCHES; ++li) {
        a.ph_lo = (N_LAUNCHES == 1) ? 0 : li; a.ph_hi = (N_LAUNCHES == 1) ? NPHASE : li + 1; a.li = li;
        hipLaunchKernelGGL(fwd_kernel, dim3(grid), dim3(NWAVES * 64), LDS_BYTES, stream, a);
        const hipError_t le = hipPeekAtLastError();
        if (le != hipSuccess) { fprintf(stderr, "kernel_launch: launch %d failed: %s\n", li, hipGetErrorName(le)); break; }
    }
}
```

```cpp
#include <hip/hip_runtime.h>
#include <cstdio>
#include <cstdint>
namespace pg8 {
#define PG8_LAS __attribute__((address_space(3)))
typedef unsigned short bf16_t;
typedef short bf16x8 __attribute__((ext_vector_type(8)));
typedef float f32x4 __attribute__((ext_vector_type(4)));
typedef unsigned u32x4 __attribute__((ext_vector_type(4)));
constexpr int BM = 256, BK = 64, HALF = 128, HTB = HALF * BK * 2  , STAGE_BYTES = 8 * HTB, NXCD = 8, WGM = 8;

__host__ __device__ __forceinline__ int lds_byte(int r, int c) { const int st = (r >> 4) * 2 + (c >> 5), rr = r & 15, cc = c & 31, ob = rr * 64 + cc * 2; return st * 1024 + (ob ^ (((ob >> 9) & 1) << 5)); }
__host__ __device__ __forceinline__ void stage_rc(int b, int& R, int& C) { const int st = b / 1024, sb = b % 1024, swz = sb ^ (((sb >> 9) & 1) << 5); R = (st >> 1) * 16 + swz / 64; C = (st & 1) * 32 + (swz % 64) / 2; }
__host__ __device__ __forceinline__ int perm32(int rho) { const int n = rho >> 4, i = rho & 15; return 8 * (i >> 2) + 4 * n + (i & 3); }

struct Unit { int pm, pn; };
struct Gemm { const bf16_t* A; const bf16_t* Bt; int M, N, K; };

struct StaticOrder {
    int nM, nN, nwg, G, c;
    __host__ __device__ void init(int M, int N, int G_, int c_) { nM = M / BM; nN = N / BM; nwg = nM * nN; G = G_; c = c_; }
    __host__ __device__ bool next(int i, Unit& u) const {
        const long L = (long)i * G + c; if (L >= nwg) return false;
        int wgid = (int)L; { const int q = nwg / NXCD, r = nwg % NXCD, xcd = wgid % NXCD, off = wgid / NXCD; wgid = (xcd < r ? xcd * (q + 1) : r * (q + 1) + (xcd - r) * q) + off; }
        const int nig = WGM * nN, gid = wgid / nig, fm = gid * WGM, gsz = (nM - fm) < WGM ? (nM - fm) : WGM;
        u.pm = fm + ((wgid % nig) % gsz); u.pn = (wgid % nig) / gsz; return true;
    }
    __device__ __forceinline__ void a_ready(const Unit&) const {}
    __device__ __forceinline__ void done(const Unit&) const {}
};

template <class Epi, class Sched, bool ALIGN_EPI = false, bool SP2 = false>
__device__ __forceinline__ void gemm_phase(PG8_LAS unsigned char* lds, const Gemm g, const Sched& S, const Epi& E) {
    const int tid = threadIdx.x, wid = __builtin_amdgcn_readfirstlane(tid >> 6), lane = tid & 63, wr = wid >> 2, wc = wid & 3, fr = lane & 15, fq = lane >> 4;
    const int K = g.K, nt = K / BK;
    unsigned voffA[2], voffB[2];
#pragma unroll
    for (int i = 0; i < 2; ++i) { int R, C; stage_rc(tid * 16 + i * 8192, R, C); const int Rb = Epi::PERM ? ((R & ~31) + perm32(R & 31)) : R;
        voffA[i] = (unsigned)(R * K + C) * 2u; voffB[i] = (unsigned)(Rb * K + C) * 2u; }
    const size_t kstep = (size_t)(BK * 2);
    const size_t hstep = (size_t)HALF * K * 2;
    const size_t tstep = 2 * hstep;
    const unsigned ldsw = (unsigned)wid * 1024u;
    const int aoff = lds_byte(wr * 64 + fr, fq * 8), boff = lds_byte(wc * 32 + fr, fq * 8);
#define PG8_SA(b, h) (((b) * 2 + (h)) * HTB)
#define PG8_SB(b, h) ((4 + (b) * 2 + (h)) * HTB)
#define PG8_STAGE(bufoff, gbase, voff) do { _Pragma("unroll") for (int _i = 0; _i < 2; ++_i) \
        __builtin_amdgcn_global_load_lds((const unsigned*)((const char*)(gbase) + (voff)[_i]), (PG8_LAS unsigned*)(lds + (bufoff) + ldsw + _i * 8192), 16, 0, 0); } while (0)
#define PG8_LDA(dst, b, h) do { _Pragma("unroll") for (int m = 0; m < 4; ++m) _Pragma("unroll") for (int k = 0; k < 2; ++k) dst[m][k] = *(const PG8_LAS bf16x8*)(lds + PG8_SA(b, h) + aoff + m * 2048 + k * 1024); } while (0)
#define PG8_LDB(dst, b, h) do { _Pragma("unroll") for (int n = 0; n < 2; ++n) _Pragma("unroll") for (int k = 0; k < 2; ++k) dst[n][k] = *(const PG8_LAS bf16x8*)(lds + PG8_SB(b, h) + boff + n * 2048 + k * 1024); } while (0)
#define PG8_MMA(ai, bj, At, Bt) do { __builtin_amdgcn_s_setprio(1); _Pragma("unroll") for (int m = 0; m < 4; ++m) _Pragma("unroll") for (int n = 0; n < 2; ++n) _Pragma("unroll") for (int k = 0; k < 2; ++k) \
        acc[ai][bj][m][n] = __builtin_amdgcn_mfma_f32_16x16x32_bf16(Bt[n][k], At[m][k], acc[ai][bj][m][n], 0, 0, 0); __builtin_amdgcn_s_setprio(0); } while (0)
#define PG8_WAIT_V(n) asm volatile("s_waitcnt vmcnt(" #n ")" ::: "memory")
#define PG8_WAIT_L(n) asm volatile("s_waitcnt lgkmcnt(" #n ")" ::: "memory")
#define PG8_BAR __builtin_amdgcn_s_barrier()
#define PG8_SCHED __builtin_amdgcn_sched_barrier(0)
    Unit cur, nxt; int ui = 0;
    if (!S.next(0, cur)) return;
    f32x4 acc[2][2][4][2];
#pragma unroll
    for (int a = 0; a < 2; ++a)
#pragma unroll
        for (int b = 0; b < 2; ++b)
#pragma unroll
            for (int m = 0; m < 4; ++m)
#pragma unroll
                for (int n = 0; n < 2; ++n) acc[a][b][m][n] = (f32x4){0.f, 0.f, 0.f, 0.f};
    bf16x8 At[4][2], B0[2][2], B1[2][2];
    const char* cA = (const char*)g.A + (size_t)cur.pm * tstep; const char* cB = (const char*)g.Bt + (size_t)cur.pn * tstep;
    S.a_ready(cur);
    if constexpr (SP2) {
        PG8_STAGE(PG8_SB(0, 0), cB, voffB); PG8_STAGE(PG8_SB(0, 1), cB + hstep, voffB); PG8_STAGE(PG8_SA(0, 0), cA, voffA); PG8_STAGE(PG8_SA(0, 1), cA + hstep, voffA);
        if (wr == 1) PG8_BAR;
        PG8_WAIT_V(2); PG8_BAR;
        PG8_STAGE(PG8_SB(1, 0), cB + kstep, voffB); PG8_STAGE(PG8_SA(1, 0), cA + kstep, voffA); PG8_STAGE(PG8_SB(1, 1), cB + hstep + kstep, voffB);
        PG8_WAIT_V(6); PG8_BAR;
    } else {
        PG8_STAGE(PG8_SB(0, 0), cB, voffB); PG8_STAGE(PG8_SA(0, 0), cA, voffA); PG8_STAGE(PG8_SB(0, 1), cB + hstep, voffB); PG8_STAGE(PG8_SA(0, 1), cA + hstep, voffA);
        if (wr == 1) PG8_BAR;
        PG8_WAIT_V(4); PG8_BAR;
        PG8_STAGE(PG8_SB(1, 0), cB + kstep, voffB); PG8_STAGE(PG8_SA(1, 0), cA + kstep, voffA); PG8_STAGE(PG8_SB(1, 1), cB + hstep + kstep, voffB);
        PG8_WAIT_V(6); PG8_BAR;
    }
    for (;;) {
        const bool has_next = S.next(ui + 1, nxt);
        const char* nA = has_next ? (const char*)g.A + (size_t)nxt.pm * tstep : cA; const char* nB = has_next ? (const char*)g.Bt + (size_t)nxt.pn * tstep : cB;
        for (int t = 0; t < nt; t += 2) {
            const bool last = (t == nt - 2);
            const char* a1 = cA + (size_t)(t + 1) * kstep;
            const char* a2 = last ? nA : cA + (size_t)(t + 2) * kstep; const char* b2 = last ? nB : cB + (size_t)(t + 2) * kstep;
            const char* a3 = a2 + kstep; const char* b3 = b2 + kstep;
            if (last && has_next) S.a_ready(nxt);
            if constexpr (SP2) {
            PG8_LDB(B0, 0, 0); PG8_LDB(B1, 0, 1); PG8_SCHED; PG8_LDA(At, 0, 0); PG8_STAGE(PG8_SA(1, 1), a1 + hstep, voffA);
            PG8_WAIT_V(8); PG8_WAIT_L(0); PG8_BAR; PG8_MMA(0, 0, At, B0); PG8_MMA(0, 1, At, B1); PG8_BAR; PG8_SCHED;
            PG8_LDA(At, 0, 1); PG8_STAGE(PG8_SB(0, 0), b2, voffB); PG8_STAGE(PG8_SB(0, 1), b2 + hstep, voffB); PG8_STAGE(PG8_SA(0, 0), a2, voffA);
            PG8_WAIT_V(8); PG8_WAIT_L(0); PG8_BAR; PG8_MMA(1, 0, At, B0); PG8_MMA(1, 1, At, B1); PG8_BAR; PG8_SCHED;
            PG8_LDB(B0, 1, 0); PG8_LDB(B1, 1, 1); PG8_SCHED; PG8_LDA(At, 1, 0); PG8_STAGE(PG8_SA(0, 1), a2 + hstep, voffA);
            PG8_WAIT_V(8); PG8_WAIT_L(0); PG8_BAR; PG8_MMA(0, 0, At, B0); PG8_MMA(0, 1, At, B1); PG8_BAR; PG8_SCHED;
            PG8_LDA(At, 1, 1); PG8_STAGE(PG8_SB(1, 0), b3, voffB); PG8_STAGE(PG8_SB(1, 1), b3 + hstep, voffB); PG8_STAGE(PG8_SA(1, 0), a3, voffA);
            PG8_WAIT_V(8); PG8_WAIT_L(0); PG8_BAR; PG8_MMA(1, 0, At, B0); PG8_MMA(1, 1, At, B1); PG8_BAR; PG8_SCHED;
            } else {
            PG8_LDB(B0, 0, 0); PG8_SCHED; PG8_LDA(At, 0, 0); PG8_STAGE(PG8_SA(1, 1), a1 + hstep, voffA);
            PG8_WAIT_L(8); PG8_BAR; PG8_WAIT_L(0); PG8_MMA(0, 0, At, B0); PG8_BAR; PG8_SCHED;
            PG8_LDB(B1, 0, 1); PG8_STAGE(PG8_SB(0, 0), b2, voffB);
            PG8_BAR; PG8_WAIT_L(0); PG8_MMA(0, 1, At, B1); PG8_BAR;
            PG8_LDA(At, 0, 1); PG8_STAGE(PG8_SA(0, 0), a2, voffA);
            PG8_BAR; PG8_WAIT_L(0); PG8_MMA(1, 0, At, B0); PG8_BAR; PG8_SCHED;
            PG8_STAGE(PG8_SB(0, 1), b2 + hstep, voffB);
            PG8_WAIT_V(6); PG8_BAR; PG8_MMA(1, 1, At, B1); PG8_BAR;
            PG8_LDB(B0, 1, 0); PG8_SCHED; PG8_LDA(At, 1, 0); PG8_STAGE(PG8_SA(0, 1), a2 + hstep, voffA);
            PG8_WAIT_L(8); PG8_BAR; PG8_WAIT_L(0); PG8_MMA(0, 0, At, B0); PG8_BAR; PG8_SCHED;
            PG8_LDB(B1, 1, 1); PG8_STAGE(PG8_SB(1, 0), b3, voffB);
            PG8_BAR; PG8_WAIT_L(0); PG8_MMA(0, 1, At, B1); PG8_BAR;
            PG8_LDA(At, 1, 1); PG8_STAGE(PG8_SA(1, 0), a3, voffA);
            PG8_BAR; PG8_WAIT_L(0); PG8_MMA(1, 0, At, B0); PG8_BAR; PG8_SCHED;
            PG8_STAGE(PG8_SB(1, 1), b3 + hstep, voffB);
            PG8_WAIT_V(6); PG8_BAR; PG8_MMA(1, 1, At, B1); PG8_BAR;
            }
        }
        if constexpr (ALIGN_EPI) { if (wr == 0) PG8_BAR; }
        if constexpr (!Epi::AFTER_DRAIN) { E(acc, cur, wr, wc, fr, fq); S.done(cur); }
        if (!has_next) break;
#pragma unroll
        for (int a = 0; a < 2; ++a)
#pragma unroll
            for (int b = 0; b < 2; ++b)
#pragma unroll
                for (int m = 0; m < 4; ++m)
#pragma unroll
                    for (int n = 0; n < 2; ++n) acc[a][b][m][n] = (f32x4){0.f, 0.f, 0.f, 0.f};
        cur = nxt; cA = nA; cB = nB; ++ui;
        if constexpr (ALIGN_EPI) { if (wr == 1) PG8_BAR; }
    }
    PG8_WAIT_V(0);
    if constexpr (!ALIGN_EPI) { if (wr == 0) PG8_BAR; }
    PG8_BAR;
    if constexpr (Epi::AFTER_DRAIN) { E.fused(acc, cur, wr, wc, fr, fq, lds, wid, lane); S.done(cur); }
#undef PG8_SA
#undef PG8_SB
#undef PG8_STAGE
#undef PG8_LDA
#undef PG8_LDB
#undef PG8_MMA
#undef PG8_WAIT_V
#undef PG8_WAIT_L
#undef PG8_BAR
#undef PG8_SCHED
}
}

constexpr int NWAVES = 8;
constexpr int NPHASE = 11;
#ifndef MK_N_LAUNCHES
#define MK_N_LAUNCHES 1
#endif
constexpr int N_LAUNCHES = MK_N_LAUNCHES;

constexpr int D = 1024, BATCH = 8, SEQ = 2048, CTX = 256;
constexpr int NX = BATCH * SEQ, NC = BATCH * CTX, NROWS = NX + NC;
constexpr int PW = 4096;
constexpr int NEXP = 32, TOPK = 4, DFF = 1024;
constexpr int MAXRT = 288;
constexpr float EPS = 1e-6f;

constexpr size_t MiB = 1u << 20;
constexpr size_t WS_CTL = 0, CTL_ZERO_BYTES = 1 * MiB;
constexpr size_t WS_MOD = 1 * MiB;
constexpr size_t WS_LB = 1 * MiB + 512 * 1024;
constexpr size_t WS_COS = WS_LB + 4096, WS_SIN = WS_COS + 2048 * 32 * 4;
constexpr size_t WS_TOKE = 2 * MiB, WS_TOKPOS = WS_TOKE + 256 * 1024, WS_TOKGATE = WS_TOKPOS + 256 * 1024, WS_TOKROW = WS_TOKGATE + 256 * 1024, WS_ROWGATE = WS_TOKROW + 256 * 1024;
constexpr size_t WS_WIN = 4 * MiB, WS_WOUT = 12 * MiB, WS_W1 = 14 * MiB, WS_W2 = 142 * MiB;
constexpr size_t WS_XN = 206 * MiB, WS_P = 242 * MiB, WS_XG = WS_P, WS_OF = 386 * MiB, WS_OB = 418 * MiB, WS_AO = 450 * MiB;
constexpr size_t WS_H = 482 * MiB, WS_VX = 546 * MiB, WS_ACT = 578 * MiB, WS_YB = 722 * MiB, WS_END = 866 * MiB;
constexpr int CW_TMO = 0, CW_CODE = 1, CW_BAR = 4096, CW_CNT = 8192;

constexpr int LCTL_BYTES = 2048, SCR_OFF = LCTL_BYTES, LDS_BYTES = 147456;
constexpr int L_MISC = 0;
constexpr int L_TSTART = 128;
constexpr int L_TILEE = 384;
constexpr int L_LCNT = 1600;
constexpr int L_GBASE = 1728;

#define GAS __attribute__((address_space(1)))
#define LAS __attribute__((address_space(3)))
typedef unsigned short bf16;
typedef unsigned v4u __attribute__((ext_vector_type(4)));
typedef unsigned v2u __attribute__((ext_vector_type(2)));
typedef float f32x4 __attribute__((ext_vector_type(4)));
typedef float f32x2 __attribute__((ext_vector_type(2)));
typedef short bf16x8 __attribute__((ext_vector_type(8)));
typedef GAS unsigned gu32;
#define RLX_AGENT __ATOMIC_RELAXED, __HIP_MEMORY_SCOPE_AGENT
#define LDS_WAIT() asm volatile("s_waitcnt lgkmcnt(0)" ::: "memory")
#define VM_WAIT() asm volatile("s_waitcnt vmcnt(0)" ::: "memory")
#define LBAR() do { asm volatile("s_waitcnt lgkmcnt(0)" ::: "memory"); __builtin_amdgcn_s_barrier(); asm volatile("" ::: "memory"); } while (0)
__device__ __forceinline__ unsigned f2bf(float f) { unsigned u = __builtin_bit_cast(unsigned, f); return (u + 0x7fffu + ((u >> 16) & 1u)) >> 16; }
__device__ __forceinline__ unsigned pk2(float lo, float hi) { return f2bf(lo) | (f2bf(hi) << 16); }
__device__ __forceinline__ float bflo(unsigned u) { return __builtin_bit_cast(float, u << 16); }
__device__ __forceinline__ float bfhi(unsigned u) { return __builtin_bit_cast(float, u & 0xffff0000u); }
__device__ __forceinline__ float wave_sum(float v) {
#pragma unroll
    for (int o = 1; o < 64; o <<= 1) v += __shfl_xor(v, o);
    return v;
}
__device__ __forceinline__ float sigmoidf_(float x) { return 1.f / (1.f + __expf(-x)); }
__device__ __forceinline__ float siluf_(float x) { return x / (1.f + __expf(-x)); }

#define XB_TMO      128
#define XB_XCNT(j)  (256  + 64 * (j))
#define XB_XSUB(j)  (1280 + 64 * (j))
#define XB_XGEN(j)  (2304 + 64 * (j))
#define XB_TOP      3328
#define XB_TOPGEN   3392
#define XCD_BAR_WORDS 3456
#define XB_SPIN_CAP (1u << 18)

__device__ __forceinline__ unsigned xb_ld(unsigned* p)              { return __hip_atomic_load(p, __ATOMIC_RELAXED, __HIP_MEMORY_SCOPE_AGENT); }
__device__ __forceinline__ unsigned xb_add(unsigned* p, unsigned v) { return __hip_atomic_fetch_add(p, v, __ATOMIC_RELAXED, __HIP_MEMORY_SCOPE_AGENT); }
__device__ __forceinline__ unsigned xb_xcc_id() { return (unsigned)__builtin_amdgcn_s_getreg((3 << 11) | 20) & 0xFu; }
#define XB_SPIN(cond, bar) do { unsigned _sp = 0; while (cond) { __builtin_amdgcn_s_sleep(1); \
    if ((++_sp & 255u) == 0u) { if (xb_ld(&(bar)[XB_TMO])) break; if (_sp > XB_SPIN_CAP) { atomicAdd(&(bar)[XB_TMO], 1u); break; } } } } while (0)

struct XcdBarrier {
    unsigned* bar; unsigned x;
    volatile LAS unsigned* st;
};

__device__ __forceinline__ XcdBarrier xcd_barrier_post(unsigned* bar, volatile LAS unsigned* st) {
    XcdBarrier b; b.bar = bar; b.x = xb_xcc_id(); b.st = st;
    if (threadIdx.x == 0) (void)xb_add(&bar[XB_XCNT(b.x)], 1u);
    return b;
}
__device__ __forceinline__ void xcd_barrier_complete(unsigned* bar, unsigned x, unsigned& nloc, unsigned& nx) {
    const unsigned G = gridDim.x * gridDim.y * gridDim.z;
    unsigned sum, cnt, mine, sp = 0u;
    for (;;) {
        sum = 0u; cnt = 0u; mine = 0u;
#pragma unroll
        for (unsigned j = 0; j < 16; ++j) { const unsigned c = xb_ld(&bar[XB_XCNT(j)]); sum += c; cnt += (c > 0u) ? 1u : 0u; mine = (j == x) ? c : mine; }
        if (sum == G) break;
        __builtin_amdgcn_s_sleep(1);
        if ((++sp & 255u) == 0u) { if (xb_ld(&bar[XB_TMO])) break; if (sp > XB_SPIN_CAP) { atomicAdd(&bar[XB_TMO], 1u); break; } }
    }
    nloc = mine > 0u ? mine : 1u; nx = cnt > 0u ? cnt : 1u;
}

__device__ __forceinline__ void xcd_barrier(const XcdBarrier& b) {
    asm volatile("s_waitcnt vmcnt(0)" ::: "memory");
    __syncthreads();
    if (threadIdx.x == 0) {
        unsigned* bar = b.bar;
        __builtin_amdgcn_s_waitcnt(0);
        unsigned nloc = b.st[0], nx = b.st[1];
        if (nloc == 0u) { xcd_barrier_complete(bar, b.x, nloc, nx); b.st[0] = nloc; b.st[1] = nx; }
        const unsigned old = xb_add(&bar[XB_XSUB(b.x)], 1u);
        const unsigned gen = old / nloc;
        if (old + 1u == (gen + 1u) * nloc) {
            __builtin_amdgcn_fence(__ATOMIC_RELEASE, "agent");
            asm volatile("s_waitcnt vmcnt(0)" ::: "memory");
            const unsigned og = xb_add(&bar[XB_TOP], 1u);
            const unsigned tg = og / nx;
            if (og + 1u == (tg + 1u) * nx) xb_add(&bar[XB_TOPGEN], 1u);
            else XB_SPIN(xb_ld(&bar[XB_TOPGEN]) == tg, bar);
            __builtin_amdgcn_fence(__ATOMIC_ACQUIRE, "agent");
            xb_add(&bar[XB_XGEN(b.x)], 1u);
            asm volatile("s_waitcnt vmcnt(0)" ::: "memory");
        } else {
            XB_SPIN(xb_ld(&bar[XB_XGEN(b.x)]) == gen, bar);
            __builtin_amdgcn_fence(__ATOMIC_ACQUIRE, "agent");
            asm volatile("s_waitcnt vmcnt(0)" ::: "memory");
        }
    }
    __syncthreads();
}


struct Frame {
    LAS unsigned char* lds;
    gu32* ctl;
    int tid, lane, wave, vcu, G;
    const float* in[19];
    float* out;
    unsigned char* ws;
};
#define IN_X 0
#define IN_C 1
#define IN_CTX 2
#define IN_CCTX 3
#define IN_WADA 4
#define IN_BADA 5
#define IN_NMIX 6
#define IN_NFFN 7
#define IN_WIN 8
#define IN_WOUT 9
#define IN_HGLB 10
#define IN_HGNW 11
#define IN_RW 12
#define IN_RB 13
#define IN_W1 14
#define IN_B1 15
#define IN_W2 16
#define IN_B2 17
#define IN_NFIN 18

struct TItem { const float* src; bf16* dst; int ldw, kind, n0, k0; };
__device__ __forceinline__ int t_prow(int kind, int n) {
    if (kind == 1) { if (n < 512) { const int l = n & 255; return (n & ~255) + 128 * ((l >> 5) & 1) + 32 * (l >> 6) + (l & 31); } return n; }
    if (kind == 2) { const int half = n >> 10, r = n & 1023; return 256 * (r >> 7) + 128 * half + (r & 127); }
    return n;
}
__device__ __forceinline__ bool t_decode(const Frame& F, int it, TItem& T) {
    constexpr int I_IN = 16 * 64, I_OUT = 16 * 16, I_W1 = 32 * 16 * 32, I_W2 = 32 * 16 * 16, NITEMS = I_IN + I_OUT + I_W1 + I_W2;
    if (it >= NITEMS) return false;
    int r = it;
    if (r < I_IN) { T.src = F.in[IN_WIN]; T.dst = (bf16*)(F.ws + WS_WIN); T.ldw = PW; T.kind = 1; T.k0 = (r & 15) * 64; T.n0 = (r >> 4) * 64; return true; }
    r -= I_IN;
    if (r < I_OUT) { T.src = F.in[IN_WOUT]; T.dst = (bf16*)(F.ws + WS_WOUT); T.ldw = D; T.kind = 0; T.k0 = (r & 15) * 64; T.n0 = (r >> 4) * 64; return true; }
    r -= I_OUT;
    if (r < I_W1) { const int e = r >> 9, q = r & 511; T.src = F.in[IN_W1] + (size_t)e * 1024 * 2048; T.dst = (bf16*)(F.ws + WS_W1) + (size_t)e * 2048 * 1024; T.ldw = 2048; T.kind = 2; T.k0 = (q & 15) * 64; T.n0 = (q >> 4) * 64; return true; }
    r -= I_W1;
    { const int e = r >> 8, q = r & 255; T.src = F.in[IN_W2] + (size_t)e * 1024 * 1024; T.dst = (bf16*)(F.ws + WS_W2) + (size_t)e * 1024 * 1024; T.ldw = 1024; T.kind = 0; T.k0 = (q & 15) * 64; T.n0 = (q >> 4) * 64; return true; }
}
__device__ __forceinline__ void t_load(const TItem& T, float (&v)[64], int lane) {
    const float* s = T.src + (size_t)T.k0 * T.ldw + T.n0 + lane;
#pragma unroll
    for (int i = 0; i < 64; ++i) v[i] = s[(size_t)i * T.ldw];
}
__device__ __forceinline__ void t_store(const TItem& T, const float (&v)[64], LAS float* scr, int lane) {
#pragma unroll
    for (int i = 0; i < 64; ++i) scr[i * 65 + lane] = v[i];
    LDS_WAIT(); asm volatile("" ::: "memory");
    const int c = lane & 7;
#pragma unroll
    for (int j = 0; j < 8; ++j) { const int n = (lane >> 3) + 8 * j; const LAS float* s = scr + (8 * c) * 65 + n;
        v4u o; o.x = pk2(s[0 * 65], s[1 * 65]); o.y = pk2(s[2 * 65], s[3 * 65]); o.z = pk2(s[4 * 65], s[5 * 65]); o.w = pk2(s[6 * 65], s[7 * 65]);
        *(GAS v4u*)(T.dst + (size_t)t_prow(T.kind, T.n0 + n) * 1024 + T.k0 + 8 * c) = o; }
    LDS_WAIT(); asm volatile("" ::: "memory");
}
__device__ __forceinline__ void p0_prologue(Frame& F) {
    const int gw = F.vcu * NWAVES + F.wave, NGW = F.G * NWAVES;
    float* MOD = (float*)(F.ws + WS_MOD);
    for (int cg = F.vcu; cg < 96; cg += F.G) {
        LAS float* sl = (LAS float*)(F.lds + SCR_OFF);
        LAS float* red = sl + 9 * 1024;
        for (int i = F.tid; i < 9 * 1024; i += NWAVES * 64) { const int b = i >> 10, k = i & 1023; const float cv = b < 8 ? F.in[IN_C][b * 1024 + k] : F.in[IN_CCTX][k]; sl[i] = siluf_(cv); }
        __syncthreads();
        const int j = 64 * cg + F.lane; const int kb = 128 * F.wave;
        const float* wa = F.in[IN_WADA] + (size_t)kb * 6144 + j;
        float acc[9];
#pragma unroll
        for (int b = 0; b < 9; ++b) acc[b] = 0.f;
#pragma unroll 1
        for (int k = 0; k < 128; k += 32) {
            float w[32];
#pragma unroll
            for (int i = 0; i < 32; ++i) w[i] = wa[(size_t)(k + i) * 6144];
#pragma unroll
            for (int b = 0; b < 9; ++b)
#pragma unroll
                for (int i = 0; i < 32; i += 4) { const f32x4 s0 = *(const LAS f32x4*)(sl + b * 1024 + kb + k + i); acc[b] += s0[0] * w[i] + s0[1] * w[i + 1] + s0[2] * w[i + 2] + s0[3] * w[i + 3]; }
        }
#pragma unroll
        for (int b = 0; b < 9; ++b) red[(F.wave * 9 + b) * 64 + F.lane] = acc[b];
        __syncthreads();
        for (int i = F.tid; i < 9 * 64; i += NWAVES * 64) { const int b = i >> 6, l = i & 63; float s = F.in[IN_BADA][64 * cg + l];
#pragma unroll
            for (int w8 = 0; w8 < 8; ++w8) s += red[(w8 * 9 + b) * 64 + l];
            MOD[b * 6144 + 64 * cg + l] = s; }
        __syncthreads();
    }
    if (F.vcu == F.G - 1) {
        float* LB = (float*)(F.ws + WS_LB); float* COS = (float*)(F.ws + WS_COS); float* SIN = (float*)(F.ws + WS_SIN);
        for (int i = F.tid; i < 1024; i += NWAVES * 64) { const float a0 = F.in[IN_HGLB][i], a1 = F.in[IN_HGLB][1024 + i]; LB[i] = 1.f / (1.f + expf(a1 - a0)); }
        for (int i = F.tid; i < 2048 * 32; i += NWAVES * 64) { const int n = i >> 5, j = i & 31, fi = j & 15; const float pos = (float)(j < 16 ? (n >> 6) : (n & 63));
            const float inv = powf(10000.f, -(float)fi / 16.f); const float ang = pos * inv; COS[i] = cosf(ang); SIN[i] = sinf(ang); }
    }
    LAS float* scr = (LAS float*)(F.lds + SCR_OFF + F.wave * 16640);
    int it = NGW - 1 - gw; TItem cur, nxt; float va[64], vb[64];
    bool has = t_decode(F, it, cur);
    if (has) t_load(cur, va, F.lane);
    while (has) {
        it += NGW; const bool hn = t_decode(F, it, nxt);
        if (hn) t_load(nxt, vb, F.lane);
        t_store(cur, va, scr, F.lane);
        has = hn; if (!has) break;
        cur = nxt;
        it += NGW; const bool hn2 = t_decode(F, it, nxt);
        if (hn2) t_load(nxt, va, F.lane);
        t_store(cur, vb, scr, F.lane);
        has = hn2; cur = nxt;
    }
}

__device__ __forceinline__ void p1_xn(Frame& F) {
    const int gw = F.vcu * NWAVES + F.wave, NGW = F.G * NWAVES;
    const float* MOD = (const float*)(F.ws + WS_MOD); bf16* XN = (bf16*)(F.ws + WS_XN);
    for (int m = gw; m < NROWS; m += NGW) {
        const float* src = m < NX ? F.in[IN_X] + (size_t)m * D : F.in[IN_CTX] + (size_t)(m - NX) * D; const int b = m < NX ? (m >> 11) : 8;
        const GAS f32x4* xr = (const GAS f32x4*)src + F.lane; f32x4 v[4]; float s = 0.f;
#pragma unroll
        for (int j = 0; j < 4; ++j) { v[j] = xr[64 * j]; s += (v[j].x * v[j].x + v[j].y * v[j].y) + (v[j].z * v[j].z + v[j].w * v[j].w); }
        const float rinv = 1.f / sqrtf(wave_sum(s) * (1.f / D) + EPS);
        GAS v2u* o8 = (GAS v2u*)(XN + (size_t)m * D) + F.lane;
#pragma unroll
        for (int j = 0; j < 4; ++j) { const int k = 4 * F.lane + 256 * j;
            const f32x4 nw = *(const f32x4*)(F.in[IN_NMIX] + k), sh = *(const f32x4*)(MOD + b * 6144 + k), sc = *(const f32x4*)(MOD + b * 6144 + 1024 + k);
            const f32x4 u = v[j] * rinv * nw * (sc + 1.f) + sh; v2u w; w.x = pk2(u.x, u.y); w.y = pk2(u.z, u.w); o8[64 * j] = w; }
    }
}

struct InProjOrder {
    int G, c;
    __device__ __forceinline__ bool next(int i, pg8::Unit& u) const {
        const int L = i * G + c;
        if (L < 1024) { pg8::StaticOrder S; S.init(NX, PW, 1 << 30, L); return S.next(0, u); }
        if (L < 1024 + 72) { const int j = L - 1024, ti = j >> 3; u.pm = 64 + (j & 7); u.pn = ti < 3 ? 1 + ti : 5 + ti; return true; }
        return false;
    }
    __device__ __forceinline__ void a_ready(const pg8::Unit&) const {}
    __device__ __forceinline__ void done(const pg8::Unit&) const {}
};
struct EpiInProj {
    static constexpr bool PERM = true, AFTER_DRAIN = false;
    bf16* P; const float* LB; const float* COS; const float* SIN;
    __device__ __forceinline__ void operator()(const f32x4 (&acc)[2][2][4][2], const pg8::Unit& u, int wr, int wc, int fr, int fq) const {
        const int t = u.pn; const int row0 = u.pm * 256 + wr * 64 + fr; const int cb = wc * 32 + 8 * fq;
        if (t < 2) {
            const bool isx = u.pm < 64; const float sc = t == 1 ? 0.125f : 1.f;
#pragma unroll
            for (int ai = 0; ai < 2; ++ai)
#pragma unroll
                for (int m = 0; m < 4; ++m) { const int r = row0 + ai * 128 + m * 16; f32x4 c0, c1, s0, s1;
                    if (isx) { const int pos = r & 2047; c0 = *(const f32x4*)(COS + pos * 32 + 8 * fq); c1 = *(const f32x4*)(COS + pos * 32 + 8 * fq + 4); s0 = *(const f32x4*)(SIN + pos * 32 + 8 * fq); s1 = *(const f32x4*)(SIN + pos * 32 + 8 * fq + 4); }
                    else { c0 = (f32x4){1.f, 1.f, 1.f, 1.f}; c1 = c0; s0 = (f32x4){0.f, 0.f, 0.f, 0.f}; s1 = s0; }
                    const f32x4 a0 = acc[ai][0][m][0] * sc, a1 = acc[ai][0][m][1] * sc, b0 = acc[ai][1][m][0] * sc, b1 = acc[ai][1][m][1] * sc;
                    const f32x4 o10 = a0 * c0 - b0 * s0, o11 = a1 * c1 - b1 * s1, o20 = a0 * s0 + b0 * c0, o21 = a1 * s1 + b1 * c1;
                    bf16* rp = P + (size_t)r * PW + 256 * t + 64 * wc + 8 * fq;
                    v4u w; w.x = pk2(o10[0], o10[1]); w.y = pk2(o10[2], o10[3]); w.z = pk2(o11[0], o11[1]); w.w = pk2(o11[2], o11[3]); *(v4u*)rp = w;
                    w.x = pk2(o20[0], o20[1]); w.y = pk2(o20[2], o20[3]); w.z = pk2(o21[0], o21[1]); w.w = pk2(o21[2], o21[3]); *(v4u*)(rp + 32) = w; }
            return;
        }
        const int mode = (t == 2 || t == 3 || t == 12 || t == 13) ? 0 : ((t >= 8 && t < 12) ? 2 : 1);
        f32x4 lb[2][2];
        if (mode == 2) {
#pragma unroll
            for (int bj = 0; bj < 2; ++bj)
#pragma unroll
                for (int n = 0; n < 2; ++n) lb[bj][n] = *(const f32x4*)(LB + ((t - 8) >> 1) * 512 + ((t & 1) << 8) + 128 * bj + cb + 4 * n);
        }
#pragma unroll
        for (int ai = 0; ai < 2; ++ai)
#pragma unroll
            for (int m = 0; m < 4; ++m) { const int r = row0 + ai * 128 + m * 16; bf16* rp = P + (size_t)r * PW + 256 * t + cb;
#pragma unroll
                for (int bj = 0; bj < 2; ++bj) { f32x4 v0 = acc[ai][bj][m][0], v1 = acc[ai][bj][m][1];
                    if (mode == 1) {
#pragma unroll
                        for (int i = 0; i < 4; ++i) { v0[i] = siluf_(v0[i]); v1[i] = siluf_(v1[i]); } }
                    else if (mode == 2) {
#pragma unroll
                        for (int i = 0; i < 4; ++i) { const float l0 = lb[bj][0][i], l1 = lb[bj][1][i]; v0[i] = __logf(l0 + (1.f - l0) * sigmoidf_(v0[i])); v1[i] = __logf(l1 + (1.f - l1) * sigmoidf_(v1[i])); } }
                    v4u w; w.x = pk2(v0[0], v0[1]); w.y = pk2(v0[2], v0[3]); w.z = pk2(v1[0], v1[1]); w.w = pk2(v1[2], v1[3]); *(v4u*)(rp + 128 * bj) = w; } }
    }
};

__device__ __forceinline__ bf16x8 ldfrag(const LAS unsigned char* base, int stride, int row0, int kb, int lane) {
    return *(const LAS bf16x8*)(base + (row0 + (lane & 15)) * stride + kb + 16 * (lane >> 4));
}
#define MFMA16(a, b, c) __builtin_amdgcn_mfma_f32_16x16x32_bf16((a), (b), (c), 0, 0, 0)
template <bool HG>
__device__ __forceinline__ void scan_chain(Frame& F, int b, int h, int dir, int dvh) {
    constexpr int DK = HG ? 128 : 64;
    constexpr int QS = DK * 2 + 16, SS = 64 * 2 + 16;
    constexpr int KROWS = HG ? 160 : 64;
    constexpr int O_QI = 0, O_QT = O_QI + 64 * QS, O_KIJ = O_QT + 64 * QS, O_KTT = O_KIJ + KROWS * QS, O_VT = O_KTT + DK * SS, O_PM = O_VT + 64 * SS, O_ST = O_PM + 64 * SS, O_T = O_ST + 64 * QS, O_GD = O_T + 4096, O_END = O_GD + 512;
    static_assert(SCR_OFF + O_END <= LDS_BYTES, "scan LDS");
    LAS unsigned char* L = F.lds + SCR_OFF;
    LAS unsigned char* Qi = L + O_QI; LAS unsigned char* Qt = L + O_QT; LAS unsigned char* Kij = L + O_KIJ; LAS unsigned char* Ktt = L + O_KTT;
    LAS unsigned char* Vt = L + O_VT; LAS unsigned char* Pm = L + O_PM; LAS unsigned char* St = L + O_ST;
    LAS float* T = (LAS float*)(L + O_T); LAS float* GD = (LAS float*)(L + O_GD);
    const int tid = F.tid, lane = F.lane, w = F.wave;
    const bf16* P = (const bf16*)(F.ws + WS_P);
    bf16* O = (bf16*)(F.ws + (dir ? WS_OB : WS_OF));
    const int qcol = HG ? 1536 + 128 * h : 64 * h;
    const int kcol = HG ? 2048 + 512 * dir + 128 * h : 256 + 64 * h;
    const int vcol = (HG ? 3072 : 512) + 128 * h + 64 * dvh;
    const int ocol = (HG ? 512 : 0) + 128 * h + 64 * dvh;
    const float lg = HG ? 0.f : log1pf(-exp2f(-(float)(dir ? 6 : 5) - 2.f * (float)h));
    for (int i = tid; i < (64 * SS) / 4; i += NWAVES * 64) ((LAS unsigned*)Pm)[i] = 0u;
    for (int i = tid; i < (64 * QS) / 4; i += NWAVES * 64) ((LAS unsigned*)St)[i] = 0u;
    constexpr int NVB = HG ? 4 : 2;
    f32x4 accS[NVB];
#pragma unroll
    for (int i = 0; i < NVB; ++i) accS[i] = (f32x4){0.f, 0.f, 0.f, 0.f};
    const int db = HG ? w : (w & 3);
    const int tb = w & 3, vb0 = 2 * (w >> 2);
    constexpr int TPT = HG ? 8 : 4;
    const int cp = HG ? lane : (tid & 31);
    const int tg = HG ? w : (tid >> 5);
    const int vp = tid >> 3, vs = tid & 7;
    unsigned qreg[TPT], kreg[TPT]; v4u vreg;
#define SCAN_ROW0(s) ((s) < 4 ? (NX + b * CTX + (dir ? 255 - 64 * (s) : 64 * (s))) : (b * SEQ + (dir ? 2047 - 64 * ((s) - 4) : 64 * ((s) - 4))))
#define SCAN_LOAD(s) do { const int r0_ = SCAN_ROW0(s); const int sg_ = dir ? -1 : 1; \
        _Pragma("unroll") for (int j = 0; j < TPT; ++j) { const bf16* rp_ = P + (size_t)(r0_ + sg_ * (TPT * tg + j)) * PW; \
            kreg[j] = *(const unsigned*)(rp_ + kcol + 2 * cp); qreg[j] = ((s) >= 4) ? *(const unsigned*)(rp_ + qcol + 2 * cp) : 0u; } \
        vreg = *(const v4u*)(P + (size_t)(r0_ + sg_ * vp) * PW + vcol + 8 * vs); } while (0)
    SCAN_LOAD(0);
    LBAR();
    for (int s = 0; s < 36; ++s) {
        const bool isx = s >= 4;
        const int r0 = SCAN_ROW0(s); const int sg = dir ? -1 : 1;
        {
            const unsigned vv[4] = {vreg.x, vreg.y, vreg.z, vreg.w};
#pragma unroll
            for (int e = 0; e < 4; ++e) { *(LAS unsigned short*)(Vt + (8 * vs + 2 * e) * SS + 2 * vp) = (unsigned short)(vv[e] & 0xffffu); *(LAS unsigned short*)(Vt + (8 * vs + 2 * e + 1) * SS + 2 * vp) = (unsigned short)(vv[e] >> 16); }
        }
        if constexpr (HG) {
            float c0[8], c1[8]; float run0 = 0.f, run1 = 0.f;
#pragma unroll
            for (int j = 0; j < 8; ++j) { run0 += bflo(kreg[j]); run1 += bfhi(kreg[j]); c0[j] = run0; c1[j] = run1; }
            *(LAS f32x2*)(T + w * 128 + 2 * cp) = (f32x2){run0, run1};
            LBAR();
            float pre0 = 0.f, pre1 = 0.f, base0 = 0.f, base1 = 0.f, bm0 = 0.f, bm1 = 0.f; float bs0[4], bs1[4];
            const int i_sub = w >> 1;
#pragma unroll
            for (int o = 0; o < 8; ++o) { const f32x2 tt = *(const LAS f32x2*)(T + o * 128 + 2 * cp);
                if (o == w) { base0 = pre0; base1 = pre1; }
                if ((o & 1) == 0) { bs0[o >> 1] = pre0; bs1[o >> 1] = pre1; if ((o >> 1) == i_sub) { bm0 = pre0; bm1 = pre1; } }
                pre0 += tt.x; pre1 += tt.y; }
            const float bend0 = pre0, bend1 = pre1;
            const float eBi0 = __expf(bm0), eBi1 = __expf(bm1), eEnd0 = __expf(bend0 - bm0), eEnd1 = __expf(bend1 - bm1);
            float gI0[4], gI1[4];
#pragma unroll
            for (int ii = 0; ii < 4; ++ii) { gI0[ii] = __expf(fminf(bs0[ii] - bm0, 0.f)); gI1[ii] = __expf(fminf(bs1[ii] - bm1, 0.f)); }
            if (w == 0) *(LAS f32x2*)(GD + 2 * cp) = (f32x2){__expf(bend0), __expf(bend1)};
            unsigned kt0[4], kt1[4];
#pragma unroll
            for (int j = 0; j < 8; ++j) {
                const int p = 8 * w + j;
                const float d0 = base0 + c0[j] - bm0, d1 = base1 + c1[j] - bm1;
                const float E0 = __expf(d0), E1 = __expf(d1), R0 = __expf(-d0), R1 = __expf(-d1);
                const float k0 = 1.f - __expf(bflo(kreg[j])), k1 = 1.f - __expf(bfhi(kreg[j]));
                const float kr0 = k0 * R0, kr1 = k1 * R1;
                const unsigned ktp = pk2(kr0 * eEnd0, kr1 * eEnd1);
                if ((j & 1) == 0) { kt0[j >> 1] = ktp & 0xffffu; kt1[j >> 1] = ktp >> 16; } else { kt0[j >> 1] |= ktp << 16; kt1[j >> 1] |= ktp & 0xffff0000u; }
                if (isx) {
                    const float q0 = bflo(qreg[j]), q1 = bfhi(qreg[j]);
                    const float qi0 = q0 * E0, qi1 = q1 * E1;
                    *(LAS unsigned*)(Qi + p * QS + 4 * cp) = pk2(qi0, qi1);
                    *(LAS unsigned*)(Qt + p * QS + 4 * cp) = pk2(qi0 * eBi0, qi1 * eBi1);
#pragma unroll
                    for (int ii = 0; ii < 4; ++ii) if (ii >= i_sub) { const int blk = ii * (ii + 1) / 2 + i_sub;
                        *(LAS unsigned*)(Kij + (blk * 16 + (p & 15)) * QS + 4 * cp) = pk2(kr0 * gI0[ii], kr1 * gI1[ii]); }
                }
            }
            *(LAS v4u*)(Ktt + (2 * cp) * SS + 16 * w) = (v4u){kt0[0], kt0[1], kt0[2], kt0[3]};
            *(LAS v4u*)(Ktt + (2 * cp + 1) * SS + 16 * w) = (v4u){kt1[0], kt1[1], kt1[2], kt1[3]};
        } else {
            unsigned kt0[2], kt1[2];
#pragma unroll
            for (int j = 0; j < 4; ++j) {
                const int p = 4 * tg + j;
                const float kd = __expf(lg * (float)(63 - p));
                const unsigned ktp = pk2(bflo(kreg[j]) * kd, bfhi(kreg[j]) * kd);
                if ((j & 1) == 0) { kt0[j >> 1] = ktp & 0xffffu; kt1[j >> 1] = ktp >> 16; } else { kt0[j >> 1] |= ktp << 16; kt1[j >> 1] |= ktp & 0xffff0000u; }
                if (isx) {
                    const float qd = __expf(lg * (float)(p + 1));
                    *(LAS unsigned*)(Qi + p * QS + 4 * cp) = qreg[j];
                    *(LAS unsigned*)(Qt + p * QS + 4 * cp) = pk2(bflo(qreg[j]) * qd, bfhi(qreg[j]) * qd);
                    *(LAS unsigned*)(Kij + p * QS + 4 * cp) = kreg[j];
                }
            }
            *(LAS v2u*)(Ktt + (2 * cp) * SS + 8 * tg) = (v2u){kt0[0], kt0[1]};
            *(LAS v2u*)(Ktt + (2 * cp + 1) * SS + 8 * tg) = (v2u){kt1[0], kt1[1]};
        }
        if (s + 1 < 36) SCAN_LOAD(s + 1);
        LBAR();
        f32x4 oT[2];
        oT[0] = (f32x4){0.f, 0.f, 0.f, 0.f}; oT[1] = oT[0];
        if (isx) {
#pragma unroll
            for (int rep = 0; rep < 2; ++rep) { const int bi = w + 8 * rep; if (bi < 10) {
                const int i = bi >= 6 ? 3 : (bi >= 3 ? 2 : (bi >= 1 ? 1 : 0)), j = bi - i * (i + 1) / 2;
                f32x4 sc = (f32x4){0.f, 0.f, 0.f, 0.f};
#pragma unroll
                for (int ks = 0; ks < DK / 32; ++ks) { const bf16x8 a = ldfrag(Kij, QS, HG ? 16 * bi : 16 * j, 64 * ks, lane), bq = ldfrag(Qi, QS, 16 * i, 64 * ks, lane); sc = MFMA16(a, bq, sc); }
#pragma unroll
                for (int r = 0; r < 4; ++r) { const int dt = (16 * i + (lane & 15)) - (16 * j + 4 * (lane >> 4) + r);
                    if constexpr (HG) { if (dt < 0) sc[r] = 0.f; } else { sc[r] = dt >= 0 ? sc[r] * __expf(lg * (float)dt) : 0.f; } }
                *(LAS v2u*)(Pm + (16 * i + (lane & 15)) * SS + 2 * (16 * j + 4 * (lane >> 4))) = (v2u){pk2(sc[0], sc[1]), pk2(sc[2], sc[3])}; } }
#pragma unroll
            for (int vi = 0; vi < 2; ++vi)
#pragma unroll
                for (int ks = 0; ks < DK / 32; ++ks) { const bf16x8 a = ldfrag(St, QS, 16 * (vb0 + vi), 64 * ks, lane), bq = ldfrag(Qt, QS, 16 * tb, 64 * ks, lane); oT[vi] = MFMA16(a, bq, oT[vi]); }
        }
        {
            f32x4 gv;
            if constexpr (HG) gv = *(const LAS f32x4*)(GD + 16 * db + 4 * (lane >> 4)); else { const float g64 = __expf(lg * 64.f); gv = (f32x4){g64, g64, g64, g64}; }
#pragma unroll
            for (int vi = 0; vi < NVB; ++vi) { const int vb = HG ? vi : vb0 + vi; accS[vi] = accS[vi] * gv;
#pragma unroll
                for (int ks = 0; ks < 2; ++ks) { const bf16x8 a = ldfrag(Ktt, SS, 16 * db, 64 * ks, lane), bv = ldfrag(Vt, SS, 16 * vb, 64 * ks, lane); accS[vi] = MFMA16(a, bv, accS[vi]); } }
        }
        LBAR();
        if (isx) {
#pragma unroll
            for (int vi = 0; vi < 2; ++vi) {
#pragma unroll
                for (int ks = 0; ks < 2; ++ks) { const bf16x8 a = ldfrag(Vt, SS, 16 * (vb0 + vi), 64 * ks, lane), bp = ldfrag(Pm, SS, 16 * tb, 64 * ks, lane); oT[vi] = MFMA16(a, bp, oT[vi]); }
                const int t = 16 * tb + (lane & 15);
                *(v2u*)(O + (size_t)(r0 + sg * t) * D + ocol + 16 * (vb0 + vi) + 4 * (lane >> 4)) = (v2u){pk2(oT[vi][0], oT[vi][1]), pk2(oT[vi][2], oT[vi][3])};
            }
        }
#pragma unroll
        for (int vi = 0; vi < NVB; ++vi) { const int vb = HG ? vi : vb0 + vi;
            *(LAS v2u*)(St + (16 * vb + (lane & 15)) * QS + 2 * (16 * db + 4 * (lane >> 4))) = (v2u){pk2(accS[vi][0], accS[vi][1]), pk2(accS[vi][2], accS[vi][3])}; }
        LBAR();
    }
#undef SCAN_LOAD
#undef SCAN_ROW0
}
__device__ __forceinline__ void p3_scan(Frame& F) {
    for (int id = F.vcu; id < 256; id += F.G) {
        const int dvh = id & 1, mixer = (id >> 1) & 1, dir = (id >> 2) & 1, h = (id >> 3) & 3, b = id >> 5;
        if (mixer) scan_chain<true>(F, b, h, dir, dvh); else scan_chain<false>(F, b, h, dir, dvh);
        __syncthreads();
    }
}

__device__ __forceinline__ void p4_merge(Frame& F) {
    const int gw = F.vcu * NWAVES + F.wave, NGW = F.G * NWAVES;
    const bf16* P = (const bf16*)(F.ws + WS_P); const bf16* OF = (const bf16*)(F.ws + WS_OF); const bf16* OB = (const bf16*)(F.ws + WS_OB); bf16* AO = (bf16*)(F.ws + WS_AO);
    const int lane = F.lane; const bool ishg = lane >= 32;
    float nw[16];
#pragma unroll
    for (int i = 0; i < 16; ++i) nw[i] = ishg ? F.in[IN_HGNW][16 * (lane & 7) + i] : 1.f;
    for (int t = gw; t < NX; t += NGW) {
        const v4u* pf = (const v4u*)(OF + (size_t)t * D + 16 * lane); const v4u* pb = (const v4u*)(OB + (size_t)t * D + 16 * lane);
        const v4u* pg = (const v4u*)(P + (size_t)t * PW + (ishg ? 3584 + 16 * (lane - 32) : 1024 + 16 * lane));
        const v4u f0 = pf[0], f1 = pf[1], b0 = pb[0], b1 = pb[1], g0 = pg[0], g1 = pg[1];
        const unsigned fu[8] = {f0.x, f0.y, f0.z, f0.w, f1.x, f1.y, f1.z, f1.w}, bu[8] = {b0.x, b0.y, b0.z, b0.w, b1.x, b1.y, b1.z, b1.w}, gu[8] = {g0.x, g0.y, g0.z, g0.w, g1.x, g1.y, g1.z, g1.w};
        float x[16]; float ss = 0.f;
#pragma unroll
        for (int i = 0; i < 8; ++i) { x[2 * i] = bflo(fu[i]) + bflo(bu[i]); x[2 * i + 1] = bfhi(fu[i]) + bfhi(bu[i]); ss += x[2 * i] * x[2 * i] + x[2 * i + 1] * x[2 * i + 1]; }
        ss += __shfl_xor(ss, 1); ss += __shfl_xor(ss, 2); ss += __shfl_xor(ss, 4);
        const float rinv = 1.f / sqrtf(ss * (1.f / 128.f) + EPS);
        unsigned o[8];
#pragma unroll
        for (int i = 0; i < 8; ++i) o[i] = pk2(x[2 * i] * rinv * nw[2 * i] * bflo(gu[i]), x[2 * i + 1] * rinv * nw[2 * i + 1] * bfhi(gu[i]));
        v4u* po = (v4u*)(AO + (size_t)t * D + 16 * lane); po[0] = (v4u){o[0], o[1], o[2], o[3]}; po[1] = (v4u){o[4], o[5], o[6], o[7]};
    }
}

struct EpiResid {
    static constexpr bool PERM = false, AFTER_DRAIN = false;
    const float* X; const float* MOD; float* H;
    __device__ __forceinline__ void operator()(const f32x4 (&acc)[2][2][4][2], const pg8::Unit& u, int wr, int wc, int fr, int fq) const {
        const int row0 = u.pm * 256 + wr * 64 + fr, col0 = u.pn * 256 + wc * 32 + 4 * fq; const int b = (u.pm * 256) >> 11;
        f32x4 g[2][2];
#pragma unroll
        for (int bj = 0; bj < 2; ++bj)
#pragma unroll
            for (int n = 0; n < 2; ++n) g[bj][n] = *(const f32x4*)(MOD + b * 6144 + 2048 + col0 + bj * 128 + n * 16);
#pragma unroll
        for (int ai = 0; ai < 2; ++ai)
#pragma unroll
            for (int m = 0; m < 4; ++m) { const size_t off = (size_t)(row0 + ai * 128 + m * 16) * D + col0;
#pragma unroll
                for (int bj = 0; bj < 2; ++bj)
#pragma unroll
                    for (int n = 0; n < 2; ++n) { const f32x4 xv = *(const f32x4*)(X + off + bj * 128 + n * 16); *(f32x4*)(H + off + bj * 128 + n * 16) = xv + g[bj][n] * acc[ai][bj][m][n]; } }
    }
};

__device__ __forceinline__ void p6_router(Frame& F) {
    LAS float* Wl = (LAS float*)(F.lds + SCR_OFF);
    LAS int* le = (LAS int*)(F.lds + SCR_OFF + 131072);
    LAS int* lp = le + 256;
    LAS float* lgt = (LAS float*)(lp + 256);
    LAS int* lcnt = (LAS int*)(F.lds + L_LCNT); LAS int* gbase = (LAS int*)(F.lds + L_GBASE);
    const int tid = F.tid, lane = F.lane, w = F.wave;
    LAS float* cmL = (LAS float*)(F.lds + SCR_OFF + 131072 + 3072); LAS float* shL = cmL + 1024;
    const float* MOD = (const float*)(F.ws + WS_MOD); const float* H = (const float*)(F.ws + WS_H); bf16* VX = (bf16*)(F.ws + WS_VX);
    int* TOKE = (int*)(F.ws + WS_TOKE); int* TOKPOS = (int*)(F.ws + WS_TOKPOS); float* TOKGATE = (float*)(F.ws + WS_TOKGATE);
    for (int it = 0; it < 16; ++it) { const int idx = tid + 512 * it, k = idx >> 3, c = idx & 7; const f32x4 v = ((const f32x4*)F.in[IN_RW])[idx]; *(LAS f32x4*)(Wl + k * 32 + 4 * (c ^ (k & 7))) = v; }
    const float rb = F.in[IN_RB][lane >> 1];
#pragma unroll 1
    for (int tok0 = F.vcu * 64; tok0 < NX; tok0 += F.G * 64) {
        const int b = tok0 >> 11;
        if (tid < 32) lcnt[tid] = 0;
        for (int k = tid; k < 1024; k += NWAVES * 64) { cmL[k] = F.in[IN_NFFN][k] * (1.f + MOD[b * 6144 + 4096 + k]); shL[k] = MOD[b * 6144 + 3072 + k]; }
        __syncthreads();
#pragma unroll 1
        for (int pr = 0; pr < 4; ++pr) {
            const int tl = 8 * w + 2 * pr;
            float acc[2][32]; float rinv[2];
            const LAS float* wb[8];
#pragma unroll
            for (int c = 0; c < 8; ++c) wb[c] = Wl + lane * 32 + 4 * (c ^ (lane & 7));
            const float* hr0 = H + (size_t)(tok0 + tl) * D + lane; const float* hr1 = hr0 + D;
            { float t0[16], t1[16]; float s0 = 0.f, s1 = 0.f;
#pragma unroll
              for (int jj = 0; jj < 16; ++jj) { t0[jj] = hr0[64 * jj]; t1[jj] = hr1[64 * jj]; }
#pragma unroll
              for (int jj = 0; jj < 16; ++jj) { s0 += t0[jj] * t0[jj]; s1 += t1[jj] * t1[jj]; }
              rinv[0] = 1.f / sqrtf(wave_sum(s0) * (1.f / D) + EPS); rinv[1] = 1.f / sqrtf(wave_sum(s1) * (1.f / D) + EPS); }
#pragma unroll
            for (int e = 0; e < 32; ++e) { acc[0][e] = 0.f; acc[1][e] = 0.f; }
            float xc0[4], xc1[4], xn0[4], xn1[4];
#pragma unroll
            for (int u = 0; u < 4; ++u) { xc0[u] = hr0[64 * u]; xc1[u] = hr1[64 * u]; }
#pragma unroll 1
            for (int jc = 0; jc < 4; ++jc) { const int jn = (jc + 1) & 3;
#pragma unroll
                for (int u = 0; u < 4; ++u) { xn0[u] = hr0[64 * (4 * jn + u)]; xn1[u] = hr1[64 * (4 * jn + u)]; }
#pragma unroll
                for (int u = 0; u < 4; ++u) { const int k = lane + 64 * (4 * jc + u);
                    const float cm = cmL[k], sh = shL[k];
                    const float v0 = xc0[u] * rinv[0] * cm + sh, v1 = xc1[u] * rinv[1] * cm + sh;
                    VX[(size_t)(tok0 + tl) * D + k] = (bf16)f2bf(v0); VX[(size_t)(tok0 + tl + 1) * D + k] = (bf16)f2bf(v1);
#pragma unroll
                    for (int c = 0; c < 8; ++c) { const f32x4 w4 = *(const LAS f32x4*)(wb[c] + 2048 * (4 * jc + u));
#pragma unroll
                        for (int i = 0; i < 4; ++i) { acc[0][4 * c + i] += v0 * w4[i]; acc[1][4 * c + i] += v1 * w4[i]; } } }
#pragma unroll
                for (int u = 0; u < 4; ++u) { xc0[u] = xn0[u]; xc1[u] = xn1[u]; } }
#pragma unroll
            for (int tk = 0; tk < 2; ++tk) {
#pragma unroll
                for (int st = 0; st < 5; ++st) { const int off = 32 >> st, half = 16 >> st; const bool up = (lane & off) != 0;
#pragma unroll
                    for (int i = 0; i < half; ++i) { const float a = acc[tk][i], bb = acc[tk][i + half]; const float send = up ? a : bb, keep = up ? bb : a; acc[tk][i] = keep + __shfl_xor(send, off); } }
                float logit = acc[tk][0] + __shfl_xor(acc[tk][0], 1) + rb;
                const int myE = lane >> 1;
                float tv[4]; int ti[4];
#pragma unroll
                for (int r = 0; r < 4; ++r) { float bv = logit; int bi = myE;
#pragma unroll
                    for (int o = 1; o < 64; o <<= 1) { const float pv = __shfl_xor(bv, o); const int pi = __shfl_xor(bi, o); if (pv > bv || (pv == bv && pi < bi)) { bv = pv; bi = pi; } }
                    tv[r] = bv; ti[r] = bi; if (myE == bi) logit = -INFINITY; }
                const float e1 = __expf(tv[1] - tv[0]), e2 = __expf(tv[2] - tv[0]), e3 = __expf(tv[3] - tv[0]); const float inv = 1.f / (1.f + e1 + e2 + e3);
                if (lane == 0) { const float gg[4] = {inv, e1 * inv, e2 * inv, e3 * inv};
#pragma unroll
                    for (int r = 0; r < 4; ++r) { le[(tl + tk) * 4 + r] = ti[r]; lgt[(tl + tk) * 4 + r] = gg[r]; lp[(tl + tk) * 4 + r] = __hip_atomic_fetch_add(lcnt + ti[r], 1, __ATOMIC_RELAXED, __HIP_MEMORY_SCOPE_WORKGROUP); } }
            }
        }
        __syncthreads();
        if (tid < 32) gbase[tid] = (int)__hip_atomic_fetch_add((unsigned*)(F.ctl + CW_CNT + tid), (unsigned)lcnt[tid], RLX_AGENT);
        __syncthreads();
        if (tid < 256) { const int e = le[tid]; TOKE[tok0 * 4 + tid] = e; TOKPOS[tok0 * 4 + tid] = gbase[e] + lp[tid]; TOKGATE[tok0 * 4 + tid] = lgt[tid]; }
        __syncthreads();
    }
}

__device__ __forceinline__ void moe_tables(Frame& F) {
    LAS int* TS = (LAS int*)(F.lds + L_TSTART); LAS int* TE = (LAS int*)(F.lds + L_TILEE);
    if (F.wave == 0) {
        const int e = F.lane; int nt = 0;
        if (e < 32) { const int c = (int)__hip_atomic_load((unsigned*)(F.ctl + CW_CNT + e), RLX_AGENT); nt = (c + 255) >> 8; }
        int incl = nt;
#pragma unroll
        for (int o = 1; o < 32; o <<= 1) { const int y = __shfl_up(incl, o); if ((F.lane & 31) >= o) incl += y; }
        const int st = incl - nt;
        if (e < 32) { TS[e] = st; for (int i = 0; i < nt; ++i) TE[st + i] = e; if (e == 31) TS[32] = incl; }
    }
    __syncthreads();
}
__device__ __forceinline__ void p7_gather(Frame& F) {
    moe_tables(F);
    const LAS int* TS = (const LAS int*)(F.lds + L_TSTART);
    const int gw = F.vcu * NWAVES + F.wave, NGW = F.G * NWAVES;
    const int* TOKE = (const int*)(F.ws + WS_TOKE); const int* TOKPOS = (const int*)(F.ws + WS_TOKPOS); const float* TOKGATE = (const float*)(F.ws + WS_TOKGATE);
    int* TOKROW = (int*)(F.ws + WS_TOKROW); float* ROWGATE = (float*)(F.ws + WS_ROWGATE);
    const bf16* VX = (const bf16*)(F.ws + WS_VX); bf16* XG = (bf16*)(F.ws + WS_XG);
    for (int item = gw; item < NX * TOPK; item += NGW) {
        const int e = TOKE[item], pos = TOKPOS[item]; const int row = 256 * TS[e] + pos; const int t = item >> 2;
        const v4u* src = (const v4u*)(VX + (size_t)t * D) + F.lane; v4u* dst = (v4u*)(XG + (size_t)row * D) + F.lane;
        const v4u a = src[0], b2 = src[64]; dst[0] = a; dst[64] = b2;
        if (F.lane == 0) { ROWGATE[row] = TOKGATE[item]; TOKROW[item] = row; }
    }
}
struct MoeOrder {
    int G, c, nct; const LAS int* TS; const LAS int* TE;
    __device__ __forceinline__ bool next(int i, pg8::Unit& u) const {
        const int L = i * G + c; const int NT = TS[32];
        if (L >= NT * nct) return false;
        const int rt = L / nct, ct = L - rt * nct; const int e = TE[rt];
        u.pm = __builtin_amdgcn_readfirstlane(rt); u.pn = __builtin_amdgcn_readfirstlane(e * nct + ct); return true;
    }
    __device__ __forceinline__ void a_ready(const pg8::Unit&) const {}
    __device__ __forceinline__ void done(const pg8::Unit&) const {}
};
struct EpiGlu {
    static constexpr bool PERM = true, AFTER_DRAIN = false;
    bf16* ACT; const float* B1;
    __device__ __forceinline__ void operator()(const f32x4 (&acc)[2][2][4][2], const pg8::Unit& u, int wr, int wc, int fr, int fq) const {
        const int e = u.pn >> 3, ct = u.pn & 7; const int row0 = u.pm * 256 + wr * 64 + fr; const int cb = wc * 32 + 8 * fq;
        f32x4 bg[2], bl[2];
#pragma unroll
        for (int n = 0; n < 2; ++n) { bg[n] = *(const f32x4*)(B1 + e * 2048 + 128 * ct + cb + 4 * n); bl[n] = *(const f32x4*)(B1 + e * 2048 + 1024 + 128 * ct + cb + 4 * n); }
#pragma unroll
        for (int ai = 0; ai < 2; ++ai)
#pragma unroll
            for (int m = 0; m < 4; ++m) { const int r = row0 + ai * 128 + m * 16; unsigned o[4];
#pragma unroll
                for (int n = 0; n < 2; ++n) { float a[4];
#pragma unroll
                    for (int i = 0; i < 4; ++i) { const float xg = fminf(acc[ai][0][m][n][i] + bg[n][i], 7.f); const float xl = fminf(fmaxf(acc[ai][1][m][n][i] + bl[n][i], -7.f), 7.f);
                        a[i] = xg * sigmoidf_(1.702f * xg) * (xl + 1.f); }
                    o[2 * n] = pk2(a[0], a[1]); o[2 * n + 1] = pk2(a[2], a[3]); }
                *(v4u*)(ACT + (size_t)r * DFF + 128 * ct + cb) = (v4u){o[0], o[1], o[2], o[3]}; }
    }
};
struct EpiDown {
    static constexpr bool PERM = true, AFTER_DRAIN = false;
    bf16* YB; const float* B2; const float* ROWGATE;
    __device__ __forceinline__ void operator()(const f32x4 (&acc)[2][2][4][2], const pg8::Unit& u, int wr, int wc, int fr, int fq) const {
        const int e = u.pn >> 2, ct = u.pn & 3; const int row0 = u.pm * 256 + wr * 64 + fr; const int cb = 256 * ct + wc * 32 + 8 * fq;
        f32x4 bv[2][2];
#pragma unroll
        for (int bj = 0; bj < 2; ++bj)
#pragma unroll
            for (int n = 0; n < 2; ++n) bv[bj][n] = *(const f32x4*)(B2 + e * 1024 + cb + 128 * bj + 4 * n);
#pragma unroll
        for (int ai = 0; ai < 2; ++ai)
#pragma unroll
            for (int m = 0; m < 4; ++m) { const int r = row0 + ai * 128 + m * 16; const float gt = ROWGATE[r];
#pragma unroll
                for (int bj = 0; bj < 2; ++bj) { const f32x4 v0 = (acc[ai][bj][m][0] + bv[bj][0]) * gt, v1 = (acc[ai][bj][m][1] + bv[bj][1]) * gt;
                    *(v4u*)(YB + (size_t)r * D + cb + 128 * bj) = (v4u){pk2(v0[0], v0[1]), pk2(v0[2], v0[3]), pk2(v1[0], v1[1]), pk2(v1[2], v1[3])}; } }
    }
};
__device__ __forceinline__ void p10_final(Frame& F) {
    const int gw = F.vcu * NWAVES + F.wave, NGW = F.G * NWAVES;
    const float* MOD = (const float*)(F.ws + WS_MOD); const float* H = (const float*)(F.ws + WS_H); const bf16* YB = (const bf16*)(F.ws + WS_YB); const int* TOKROW = (const int*)(F.ws + WS_TOKROW);
    for (int t = gw; t < NX; t += NGW) {
        const int b = t >> 11; int rows[4];
#pragma unroll
        for (int k = 0; k < 4; ++k) rows[k] = TOKROW[t * 4 + k];
        f32x4 hv[4]; float ss = 0.f;
#pragma unroll
        for (int j = 0; j < 4; ++j) { const int k0 = 4 * F.lane + 256 * j; f32x4 y = (f32x4){0.f, 0.f, 0.f, 0.f};
#pragma unroll
            for (int k = 0; k < 4; ++k) { const v2u yy = *(const v2u*)(YB + (size_t)rows[k] * D + k0); y += (f32x4){bflo(yy.x), bfhi(yy.x), bflo(yy.y), bfhi(yy.y)}; }
            const f32x4 h4 = *(const f32x4*)(H + (size_t)t * D + k0), g2 = *(const f32x4*)(MOD + b * 6144 + 5120 + k0);
            hv[j] = h4 + g2 * y; ss += (hv[j].x * hv[j].x + hv[j].y * hv[j].y) + (hv[j].z * hv[j].z + hv[j].w * hv[j].w); }
        const float rinv = 1.f / sqrtf(wave_sum(ss) * (1.f / D) + EPS);
#pragma unroll
        for (int j = 0; j < 4; ++j) { const int k0 = 4 * F.lane + 256 * j; const f32x4 nw = *(const f32x4*)(F.in[IN_NFIN] + k0); *(f32x4*)(F.out + (size_t)t * D + k0) = hv[j] * rinv * nw; }
    }
}

struct Args { const float* in[19]; float* out; unsigned char* ws; int ph_lo, ph_hi, li, pad; };
__global__ void __launch_bounds__(NWAVES * 64, 2) fwd_kernel(Args args) {
    extern __shared__ __attribute__((aligned(16))) unsigned char lds[];
    Frame F;
    F.lds = (LAS unsigned char*)lds;
    F.tid = threadIdx.x; F.lane = F.tid & 63; F.wave = __builtin_amdgcn_readfirstlane(F.tid >> 6);
    F.G = gridDim.x; { const int bx = blockIdx.x; F.vcu = (F.G % 8 == 0) ? (bx % 8) * (F.G / 8) + bx / 8 : bx; }
    F.ws = args.ws; F.ctl = (gu32*)(args.ws + WS_CTL); F.out = args.out;
#pragma unroll
    for (int i = 0; i < 19; ++i) F.in[i] = args.in[i];
    for (int u = F.tid; u < LCTL_BYTES / 4; u += NWAVES * 64) ((LAS unsigned*)F.lds)[u] = 0u;
    __syncthreads();
    XcdBarrier bar; bar.bar = (unsigned*)(F.ctl + CW_BAR); bar.x = 0; bar.st = nullptr;
    if (N_LAUNCHES == 1) bar = xcd_barrier_post((unsigned*)(F.ctl + CW_BAR), (volatile LAS unsigned*)(F.lds + L_MISC) + 8);
    const int lo = args.ph_lo, hi = args.ph_hi;
#ifndef PH_MASK
#define PH_MASK 0x7ff
#endif
#define IN(k) (((PH_MASK >> (k)) & 1) && lo <= (k) && (k) < hi)
#define SEAM(k) do { if (IN(k) && IN((k) + 1)) xcd_barrier(bar); } while (0)
    LAS unsigned char* ring = F.lds + SCR_OFF;
#ifndef REP_MASK
#define REP_MASK 0
#endif
#define NREP(k) (1 + ((REP_MASK >> (k)) & 1))
#define PH(k, ...) if (IN(k)) { for (int rep_ = 0; rep_ < NREP(k); ++rep_) { __VA_ARGS__; if (rep_ + 1 < NREP(k)) xcd_barrier(bar); } SEAM(k); }
    PH(0, p0_prologue(F))
    PH(1, p1_xn(F))
    PH(2, {
        pg8::Gemm g{(const bf16*)(F.ws + WS_XN), (const bf16*)(F.ws + WS_WIN), NROWS, PW, D};
        InProjOrder S{F.G, (int)blockIdx.x};
        EpiInProj E{(bf16*)(F.ws + WS_P), (const float*)(F.ws + WS_LB), (const float*)(F.ws + WS_COS), (const float*)(F.ws + WS_SIN)};
        pg8::gemm_phase<EpiInProj, InProjOrder, true, true>(ring, g, S, E); })
    PH(3, p3_scan(F))
    PH(4, p4_merge(F))
    PH(5, {
        pg8::Gemm g{(const bf16*)(F.ws + WS_AO), (const bf16*)(F.ws + WS_WOUT), NX, D, D};
        pg8::StaticOrder S; S.init(NX, D, F.G, (int)blockIdx.x);
        EpiResid E{F.in[IN_X], (const float*)(F.ws + WS_MOD), (float*)(F.ws + WS_H)};
        pg8::gemm_phase<EpiResid, pg8::StaticOrder, true, true>(ring, g, S, E); })
    PH(6, p6_router(F))
    PH(7, p7_gather(F))
    PH(8, {
        moe_tables(F);
        pg8::Gemm g{(const bf16*)(F.ws + WS_XG), (const bf16*)(F.ws + WS_W1), MAXRT * 256, NEXP * 2048, D};
        MoeOrder S{F.G, (int)blockIdx.x, 8, (const LAS int*)(F.lds + L_TSTART), (const LAS int*)(F.lds + L_TILEE)};
        EpiGlu E{(bf16*)(F.ws + WS_ACT), F.in[IN_B1]};
        pg8::gemm_phase<EpiGlu, MoeOrder, true, true>(ring, g, S, E); })
    PH(9, {
        moe_tables(F);
        pg8::Gemm g{(const bf16*)(F.ws + WS_ACT), (const bf16*)(F.ws + WS_W2), MAXRT * 256, NEXP * 1024, DFF};
        MoeOrder S{F.G, (int)blockIdx.x, 4, (const LAS int*)(F.lds + L_TSTART), (const LAS int*)(F.lds + L_TILEE)};
        EpiDown E{(bf16*)(F.ws + WS_YB), F.in[IN_B2], (const float*)(F.ws + WS_ROWGATE)};
        pg8::gemm_phase<EpiDown, MoeOrder, true, true>(ring, g, S, E); })
    PH(10, p10_final(F))
#undef PH
#undef IN
#undef SEAM
}

extern "C" void kernel_launch(void* const* d_in, const int* in_sizes, int n_in, void* d_out, int out_size, void* d_ws, size_t ws_size, hipStream_t stream) {
    static int grid = 0;
    if (grid == 0) {
        if (n_in != 19 || in_sizes[0] != NX * D || out_size != NX * D || ws_size < WS_END) { fprintf(stderr, "kernel_launch: unexpected shapes (n_in %d, in0 %d, out %d, ws %zu; need ws >= %zu)\n", n_in, n_in > 0 ? in_sizes[0] : -1, out_size, ws_size, (size_t)WS_END); grid = -1; return; }
        int dev = 0, cus = 0, per_cu = 0;
        if (hipGetDevice(&dev) != hipSuccess || hipDeviceGetAttribute(&cus, hipDeviceAttributeMultiprocessorCount, dev) != hipSuccess) { fprintf(stderr, "kernel_launch: device query failed\n"); grid = -1; return; }
        if (hipFuncSetAttribute((const void*)fwd_kernel, hipFuncAttributeMaxDynamicSharedMemorySize, LDS_BYTES) != hipSuccess) { fprintf(stderr, "kernel_launch: hipFuncSetAttribute failed\n"); grid = -1; return; }
        if (hipOccupancyMaxActiveBlocksPerMultiprocessor(&per_cu, (const void*)fwd_kernel, NWAVES * 64, LDS_BYTES) != hipSuccess || per_cu < 1)
            fprintf(stderr, "kernel_launch: note: occupancy query reports %d workgroups per CU\n", per_cu);
        (void)hipGetLastError();
        grid = cus;
    }
    if (grid < 0) return;
    if (hipMemsetAsync((char*)d_ws + WS_CTL, 0, CTL_ZERO_BYTES, stream) != hipSuccess) { fprintf(stderr, "kernel_launch: hipMemsetAsync failed\n"); return; }
    Args a{};
    for (int i = 0; i < 19; ++i) a.in[i] = (const float*)d_in[i];
    a.out = (float*)d_out; a.ws = (unsigned char*)d_ws;
    for (int li = 0; li < N_LAUNCHES; ++li) {
        a.ph_lo = (N_LAUNCHES == 1) ? 0 : li; a.ph_hi = (N_LAUNCHES == 1) ? NPHASE : li + 1; a.li = li;
        hipLaunchKernelGGL(fwd_kernel, dim3(grid), dim3(NWAVES * 64), LDS_BYTES, stream, a);
        const hipError_t le = hipPeekAtLastError();
        if (le != hipSuccess) { fprintf(stderr, "kernel_launch: launch %d failed: %s\n", li, hipGetErrorName(le)); break; }
    }
}
```

```cpp
#include <hip/hip_runtime.h>
#include <cstdio>
#include <cstdint>
namespace pg8 {
#define PG8_LAS __attribute__((address_space(3)))
typedef unsigned short bf16_t;
typedef short bf16x8 __attribute__((ext_vector_type(8)));
typedef float f32x4 __attribute__((ext_vector_type(4)));
typedef unsigned u32x4 __attribute__((ext_vector_type(4)));
constexpr int BM = 256, BK = 64, HALF = 128, HTB = HALF * BK * 2  , STAGE_BYTES = 8 * HTB, NXCD = 8, WGM = 8;

__host__ __device__ __forceinline__ int lds_byte(int r, int c) { const int st = (r >> 4) * 2 + (c >> 5), rr = r & 15, cc = c & 31, ob = rr * 64 + cc * 2; return st * 1024 + (ob ^ (((ob >> 9) & 1) << 5)); }
__host__ __device__ __forceinline__ void stage_rc(int b, int& R, int& C) { const int st = b / 1024, sb = b % 1024, swz = sb ^ (((sb >> 9) & 1) << 5); R = (st >> 1) * 16 + swz / 64; C = (st & 1) * 32 + (swz % 64) / 2; }
__host__ __device__ __forceinline__ int perm32(int rho) { const int n = rho >> 4, i = rho & 15; return 8 * (i >> 2) + 4 * n + (i & 3); }

struct Unit { int pm, pn; };
struct Gemm { const bf16_t* A; const bf16_t* Bt; int M, N, K; };

struct StaticOrder {
    int nM, nN, nwg, G, c;
    __host__ __device__ void init(int M, int N, int G_, int c_) { nM = M / BM; nN = N / BM; nwg = nM * nN; G = G_; c = c_; }
    __host__ __device__ bool next(int i, Unit& u) const {
        const long L = (long)i * G + c; if (L >= nwg) return false;
        int wgid = (int)L; { const int q = nwg / NXCD, r = nwg % NXCD, xcd = wgid % NXCD, off = wgid / NXCD; wgid = (xcd < r ? xcd * (q + 1) : r * (q + 1) + (xcd - r) * q) + off; }
        const int nig = WGM * nN, gid = wgid / nig, fm = gid * WGM, gsz = (nM - fm) < WGM ? (nM - fm) : WGM;
        u.pm = fm + ((wgid % nig) % gsz); u.pn = (wgid % nig) / gsz; return true;
    }
    __device__ __forceinline__ void a_ready(const Unit&) const {}
    __device__ __forceinline__ void done(const Unit&) const {}
};

template <class Epi, class Sched, bool ALIGN_EPI = false, bool SP2 = false>
__device__ __forceinline__ void gemm_phase(PG8_LAS unsigned char* lds, const Gemm g, const Sched& S, const Epi& E) {
    const int tid = threadIdx.x, wid = __builtin_amdgcn_readfirstlane(tid >> 6), lane = tid & 63, wr = wid >> 2, wc = wid & 3, fr = lane & 15, fq = lane >> 4;
    const int K = g.K, nt = K / BK;
    unsigned voffA[2], voffB[2];
#pragma unroll
    for (int i = 0; i < 2; ++i) { int R, C; stage_rc(tid * 16 + i * 8192, R, C); const int Rb = Epi::PERM ? ((R & ~31) + perm32(R & 31)) : R;
        voffA[i] = (unsigned)(R * K + C) * 2u; voffB[i] = (unsigned)(Rb * K + C) * 2u; }
    const size_t kstep = (size_t)(BK * 2);
    const size_t hstep = (size_t)HALF * K * 2;
    const size_t tstep = 2 * hstep;
    const unsigned ldsw = (unsigned)wid * 1024u;
    const int aoff = lds_byte(wr * 64 + fr, fq * 8), boff = lds_byte(wc * 32 + fr, fq * 8);
#define PG8_SA(b, h) (((b) * 2 + (h)) * HTB)
#define PG8_SB(b, h) ((4 + (b) * 2 + (h)) * HTB)
#define PG8_STAGE(bufoff, gbase, voff) do { _Pragma("unroll") for (int _i = 0; _i < 2; ++_i) \
        __builtin_amdgcn_global_load_lds((const unsigned*)((const char*)(gbase) + (voff)[_i]), (PG8_LAS unsigned*)(lds + (bufoff) + ldsw + _i * 8192), 16, 0, 0); } while (0)
#define PG8_LDA(dst, b, h) do { _Pragma("unroll") for (int m = 0; m < 4; ++m) _Pragma("unroll") for (int k = 0; k < 2; ++k) dst[m][k] = *(const PG8_LAS bf16x8*)(lds + PG8_SA(b, h) + aoff + m * 2048 + k * 1024); } while (0)
#define PG8_LDB(dst, b, h) do { _Pragma("unroll") for (int n = 0; n < 2; ++n) _Pragma("unroll") for (int k = 0; k < 2; ++k) dst[n][k] = *(const PG8_LAS bf16x8*)(lds + PG8_SB(b, h) + boff + n * 2048 + k * 1024); } while (0)
#define PG8_MMA(ai, bj, At, Bt) do { __builtin_amdgcn_s_setprio(1); _Pragma("unroll") for (int m = 0; m < 4; ++m) _Pragma("unroll") for (int n = 0; n < 2; ++n) _Pragma("unroll") for (int k = 0; k < 2; ++k) \
        acc[ai][bj][m][n] = __builtin_amdgcn_mfma_f32_16x16x32_bf16(Bt[n][k], At[m][k], acc[ai][bj][m][n], 0, 0, 0); __builtin_amdgcn_s_setprio(0); } while (0)
#define PG8_WAIT_V(n) asm volatile("s_waitcnt vmcnt(" #n ")" ::: "memory")
#define PG8_WAIT_L(n) asm volatile("s_waitcnt lgkmcnt(" #n ")" ::: "memory")
#define PG8_BAR __builtin_amdgcn_s_barrier()
#define PG8_SCHED __builtin_amdgcn_sched_barrier(0)
    Unit cur, nxt; int ui = 0;
    if (!S.next(0, cur)) return;
    f32x4 acc[2][2][4][2];
#pragma unroll
    for (int a = 0; a < 2; ++a)
#pragma unroll
        for (int b = 0; b < 2; ++b)
#pragma unroll
            for (int m = 0; m < 4; ++m)
#pragma unroll
                for (int n = 0; n < 2; ++n) acc[a][b][m][n] = (f32x4){0.f, 0.f, 0.f, 0.f};
    bf16x8 At[4][2], B0[2][2], B1[2][2];
    const char* cA = (const char*)g.A + (size_t)cur.pm * tstep; const char* cB = (const char*)g.Bt + (size_t)cur.pn * tstep;
    S.a_ready(cur);
    if constexpr (SP2) {
        PG8_STAGE(PG8_SB(0, 0), cB, voffB); PG8_STAGE(PG8_SB(0, 1), cB + hstep, voffB); PG8_STAGE(PG8_SA(0, 0), cA, voffA); PG8_STAGE(PG8_SA(0, 1), cA + hstep, voffA);
        if (wr == 1) PG8_BAR;
        PG8_WAIT_V(2); PG8_BAR;
        PG8_STAGE(PG8_SB(1, 0), cB + kstep, voffB); PG8_STAGE(PG8_SA(1, 0), cA + kstep, voffA); PG8_STAGE(PG8_SB(1, 1), cB + hstep + kstep, voffB);
        PG8_WAIT_V(6); PG8_BAR;
    } else {
        PG8_STAGE(PG8_SB(0, 0), cB, voffB); PG8_STAGE(PG8_SA(0, 0), cA, voffA); PG8_STAGE(PG8_SB(0, 1), cB + hstep, voffB); PG8_STAGE(PG8_SA(0, 1), cA + hstep, voffA);
        if (wr == 1) PG8_BAR;
        PG8_WAIT_V(4); PG8_BAR;
        PG8_STAGE(PG8_SB(1, 0), cB + kstep, voffB); PG8_STAGE(PG8_SA(1, 0), cA + kstep, voffA); PG8_STAGE(PG8_SB(1, 1), cB + hstep + kstep, voffB);
        PG8_WAIT_V(6); PG8_BAR;
    }
    for (;;) {
        const bool has_next = S.next(ui + 1, nxt);
        const char* nA = has_next ? (const char*)g.A + (size_t)nxt.pm * tstep : cA; const char* nB = has_next ? (const char*)g.Bt + (size_t)nxt.pn * tstep : cB;
        for (int t = 0; t < nt; t += 2) {
            const bool last = (t == nt - 2);
            const char* a1 = cA + (size_t)(t + 1) * kstep;
            const char* a2 = last ? nA : cA + (size_t)(t + 2) * kstep; const char* b2 = last ? nB : cB + (size_t)(t + 2) * kstep;
            const char* a3 = a2 + kstep; const char* b3 = b2 + kstep;
            if (last && has_next) S.a_ready(nxt);
            if constexpr (SP2) {
            PG8_LDB(B0, 0, 0); PG8_LDB(B1, 0, 1); PG8_SCHED; PG8_LDA(At, 0, 0); PG8_STAGE(PG8_SA(1, 1), a1 + hstep, voffA);
            PG8_WAIT_V(8); PG8_WAIT_L(0); PG8_BAR; PG8_MMA(0, 0, At, B0); PG8_MMA(0, 1, At, B1); PG8_BAR; PG8_SCHED;
            PG8_LDA(At, 0, 1); PG8_STAGE(PG8_SB(0, 0), b2, voffB); PG8_STAGE(PG8_SB(0, 1), b2 + hstep, voffB); PG8_STAGE(PG8_SA(0, 0), a2, voffA);
            PG8_WAIT_V(8); PG8_WAIT_L(0); PG8_BAR; PG8_MMA(1, 0, At, B0); PG8_MMA(1, 1, At, B1); PG8_BAR; PG8_SCHED;
            PG8_LDB(B0, 1, 0); PG8_LDB(B1, 1, 1); PG8_SCHED; PG8_LDA(At, 1, 0); PG8_STAGE(PG8_SA(0, 1), a2 + hstep, voffA);
            PG8_WAIT_V(8); PG8_WAIT_L(0); PG8_BAR; PG8_MMA(0, 0, At, B0); PG8_MMA(0, 1, At, B1); PG8_BAR; PG8_SCHED;
            PG8_LDA(At, 1, 1); PG8_STAGE(PG8_SB(1, 0), b3, voffB); PG8_STAGE(PG8_SB(1, 1), b3 + hstep, voffB); PG8_STAGE(PG8_SA(1, 0), a3, voffA);
            PG8_WAIT_V(8); PG8_WAIT_L(0); PG8_BAR; PG8_MMA(1, 0, At, B0); PG8_MMA(1, 1, At, B1); PG8_BAR; PG8_SCHED;
            } else {
            PG8_LDB(B0, 0, 0); PG8_SCHED; PG8_LDA(At, 0, 0); PG8_STAGE(PG8_SA(1, 1), a1 + hstep, voffA);
            PG8_WAIT_L(8); PG8_BAR; PG8_WAIT_L(0); PG8_MMA(0, 0, At, B0); PG8_BAR; PG8_SCHED;
            PG8_LDB(B1, 0, 1); PG8_STAGE(PG8_SB(0, 0), b2, voffB);
            PG8_BAR; PG8_WAIT_L(0); PG8_MMA(0, 1, At, B1); PG8_BAR;
            PG8_LDA(At, 0, 1); PG8_STAGE(PG8_SA(0, 0), a2, voffA);
            PG8_BAR; PG8_WAIT_L(0); PG8_MMA(1, 0, At, B0); PG8_BAR; PG8_SCHED;
            PG8_STAGE(PG8_SB(0, 1), b2 + hstep, voffB);
            PG8_WAIT_V(6); PG8_BAR; PG8_MMA(1, 1, At, B1); PG8_BAR;
            PG8_LDB(B0, 1, 0); PG8_SCHED; PG8_LDA(At, 1, 0); PG8_STAGE(PG8_SA(0, 1), a2 + hstep, voffA);
            PG8_WAIT_L(8); PG8_BAR; PG8_WAIT_L(0); PG8_MMA(0, 0, At, B0); PG8_BAR; PG8_SCHED;
            PG8_LDB(B1, 1, 1); PG8_STAGE(PG8_SB(1, 0), b3, voffB);
            PG8_BAR; PG8_WAIT_L(0); PG8_MMA(0, 1, At, B1); PG8_BAR;
            PG8_LDA(At, 1, 1); PG8_STAGE(PG8_SA(1, 0), a3, voffA);
            PG8_BAR; PG8_WAIT_L(0); PG8_MMA(1, 0, At, B0); PG8_BAR; PG8_SCHED;
            PG8_STAGE(PG8_SB(1, 1), b3 + hstep, voffB);
            PG8_WAIT_V(6); PG8_BAR; PG8_MMA(1, 1, At, B1); PG8_BAR;
            }
        }
        if constexpr (ALIGN_EPI) { if (wr == 0) PG8_BAR; }
        if constexpr (!Epi::AFTER_DRAIN) { E(acc, cur, wr, wc, fr, fq); S.done(cur); }
        if (!has_next) break;
#pragma unroll
        for (int a = 0; a < 2; ++a)
#pragma unroll
            for (int b = 0; b < 2; ++b)
#pragma unroll
                for (int m = 0; m < 4; ++m)
#pragma unroll
                    for (int n = 0; n < 2; ++n) acc[a][b][m][n] = (f32x4){0.f, 0.f, 0.f, 0.f};
        cur = nxt; cA = nA; cB = nB; ++ui;
        if constexpr (ALIGN_EPI) { if (wr == 1) PG8_BAR; }
    }
    PG8_WAIT_V(0);
    if constexpr (!ALIGN_EPI) { if (wr == 0) PG8_BAR; }
    PG8_BAR;
    if constexpr (Epi::AFTER_DRAIN) { E.fused(acc, cur, wr, wc, fr, fq, lds, wid, lane); S.done(cur); }
#undef PG8_SA
#undef PG8_SB
#undef PG8_STAGE
#undef PG8_LDA
#undef PG8_LDB
#undef PG8_MMA
#undef PG8_WAIT_V
#undef PG8_WAIT_L
#undef PG8_BAR
#undef PG8_SCHED
}
template <class Epi, class Sched>
__device__ __forceinline__ void gemm_phase_ga(PG8_LAS unsigned char* lds, const Gemm g, const Sched& S, const Epi& E) {
    const int tid = threadIdx.x, wid = __builtin_amdgcn_readfirstlane(tid >> 6), lane = tid & 63, wr = wid >> 2, wc = wid & 3, fr = lane & 15, fq = lane >> 4;
    constexpr bool ALIGN_EPI = true, SP2 = true;
    const int K = g.K, nt = K / BK;
    unsigned voffB[2]; int RA[2]; unsigned CA[2]; unsigned vA[2][2], vAn[2][2];
#pragma unroll
    for (int i = 0; i < 2; ++i) { int R, C; stage_rc(tid * 16 + i * 8192, R, C); const int Rb = Epi::PERM ? ((R & ~31) + perm32(R & 31)) : R;
        RA[i] = R; CA[i] = (unsigned)C * 2u; voffB[i] = (unsigned)(Rb * K + C) * 2u; }
    const size_t kstep = (size_t)(BK * 2);
    const size_t hstep = (size_t)HALF * K * 2;
    const size_t tstep = 2 * hstep;
    const unsigned ldsw = (unsigned)wid * 1024u;
    const int aoff = lds_byte(wr * 64 + fr, fq * 8), boff = lds_byte(wc * 32 + fr, fq * 8);
#define PG8_SA(b, h) (((b) * 2 + (h)) * HTB)
#define PG8_SB(b, h) ((4 + (b) * 2 + (h)) * HTB)
#define PG8_STAGE(bufoff, gbase, voff) do { _Pragma("unroll") for (int _i = 0; _i < 2; ++_i) \
        __builtin_amdgcn_global_load_lds((const unsigned*)((const char*)(gbase) + (voff)[_i]), (PG8_LAS unsigned*)(lds + (bufoff) + ldsw + _i * 8192), 16, 0, 0); } while (0)
#define PG8_LDA(dst, b, h) do { _Pragma("unroll") for (int m = 0; m < 4; ++m) _Pragma("unroll") for (int k = 0; k < 2; ++k) dst[m][k] = *(const PG8_LAS bf16x8*)(lds + PG8_SA(b, h) + aoff + m * 2048 + k * 1024); } while (0)
#define PG8_LDB(dst, b, h) do { _Pragma("unroll") for (int n = 0; n < 2; ++n) _Pragma("unroll") for (int k = 0; k < 2; ++k) dst[n][k] = *(const PG8_LAS bf16x8*)(lds + PG8_SB(b, h) + boff + n * 2048 + k * 1024); } while (0)
#define PG8_MMA(ai, bj, At, Bt) do { __builtin_amdgcn_s_setprio(1); _Pragma("unroll") for (int m = 0; m < 4; ++m) _Pragma("unroll") for (int n = 0; n < 2; ++n) _Pragma("unroll") for (int k = 0; k < 2; ++k) \
        acc[ai][bj][m][n] = __builtin_amdgcn_mfma_f32_16x16x32_bf16(Bt[n][k], At[m][k], acc[ai][bj][m][n], 0, 0, 0); __builtin_amdgcn_s_setprio(0); } while (0)
#define PG8_WAIT_V(n) asm volatile("s_waitcnt vmcnt(" #n ")" ::: "memory")
#define PG8_WAIT_L(n) asm volatile("s_waitcnt lgkmcnt(" #n ")" ::: "memory")
#define PG8_BAR __builtin_amdgcn_s_barrier()
#define PG8_SCHED __builtin_amdgcn_sched_barrier(0)
    Unit cur, nxt; int ui = 0;
    if (!S.next(0, cur)) return;
    f32x4 acc[2][2][4][2];
#pragma unroll
    for (int a = 0; a < 2; ++a)
#pragma unroll
        for (int b = 0; b < 2; ++b)
#pragma unroll
            for (int m = 0; m < 4; ++m)
#pragma unroll
                for (int n = 0; n < 2; ++n) acc[a][b][m][n] = (f32x4){0.f, 0.f, 0.f, 0.f};
    bf16x8 At[4][2], B0[2][2], B1[2][2];
    const char* cA = (const char*)g.A; const char* cB = (const char*)g.Bt + (size_t)cur.pn * tstep;
#pragma unroll
    for (int h = 0; h < 2; ++h)
#pragma unroll
        for (int i = 0; i < 2; ++i) vA[h][i] = (unsigned)S.arow(cur, RA[i] + 128 * h) * (unsigned)(K * 2) + CA[i];
    S.a_ready(cur);
    if constexpr (SP2) {
        PG8_STAGE(PG8_SB(0, 0), cB, voffB); PG8_STAGE(PG8_SB(0, 1), cB + hstep, voffB); PG8_STAGE(PG8_SA(0, 0), cA, vA[0]); PG8_STAGE(PG8_SA(0, 1), cA, vA[1]);
        if (wr == 1) PG8_BAR;
        PG8_WAIT_V(2); PG8_BAR;
        PG8_STAGE(PG8_SB(1, 0), cB + kstep, voffB); PG8_STAGE(PG8_SA(1, 0), cA + kstep, vA[0]); PG8_STAGE(PG8_SB(1, 1), cB + hstep + kstep, voffB);
        PG8_WAIT_V(6); PG8_BAR;
    }
    for (;;) {
        const bool has_next = S.next(ui + 1, nxt);
        const char* nB = has_next ? (const char*)g.Bt + (size_t)nxt.pn * tstep : cB;
#pragma unroll
        for (int h = 0; h < 2; ++h)
#pragma unroll
            for (int i = 0; i < 2; ++i) vAn[h][i] = has_next ? (unsigned)S.arow(nxt, RA[i] + 128 * h) * (unsigned)(K * 2) + CA[i] : vA[h][i];
        for (int t = 0; t < nt; t += 2) {
            const bool last = (t == nt - 2);
            const char* a1 = cA + (size_t)(t + 1) * kstep;
            const char* a2 = last ? cA : cA + (size_t)(t + 2) * kstep;
            unsigned w2[2][2];
            _Pragma("unroll") for (int h = 0; h < 2; ++h) _Pragma("unroll") for (int i = 0; i < 2; ++i) w2[h][i] = last ? vAn[h][i] : vA[h][i]; const char* b2 = last ? nB : cB + (size_t)(t + 2) * kstep;
            const char* a3 = a2 + kstep; const char* b3 = b2 + kstep;
            if (last && has_next) S.a_ready(nxt);
            if constexpr (SP2) {
            PG8_LDB(B0, 0, 0); PG8_LDB(B1, 0, 1); PG8_SCHED; PG8_LDA(At, 0, 0); PG8_STAGE(PG8_SA(1, 1), a1, vA[1]);
            PG8_WAIT_V(8); PG8_WAIT_L(0); PG8_BAR; PG8_MMA(0, 0, At, B0); PG8_MMA(0, 1, At, B1); PG8_BAR; PG8_SCHED;
            PG8_LDA(At, 0, 1); PG8_STAGE(PG8_SB(0, 0), b2, voffB); PG8_STAGE(PG8_SB(0, 1), b2 + hstep, voffB); PG8_STAGE(PG8_SA(0, 0), a2, w2[0]);
            PG8_WAIT_V(8); PG8_WAIT_L(0); PG8_BAR; PG8_MMA(1, 0, At, B0); PG8_MMA(1, 1, At, B1); PG8_BAR; PG8_SCHED;
            PG8_LDB(B0, 1, 0); PG8_LDB(B1, 1, 1); PG8_SCHED; PG8_LDA(At, 1, 0); PG8_STAGE(PG8_SA(0, 1), a2, w2[1]);
            PG8_WAIT_V(8); PG8_WAIT_L(0); PG8_BAR; PG8_MMA(0, 0, At, B0); PG8_MMA(0, 1, At, B1); PG8_BAR; PG8_SCHED;
            PG8_LDA(At, 1, 1); PG8_STAGE(PG8_SB(1, 0), b3, voffB); PG8_STAGE(PG8_SB(1, 1), b3 + hstep, voffB); PG8_STAGE(PG8_SA(1, 0), a3, w2[0]);
            PG8_WAIT_V(8); PG8_WAIT_L(0); PG8_BAR; PG8_MMA(1, 0, At, B0); PG8_MMA(1, 1, At, B1); PG8_BAR; PG8_SCHED;
            }
        }
        if constexpr (ALIGN_EPI) { if (wr == 0) PG8_BAR; }
        if constexpr (!Epi::AFTER_DRAIN) { E(acc, cur, wr, wc, fr, fq); S.done(cur); }
        if (!has_next) break;
#pragma unroll
        for (int a = 0; a < 2; ++a)
#pragma unroll
            for (int b = 0; b < 2; ++b)
#pragma unroll
                for (int m = 0; m < 4; ++m)
#pragma unroll
                    for (int n = 0; n < 2; ++n) acc[a][b][m][n] = (f32x4){0.f, 0.f, 0.f, 0.f};
        cur = nxt; cB = nB; ++ui;
#pragma unroll
        for (int h = 0; h < 2; ++h)
#pragma unroll
            for (int i = 0; i < 2; ++i) vA[h][i] = vAn[h][i];
        if constexpr (ALIGN_EPI) { if (wr == 1) PG8_BAR; }
    }
    PG8_WAIT_V(0);
    if constexpr (!ALIGN_EPI) { if (wr == 0) PG8_BAR; }
    PG8_BAR;
    if constexpr (Epi::AFTER_DRAIN) { E.fused(acc, cur, wr, wc, fr, fq, lds, wid, lane); S.done(cur); }
#undef PG8_SA
#undef PG8_SB
#undef PG8_STAGE
#undef PG8_LDA
#undef PG8_LDB
#undef PG8_MMA
#undef PG8_WAIT_V
#undef PG8_WAIT_L
#undef PG8_BAR
#undef PG8_SCHED
}
}

constexpr int NWAVES = 8;
constexpr int NPHASE = 10;
#ifndef MK_N_LAUNCHES
#define MK_N_LAUNCHES 1
#endif
constexpr int N_LAUNCHES = MK_N_LAUNCHES;

constexpr int D = 1024, BATCH = 8, SEQ = 2048, CTX = 256;
constexpr int NX = BATCH * SEQ, NC = BATCH * CTX, NROWS = NX + NC;
constexpr int PW = 4096;
constexpr int NEXP = 32, TOPK = 4, DFF = 1024;
constexpr int MAXRT = 288;
constexpr float EPS = 1e-6f;

constexpr size_t MiB = 1u << 20;
constexpr size_t WS_CTL = 0, CTL_ZERO_BYTES = 1 * MiB;
constexpr size_t WS_MOD = 1 * MiB;
constexpr size_t WS_LB = 1 * MiB + 512 * 1024;
constexpr size_t WS_COS = WS_LB + 4096, WS_SIN = WS_COS + 2048 * 32 * 4;
constexpr size_t WS_TOKE = 2 * MiB, WS_TOKPOS = WS_TOKE + 256 * 1024, WS_TOKGATE = WS_TOKPOS + 256 * 1024, WS_TOKROW = WS_TOKGATE + 256 * 1024, WS_ROWGATE = WS_TOKROW + 256 * 1024;
constexpr size_t WS_WIN = 4 * MiB, WS_WOUT = 12 * MiB, WS_W1 = 14 * MiB, WS_W2 = 142 * MiB;
constexpr size_t WS_XN = 206 * MiB, WS_P = 242 * MiB, WS_XG = WS_P, WS_OF = 386 * MiB, WS_OB = 418 * MiB, WS_AO = 450 * MiB;
constexpr size_t WS_H = 482 * MiB, WS_VX = 546 * MiB, WS_ACT = 578 * MiB, WS_YB = 722 * MiB, WS_END = 866 * MiB;
constexpr size_t WS_EXPL = WS_P, WS_EXPG = WS_P + 2 * MiB;
constexpr int CW_TMO = 0, CW_CODE = 1, CW_BAR = 4096, CW_CNT = 8192;

constexpr int LCTL_BYTES = 2048, SCR_OFF = LCTL_BYTES, LDS_BYTES = 147456;
constexpr int L_MISC = 0;
constexpr int L_TSTART = 128;
constexpr int L_TILEE = 384;
constexpr int L_LCNT = 1600;
constexpr int L_GBASE = 1728;

#define GAS __attribute__((address_space(1)))
#define LAS __attribute__((address_space(3)))
typedef unsigned short bf16;
typedef unsigned v4u __attribute__((ext_vector_type(4)));
typedef unsigned v2u __attribute__((ext_vector_type(2)));
typedef float f32x4 __attribute__((ext_vector_type(4)));
typedef float f32x2 __attribute__((ext_vector_type(2)));
typedef short bf16x8 __attribute__((ext_vector_type(8)));
typedef GAS unsigned gu32;
#define RLX_AGENT __ATOMIC_RELAXED, __HIP_MEMORY_SCOPE_AGENT
#define LDS_WAIT() asm volatile("s_waitcnt lgkmcnt(0)" ::: "memory")
#define VM_WAIT() asm volatile("s_waitcnt vmcnt(0)" ::: "memory")
#define LBAR() do { asm volatile("s_waitcnt lgkmcnt(0)" ::: "memory"); __builtin_amdgcn_s_barrier(); asm volatile("" ::: "memory"); } while (0)
__device__ __forceinline__ unsigned f2bf(float f) { unsigned u = __builtin_bit_cast(unsigned, f); return (u + 0x7fffu + ((u >> 16) & 1u)) >> 16; }
__device__ __forceinline__ unsigned pk2(float lo, float hi) { return f2bf(lo) | (f2bf(hi) << 16); }
__device__ __forceinline__ float bflo(unsigned u) { return __builtin_bit_cast(float, u << 16); }
__device__ __forceinline__ float bfhi(unsigned u) { return __builtin_bit_cast(float, u & 0xffff0000u); }
__device__ __forceinline__ float wave_sum(float v) {
#pragma unroll
    for (int o = 1; o < 64; o <<= 1) v += __shfl_xor(v, o);
    return v;
}
__device__ __forceinline__ float sigmoidf_(float x) { return 1.f / (1.f + __expf(-x)); }
__device__ __forceinline__ float siluf_(float x) { return x / (1.f + __expf(-x)); }

#define XB_TMO      128
#define XB_XCNT(j)  (256  + 64 * (j))
#define XB_XSUB(j)  (1280 + 64 * (j))
#define XB_XGEN(j)  (2304 + 64 * (j))
#define XB_TOP      3328
#define XB_TOPGEN   3392
#define XCD_BAR_WORDS 3456
#define XB_SPIN_CAP (1u << 18)

__device__ __forceinline__ unsigned xb_ld(unsigned* p)              { return __hip_atomic_load(p, __ATOMIC_RELAXED, __HIP_MEMORY_SCOPE_AGENT); }
__device__ __forceinline__ unsigned xb_add(unsigned* p, unsigned v) { return __hip_atomic_fetch_add(p, v, __ATOMIC_RELAXED, __HIP_MEMORY_SCOPE_AGENT); }
__device__ __forceinline__ unsigned xb_xcc_id() { return (unsigned)__builtin_amdgcn_s_getreg((3 << 11) | 20) & 0xFu; }
#define XB_SPIN(cond, bar) do { unsigned _sp = 0; while (cond) { __builtin_amdgcn_s_sleep(1); \
    if ((++_sp & 255u) == 0u) { if (xb_ld(&(bar)[XB_TMO])) break; if (_sp > XB_SPIN_CAP) { atomicAdd(&(bar)[XB_TMO], 1u); break; } } } } while (0)

struct XcdBarrier {
    unsigned* bar; unsigned x;
    volatile LAS unsigned* st;
};

__device__ __forceinline__ XcdBarrier xcd_barrier_post(unsigned* bar, volatile LAS unsigned* st) {
    XcdBarrier b; b.bar = bar; b.x = xb_xcc_id(); b.st = st;
    if (threadIdx.x == 0) (void)xb_add(&bar[XB_XCNT(b.x)], 1u);
    return b;
}
__device__ __forceinline__ void xcd_barrier_complete(unsigned* bar, unsigned x, unsigned& nloc, unsigned& nx) {
    const unsigned G = gridDim.x * gridDim.y * gridDim.z;
    unsigned sum, cnt, mine, sp = 0u;
    for (;;) {
        sum = 0u; cnt = 0u; mine = 0u;
#pragma unroll
        for (unsigned j = 0; j < 16; ++j) { const unsigned c = xb_ld(&bar[XB_XCNT(j)]); sum += c; cnt += (c > 0u) ? 1u : 0u; mine = (j == x) ? c : mine; }
        if (sum == G) break;
        __builtin_amdgcn_s_sleep(1);
        if ((++sp & 255u) == 0u) { if (xb_ld(&bar[XB_TMO])) break; if (sp > XB_SPIN_CAP) { atomicAdd(&bar[XB_TMO], 1u); break; } }
    }
    nloc = mine > 0u ? mine : 1u; nx = cnt > 0u ? cnt : 1u;
}

__device__ __forceinline__ void xcd_barrier(const XcdBarrier& b) {
    asm volatile("s_waitcnt vmcnt(0)" ::: "memory");
    __syncthreads();
    if (threadIdx.x == 0) {
        unsigned* bar = b.bar;
        __builtin_amdgcn_s_waitcnt(0);
        unsigned nloc = b.st[0], nx = b.st[1];
        if (nloc == 0u) { xcd_barrier_complete(bar, b.x, nloc, nx); b.st[0] = nloc; b.st[1] = nx; }
        const unsigned old = xb_add(&bar[XB_XSUB(b.x)], 1u);
        const unsigned gen = old / nloc;
        if (old + 1u == (gen + 1u) * nloc) {
            __builtin_amdgcn_fence(__ATOMIC_RELEASE, "agent");
            asm volatile("s_waitcnt vmcnt(0)" ::: "memory");
            const unsigned og = xb_add(&bar[XB_TOP], 1u);
            const unsigned tg = og / nx;
            if (og + 1u == (tg + 1u) * nx) xb_add(&bar[XB_TOPGEN], 1u);
            else XB_SPIN(xb_ld(&bar[XB_TOPGEN]) == tg, bar);
            __builtin_amdgcn_fence(__ATOMIC_ACQUIRE, "agent");
            xb_add(&bar[XB_XGEN(b.x)], 1u);
            asm volatile("s_waitcnt vmcnt(0)" ::: "memory");
        } else {
            XB_SPIN(xb_ld(&bar[XB_XGEN(b.x)]) == gen, bar);
            __builtin_amdgcn_fence(__ATOMIC_ACQUIRE, "agent");
            asm volatile("s_waitcnt vmcnt(0)" ::: "memory");
        }
    }
    __syncthreads();
}


struct Frame {
    LAS unsigned char* lds;
    gu32* ctl;
    int tid, lane, wave, vcu, G;
    const float* in[19];
    float* out;
    unsigned char* ws;
};
#define IN_X 0
#define IN_C 1
#define IN_CTX 2
#define IN_CCTX 3
#define IN_WADA 4
#define IN_BADA 5
#define IN_NMIX 6
#define IN_NFFN 7
#define IN_WIN 8
#define IN_WOUT 9
#define IN_HGLB 10
#define IN_HGNW 11
#define IN_RW 12
#define IN_RB 13
#define IN_W1 14
#define IN_B1 15
#define IN_W2 16
#define IN_B2 17
#define IN_NFIN 18

struct TItem { const float* src; bf16* dst; int ldw, kind, n0, k0; };
__device__ __forceinline__ int t_prow(int kind, int n) {
    if (kind == 1) { if (n < 512) { const int l = n & 255; return (n & ~255) + 128 * ((l >> 5) & 1) + 32 * (l >> 6) + (l & 31); } return n; }
    if (kind == 2) { const int half = n >> 10, r = n & 1023; return 256 * (r >> 7) + 128 * half + (r & 127); }
    return n;
}
__device__ __forceinline__ bool t_decode(const Frame& F, int it, TItem& T) {
    constexpr int I_IN = 16 * 64, I_OUT = 16 * 16, I_W1 = 32 * 16 * 32, I_W2 = 32 * 16 * 16, NITEMS = I_IN + I_OUT + I_W1 + I_W2;
    if (it >= NITEMS) return false;
    int r = it;
    if (r < I_IN) { T.src = F.in[IN_WIN]; T.dst = (bf16*)(F.ws + WS_WIN); T.ldw = PW; T.kind = 1; T.k0 = (r & 15) * 64; T.n0 = (r >> 4) * 64; return true; }
    r -= I_IN;
    if (r < I_OUT) { T.src = F.in[IN_WOUT]; T.dst = (bf16*)(F.ws + WS_WOUT); T.ldw = D; T.kind = 0; T.k0 = (r & 15) * 64; T.n0 = (r >> 4) * 64; return true; }
    r -= I_OUT;
    if (r < I_W1) { const int e = r >> 9, q = r & 511; T.src = F.in[IN_W1] + (size_t)e * 1024 * 2048; T.dst = (bf16*)(F.ws + WS_W1) + (size_t)e * 2048 * 1024; T.ldw = 2048; T.kind = 2; T.k0 = (q & 15) * 64; T.n0 = (q >> 4) * 64; return true; }
    r -= I_W1;
    { const int e = r >> 8, q = r & 255; T.src = F.in[IN_W2] + (size_t)e * 1024 * 1024; T.dst = (bf16*)(F.ws + WS_W2) + (size_t)e * 1024 * 1024; T.ldw = 1024; T.kind = 0; T.k0 = (q & 15) * 64; T.n0 = (q >> 4) * 64; return true; }
}
__device__ __forceinline__ void t_load(const TItem& T, float (&v)[64], int lane) {
    const float* s = T.src + (size_t)T.k0 * T.ldw + T.n0 + lane;
#pragma unroll
    for (int i = 0; i < 64; ++i) v[i] = s[(size_t)i * T.ldw];
}
__device__ __forceinline__ void t_store(const TItem& T, const float (&v)[64], LAS float* scr, int lane) {
#pragma unroll
    for (int i = 0; i < 64; ++i) scr[i * 65 + lane] = v[i];
    LDS_WAIT(); asm volatile("" ::: "memory");
    const int c = lane & 7;
#pragma unroll
    for (int j = 0; j < 8; ++j) { const int n = (lane >> 3) + 8 * j; const LAS float* s = scr + (8 * c) * 65 + n;
        v4u o; o.x = pk2(s[0 * 65], s[1 * 65]); o.y = pk2(s[2 * 65], s[3 * 65]); o.z = pk2(s[4 * 65], s[5 * 65]); o.w = pk2(s[6 * 65], s[7 * 65]);
        *(GAS v4u*)(T.dst + (size_t)t_prow(T.kind, T.n0 + n) * 1024 + T.k0 + 8 * c) = o; }
    LDS_WAIT(); asm volatile("" ::: "memory");
}
__device__ __forceinline__ void p0_prologue(Frame& F) {
    const int gw = F.vcu * NWAVES + F.wave, NGW = F.G * NWAVES;
    float* MOD = (float*)(F.ws + WS_MOD);
    for (int cg = F.vcu; cg < 96; cg += F.G) {
        LAS float* sl = (LAS float*)(F.lds + SCR_OFF);
        LAS float* red = sl + 9 * 1024;
        for (int i = F.tid; i < 9 * 1024; i += NWAVES * 64) { const int b = i >> 10, k = i & 1023; const float cv = b < 8 ? F.in[IN_C][b * 1024 + k] : F.in[IN_CCTX][k]; sl[i] = siluf_(cv); }
        __syncthreads();
        const int j = 64 * cg + F.lane; const int kb = 128 * F.wave;
        const float* wa = F.in[IN_WADA] + (size_t)kb * 6144 + j;
        float acc[9];
#pragma unroll
        for (int b = 0; b < 9; ++b) acc[b] = 0.f;
#pragma unroll 1
        for (int k = 0; k < 128; k += 32) {
            float w[32];
#pragma unroll
            for (int i = 0; i < 32; ++i) w[i] = wa[(size_t)(k + i) * 6144];
#pragma unroll
            for (int b = 0; b < 9; ++b)
#pragma unroll
                for (int i = 0; i < 32; i += 4) { const f32x4 s0 = *(const LAS f32x4*)(sl + b * 1024 + kb + k + i); acc[b] += s0[0] * w[i] + s0[1] * w[i + 1] + s0[2] * w[i + 2] + s0[3] * w[i + 3]; }
        }
#pragma unroll
        for (int b = 0; b < 9; ++b) red[(F.wave * 9 + b) * 64 + F.lane] = acc[b];
        __syncthreads();
        for (int i = F.tid; i < 9 * 64; i += NWAVES * 64) { const int b = i >> 6, l = i & 63; float s = F.in[IN_BADA][64 * cg + l];
#pragma unroll
            for (int w8 = 0; w8 < 8; ++w8) s += red[(w8 * 9 + b) * 64 + l];
            MOD[b * 6144 + 64 * cg + l] = s; }
        __syncthreads();
    }
    if (F.vcu == F.G - 1) {
        float* LB = (float*)(F.ws + WS_LB); float* COS = (float*)(F.ws + WS_COS); float* SIN = (float*)(F.ws + WS_SIN);
        for (int i = F.tid; i < 1024; i += NWAVES * 64) { const float a0 = F.in[IN_HGLB][i], a1 = F.in[IN_HGLB][1024 + i]; LB[i] = 1.f / (1.f + expf(a1 - a0)); }
        for (int i = F.tid; i < 2048 * 32; i += NWAVES * 64) { const int n = i >> 5, j = i & 31, fi = j & 15; const float pos = (float)(j < 16 ? (n >> 6) : (n & 63));
            const float inv = powf(10000.f, -(float)fi / 16.f); const float ang = pos * inv; COS[i] = cosf(ang); SIN[i] = sinf(ang); }
    }
    LAS float* scr = (LAS float*)(F.lds + SCR_OFF + F.wave * 16640);
    int it = NGW - 1 - gw; TItem cur, nxt; float va[64], vb[64];
    bool has = t_decode(F, it, cur);
    if (has) t_load(cur, va, F.lane);
    while (has) {
        it += NGW; const bool hn = t_decode(F, it, nxt);
        if (hn) t_load(nxt, vb, F.lane);
        t_store(cur, va, scr, F.lane);
        has = hn; if (!has) break;
        cur = nxt;
        it += NGW; const bool hn2 = t_decode(F, it, nxt);
        if (hn2) t_load(nxt, va, F.lane);
        t_store(cur, vb, scr, F.lane);
        has = hn2; cur = nxt;
    }
}

__device__ __forceinline__ void p1_xn(Frame& F) {
    const int gw = F.vcu * NWAVES + F.wave, NGW = F.G * NWAVES;
    const float* MOD = (const float*)(F.ws + WS_MOD); bf16* XN = (bf16*)(F.ws + WS_XN);
    for (int m = gw; m < NROWS; m += NGW) {
        const float* src = m < NX ? F.in[IN_X] + (size_t)m * D : F.in[IN_CTX] + (size_t)(m - NX) * D; const int b = m < NX ? (m >> 11) : 8;
        const GAS f32x4* xr = (const GAS f32x4*)src + F.lane; f32x4 v[4]; float s = 0.f;
#pragma unroll
        for (int j = 0; j < 4; ++j) { v[j] = xr[64 * j]; s += (v[j].x * v[j].x + v[j].y * v[j].y) + (v[j].z * v[j].z + v[j].w * v[j].w); }
        const float rinv = 1.f / sqrtf(wave_sum(s) * (1.f / D) + EPS);
        GAS v2u* o8 = (GAS v2u*)(XN + (size_t)m * D) + F.lane;
#pragma unroll
        for (int j = 0; j < 4; ++j) { const int k = 4 * F.lane + 256 * j;
            const f32x4 nw = *(const f32x4*)(F.in[IN_NMIX] + k), sh = *(const f32x4*)(MOD + b * 6144 + k), sc = *(const f32x4*)(MOD + b * 6144 + 1024 + k);
            const f32x4 u = v[j] * rinv * nw * (sc + 1.f) + sh; v2u w; w.x = pk2(u.x, u.y); w.y = pk2(u.z, u.w); o8[64 * j] = w; }
    }
}

struct InProjOrder {
    int G, c;
    __device__ __forceinline__ bool next(int i, pg8::Unit& u) const {
        const int L = i * G + c;
        if (L < 1024) { pg8::StaticOrder S; S.init(NX, PW, 1 << 30, L); return S.next(0, u); }
        if (L < 1024 + 72) { const int j = L - 1024, ti = j >> 3; u.pm = 64 + (j & 7); u.pn = ti < 3 ? 1 + ti : 5 + ti; return true; }
        return false;
    }
    __device__ __forceinline__ void a_ready(const pg8::Unit&) const {}
    __device__ __forceinline__ void done(const pg8::Unit&) const {}
};
struct EpiInProj {
    static constexpr bool PERM = true, AFTER_DRAIN = false;
    bf16* P; const float* LB; const float* COS; const float* SIN;
    __device__ __forceinline__ void operator()(const f32x4 (&acc)[2][2][4][2], const pg8::Unit& u, int wr, int wc, int fr, int fq) const {
        const int t = u.pn; const int row0 = u.pm * 256 + wr * 64 + fr; const int cb = wc * 32 + 8 * fq;
        if (t < 2) {
            const bool isx = u.pm < 64; const float sc = t == 1 ? 0.125f : 1.f;
#pragma unroll
            for (int ai = 0; ai < 2; ++ai)
#pragma unroll
                for (int m = 0; m < 4; ++m) { const int r = row0 + ai * 128 + m * 16; f32x4 c0, c1, s0, s1;
                    if (isx) { const int pos = r & 2047; c0 = *(const f32x4*)(COS + pos * 32 + 8 * fq); c1 = *(const f32x4*)(COS + pos * 32 + 8 * fq + 4); s0 = *(const f32x4*)(SIN + pos * 32 + 8 * fq); s1 = *(const f32x4*)(SIN + pos * 32 + 8 * fq + 4); }
                    else { c0 = (f32x4){1.f, 1.f, 1.f, 1.f}; c1 = c0; s0 = (f32x4){0.f, 0.f, 0.f, 0.f}; s1 = s0; }
                    const f32x4 a0 = acc[ai][0][m][0] * sc, a1 = acc[ai][0][m][1] * sc, b0 = acc[ai][1][m][0] * sc, b1 = acc[ai][1][m][1] * sc;
                    const f32x4 o10 = a0 * c0 - b0 * s0, o11 = a1 * c1 - b1 * s1, o20 = a0 * s0 + b0 * c0, o21 = a1 * s1 + b1 * c1;
                    bf16* rp = P + (size_t)r * PW + 256 * t + 64 * wc + 8 * fq;
                    v4u w; w.x = pk2(o10[0], o10[1]); w.y = pk2(o10[2], o10[3]); w.z = pk2(o11[0], o11[1]); w.w = pk2(o11[2], o11[3]); *(v4u*)rp = w;
                    w.x = pk2(o20[0], o20[1]); w.y = pk2(o20[2], o20[3]); w.z = pk2(o21[0], o21[1]); w.w = pk2(o21[2], o21[3]); *(v4u*)(rp + 32) = w; }
            return;
        }
        const int mode = (t == 2 || t == 3 || t == 12 || t == 13) ? 0 : ((t >= 8 && t < 12) ? 2 : 1);
        f32x4 lb[2][2];
        if (mode == 2) {
#pragma unroll
            for (int bj = 0; bj < 2; ++bj)
#pragma unroll
                for (int n = 0; n < 2; ++n) lb[bj][n] = *(const f32x4*)(LB + ((t - 8) >> 1) * 512 + ((t & 1) << 8) + 128 * bj + cb + 4 * n);
        }
#pragma unroll
        for (int ai = 0; ai < 2; ++ai)
#pragma unroll
            for (int m = 0; m < 4; ++m) { const int r = row0 + ai * 128 + m * 16; bf16* rp = P + (size_t)r * PW + 256 * t + cb;
#pragma unroll
                for (int bj = 0; bj < 2; ++bj) { f32x4 v0 = acc[ai][bj][m][0], v1 = acc[ai][bj][m][1];
                    if (mode == 1) {
#pragma unroll
                        for (int i = 0; i < 4; ++i) { v0[i] = siluf_(v0[i]); v1[i] = siluf_(v1[i]); } }
                    else if (mode == 2) {
#pragma unroll
                        for (int i = 0; i < 4; ++i) { const float l0 = lb[bj][0][i], l1 = lb[bj][1][i]; v0[i] = __logf(l0 + (1.f - l0) * sigmoidf_(v0[i])); v1[i] = __logf(l1 + (1.f - l1) * sigmoidf_(v1[i])); } }
                    v4u w; w.x = pk2(v0[0], v0[1]); w.y = pk2(v0[2], v0[3]); w.z = pk2(v1[0], v1[1]); w.w = pk2(v1[2], v1[3]); *(v4u*)(rp + 128 * bj) = w; } }
    }
};

__device__ __forceinline__ bf16x8 ldfrag(const LAS unsigned char* base, int stride, int row0, int kb, int lane) {
    return *(const LAS bf16x8*)(base + (row0 + (lane & 15)) * stride + kb + 16 * (lane >> 4));
}
#define MFMA16(a, b, c) __builtin_amdgcn_mfma_f32_16x16x32_bf16((a), (b), (c), 0, 0, 0)
template <bool HG>
__device__ __forceinline__ void scan_chain(Frame& F, int b, int h, int dir, int dvh) {
    constexpr int DK = HG ? 128 : 64;
    constexpr int QS = DK * 2 + 16, SS = 64 * 2 + 16;
    constexpr int KROWS = HG ? 160 : 64;
    constexpr int O_QI = 0, O_QT = O_QI + 64 * QS, O_KIJ = O_QT + 64 * QS, O_KTT = O_KIJ + KROWS * QS, O_VT = O_KTT + DK * SS, O_PM = O_VT + 64 * SS, O_ST = O_PM + 64 * SS, O_T = O_ST + 64 * QS, O_GD = O_T + 4096, O_END = O_GD + 512;
    static_assert(SCR_OFF + O_END <= LDS_BYTES, "scan LDS");
    LAS unsigned char* L = F.lds + SCR_OFF;
    LAS unsigned char* Qi = L + O_QI; LAS unsigned char* Qt = L + O_QT; LAS unsigned char* Kij = L + O_KIJ; LAS unsigned char* Ktt = L + O_KTT;
    LAS unsigned char* Vt = L + O_VT; LAS unsigned char* Pm = L + O_PM; LAS unsigned char* St = L + O_ST;
    LAS float* T = (LAS float*)(L + O_T); LAS float* GD = (LAS float*)(L + O_GD);
    const int tid = F.tid, lane = F.lane, w = F.wave;
    const bf16* P = (const bf16*)(F.ws + WS_P);
    bf16* O = (bf16*)(F.ws + (dir ? WS_OB : WS_OF));
    const int qcol = HG ? 1536 + 128 * h : 64 * h;
    const int kcol = HG ? 2048 + 512 * dir + 128 * h : 256 + 64 * h;
    const int vcol = (HG ? 3072 : 512) + 128 * h + 64 * dvh;
    const int ocol = (HG ? 512 : 0) + 128 * h + 64 * dvh;
    const float lg = HG ? 0.f : log1pf(-exp2f(-(float)(dir ? 6 : 5) - 2.f * (float)h));
    for (int i = tid; i < (64 * SS) / 4; i += NWAVES * 64) ((LAS unsigned*)Pm)[i] = 0u;
    for (int i = tid; i < (64 * QS) / 4; i += NWAVES * 64) ((LAS unsigned*)St)[i] = 0u;
    constexpr int NVB = HG ? 4 : 2;
    f32x4 accS[NVB];
#pragma unroll
    for (int i = 0; i < NVB; ++i) accS[i] = (f32x4){0.f, 0.f, 0.f, 0.f};
    const int db = HG ? w : (w & 3);
    const int tb = w & 3, vb0 = 2 * (w >> 2);
    constexpr int TPT = HG ? 8 : 4;
    const int cp = HG ? lane : (tid & 31);
    const int tg = HG ? w : (tid >> 5);
    const int vp = tid >> 3, vs = tid & 7;
    unsigned qreg[TPT], kreg[TPT]; v4u vreg;
#define SCAN_ROW0(s) ((s) < 4 ? (NX + b * CTX + (dir ? 255 - 64 * (s) : 64 * (s))) : (b * SEQ + (dir ? 2047 - 64 * ((s) - 4) : 64 * ((s) - 4))))
#define SCAN_LOAD(s) do { const int r0_ = SCAN_ROW0(s); const int sg_ = dir ? -1 : 1; \
        _Pragma("unroll") for (int j = 0; j < TPT; ++j) { const bf16* rp_ = P + (size_t)(r0_ + sg_ * (TPT * tg + j)) * PW; \
            kreg[j] = *(const unsigned*)(rp_ + kcol + 2 * cp); qreg[j] = ((s) >= 4) ? *(const unsigned*)(rp_ + qcol + 2 * cp) : 0u; } \
        vreg = *(const v4u*)(P + (size_t)(r0_ + sg_ * vp) * PW + vcol + 8 * vs); } while (0)
    SCAN_LOAD(0);
    LBAR();
    for (int s = 0; s < 36; ++s) {
        const bool isx = s >= 4;
        const int r0 = SCAN_ROW0(s); const int sg = dir ? -1 : 1;
        {
            const unsigned vv[4] = {vreg.x, vreg.y, vreg.z, vreg.w};
#pragma unroll
            for (int e = 0; e < 4; ++e) { *(LAS unsigned short*)(Vt + (8 * vs + 2 * e) * SS + 2 * vp) = (unsigned short)(vv[e] & 0xffffu); *(LAS unsigned short*)(Vt + (8 * vs + 2 * e + 1) * SS + 2 * vp) = (unsigned short)(vv[e] >> 16); }
        }
        if constexpr (HG) {
            float c0[8], c1[8]; float run0 = 0.f, run1 = 0.f;
#pragma unroll
            for (int j = 0; j < 8; ++j) { run0 += bflo(kreg[j]); run1 += bfhi(kreg[j]); c0[j] = run0; c1[j] = run1; }
            *(LAS f32x2*)(T + w * 128 + 2 * cp) = (f32x2){run0, run1};
            LBAR();
            float pre0 = 0.f, pre1 = 0.f, base0 = 0.f, base1 = 0.f, bm0 = 0.f, bm1 = 0.f; float bs0[4], bs1[4];
            const int i_sub = w >> 1;
#pragma unroll
            for (int o = 0; o < 8; ++o) { const f32x2 tt = *(const LAS f32x2*)(T + o * 128 + 2 * cp);
                if (o == w) { base0 = pre0; base1 = pre1; }
                if ((o & 1) == 0) { bs0[o >> 1] = pre0; bs1[o >> 1] = pre1; if ((o >> 1) == i_sub) { bm0 = pre0; bm1 = pre1; } }
                pre0 += tt.x; pre1 += tt.y; }
            const float bend0 = pre0, bend1 = pre1;
            const float eBi0 = __expf(bm0), eBi1 = __expf(bm1), eEnd0 = __expf(bend0 - bm0), eEnd1 = __expf(bend1 - bm1);
            float gI0[4], gI1[4];
#pragma unroll
            for (int ii = 0; ii < 4; ++ii) { gI0[ii] = __expf(fminf(bs0[ii] - bm0, 0.f)); gI1[ii] = __expf(fminf(bs1[ii] - bm1, 0.f)); }
            if (w == 0) *(LAS f32x2*)(GD + 2 * cp) = (f32x2){__expf(bend0), __expf(bend1)};
            unsigned kt0[4], kt1[4];
#pragma unroll
            for (int j = 0; j < 8; ++j) {
                const int p = 8 * w + j;
                const float d0 = base0 + c0[j] - bm0, d1 = base1 + c1[j] - bm1;
                const float E0 = __expf(d0), E1 = __expf(d1), R0 = __expf(-d0), R1 = __expf(-d1);
                const float k0 = 1.f - __expf(bflo(kreg[j])), k1 = 1.f - __expf(bfhi(kreg[j]));
                const float kr0 = k0 * R0, kr1 = k1 * R1;
                const unsigned ktp = pk2(kr0 * eEnd0, kr1 * eEnd1);
                if ((j & 1) == 0) { kt0[j >> 1] = ktp & 0xffffu; kt1[j >> 1] = ktp >> 16; } else { kt0[j >> 1] |= ktp << 16; kt1[j >> 1] |= ktp & 0xffff0000u; }
                if (isx) {
                    const float q0 = bflo(qreg[j]), q1 = bfhi(qreg[j]);
                    const float qi0 = q0 * E0, qi1 = q1 * E1;
                    *(LAS unsigned*)(Qi + p * QS + 4 * cp) = pk2(qi0, qi1);
                    *(LAS unsigned*)(Qt + p * QS + 4 * cp) = pk2(qi0 * eBi0, qi1 * eBi1);
#pragma unroll
                    for (int ii = 0; ii < 4; ++ii) if (ii >= i_sub) { const int blk = ii * (ii + 1) / 2 + i_sub;
                        *(LAS unsigned*)(Kij + (blk * 16 + (p & 15)) * QS + 4 * cp) = pk2(kr0 * gI0[ii], kr1 * gI1[ii]); }
                }
            }
            *(LAS v4u*)(Ktt + (2 * cp) * SS + 16 * w) = (v4u){kt0[0], kt0[1], kt0[2], kt0[3]};
            *(LAS v4u*)(Ktt + (2 * cp + 1) * SS + 16 * w) = (v4u){kt1[0], kt1[1], kt1[2], kt1[3]};
        } else {
            unsigned kt0[2], kt1[2];
#pragma unroll
            for (int j = 0; j < 4; ++j) {
                const int p = 4 * tg + j;
                const float kd = __expf(lg * (float)(63 - p));
                const unsigned ktp = pk2(bflo(kreg[j]) * kd, bfhi(kreg[j]) * kd);
                if ((j & 1) == 0) { kt0[j >> 1] = ktp & 0xffffu; kt1[j >> 1] = ktp >> 16; } else { kt0[j >> 1] |= ktp << 16; kt1[j >> 1] |= ktp & 0xffff0000u; }
                if (isx) {
                    const float qd = __expf(lg * (float)(p + 1));
                    *(LAS unsigned*)(Qi + p * QS + 4 * cp) = qreg[j];
                    *(LAS unsigned*)(Qt + p * QS + 4 * cp) = pk2(bflo(qreg[j]) * qd, bfhi(qreg[j]) * qd);
                    *(LAS unsigned*)(Kij + p * QS + 4 * cp) = kreg[j];
                }
            }
            *(LAS v2u*)(Ktt + (2 * cp) * SS + 8 * tg) = (v2u){kt0[0], kt0[1]};
            *(LAS v2u*)(Ktt + (2 * cp + 1) * SS + 8 * tg) = (v2u){kt1[0], kt1[1]};
        }
        if (s + 1 < 36) SCAN_LOAD(s + 1);
        LBAR();
        f32x4 oT[2];
        oT[0] = (f32x4){0.f, 0.f, 0.f, 0.f}; oT[1] = oT[0];
        if (isx) {
#pragma unroll
            for (int rep = 0; rep < 2; ++rep) { const int bi = w + 8 * rep; if (bi < 10) {
                const int i = bi >= 6 ? 3 : (bi >= 3 ? 2 : (bi >= 1 ? 1 : 0)), j = bi - i * (i + 1) / 2;
                f32x4 sc = (f32x4){0.f, 0.f, 0.f, 0.f};
#pragma unroll
                for (int ks = 0; ks < DK / 32; ++ks) { const bf16x8 a = ldfrag(Kij, QS, HG ? 16 * bi : 16 * j, 64 * ks, lane), bq = ldfrag(Qi, QS, 16 * i, 64 * ks, lane); sc = MFMA16(a, bq, sc); }
#pragma unroll
                for (int r = 0; r < 4; ++r) { const int dt = (16 * i + (lane & 15)) - (16 * j + 4 * (lane >> 4) + r);
                    if constexpr (HG) { if (dt < 0) sc[r] = 0.f; } else { sc[r] = dt >= 0 ? sc[r] * __expf(lg * (float)dt) : 0.f; } }
                *(LAS v2u*)(Pm + (16 * i + (lane & 15)) * SS + 2 * (16 * j + 4 * (lane >> 4))) = (v2u){pk2(sc[0], sc[1]), pk2(sc[2], sc[3])}; } }
#pragma unroll
            for (int vi = 0; vi < 2; ++vi)
#pragma unroll
                for (int ks = 0; ks < DK / 32; ++ks) { const bf16x8 a = ldfrag(St, QS, 16 * (vb0 + vi), 64 * ks, lane), bq = ldfrag(Qt, QS, 16 * tb, 64 * ks, lane); oT[vi] = MFMA16(a, bq, oT[vi]); }
        }
        {
            f32x4 gv;
            if constexpr (HG) gv = *(const LAS f32x4*)(GD + 16 * db + 4 * (lane >> 4)); else { const float g64 = __expf(lg * 64.f); gv = (f32x4){g64, g64, g64, g64}; }
#pragma unroll
            for (int vi = 0; vi < NVB; ++vi) { const int vb = HG ? vi : vb0 + vi; accS[vi] = accS[vi] * gv;
#pragma unroll
                for (int ks = 0; ks < 2; ++ks) { const bf16x8 a = ldfrag(Ktt, SS, 16 * db, 64 * ks, lane), bv = ldfrag(Vt, SS, 16 * vb, 64 * ks, lane); accS[vi] = MFMA16(a, bv, accS[vi]); } }
        }
        LBAR();
        if (isx) {
#pragma unroll
            for (int vi = 0; vi < 2; ++vi) {
#pragma unroll
                for (int ks = 0; ks < 2; ++ks) { const bf16x8 a = ldfrag(Vt, SS, 16 * (vb0 + vi), 64 * ks, lane), bp = ldfrag(Pm, SS, 16 * tb, 64 * ks, lane); oT[vi] = MFMA16(a, bp, oT[vi]); }
                const int t = 16 * tb + (lane & 15);
                *(v2u*)(O + (size_t)(r0 + sg * t) * D + ocol + 16 * (vb0 + vi) + 4 * (lane >> 4)) = (v2u){pk2(oT[vi][0], oT[vi][1]), pk2(oT[vi][2], oT[vi][3])};
            }
        }
#pragma unroll
        for (int vi = 0; vi < NVB; ++vi) { const int vb = HG ? vi : vb0 + vi;
            *(LAS v2u*)(St + (16 * vb + (lane & 15)) * QS + 2 * (16 * db + 4 * (lane >> 4))) = (v2u){pk2(accS[vi][0], accS[vi][1]), pk2(accS[vi][2], accS[vi][3])}; }
        LBAR();
    }
#undef SCAN_LOAD
#undef SCAN_ROW0
}
__device__ __forceinline__ void p3_scan(Frame& F) {
    for (int id = F.vcu; id < 256; id += F.G) {
        const int dvh = id & 1, mixer = (id >> 1) & 1, dir = (id >> 2) & 1, h = (id >> 3) & 3, b = id >> 5;
        if (mixer) scan_chain<true>(F, b, h, dir, dvh); else scan_chain<false>(F, b, h, dir, dvh);
        __syncthreads();
    }
}

__device__ __forceinline__ void p4_merge(Frame& F) {
    const int gw = F.vcu * NWAVES + F.wave, NGW = F.G * NWAVES;
    const bf16* P = (const bf16*)(F.ws + WS_P); const bf16* OF = (const bf16*)(F.ws + WS_OF); const bf16* OB = (const bf16*)(F.ws + WS_OB); bf16* AO = (bf16*)(F.ws + WS_AO);
    const int lane = F.lane; const bool ishg = lane >= 32;
    float nw[16];
#pragma unroll
    for (int i = 0; i < 16; ++i) nw[i] = ishg ? F.in[IN_HGNW][16 * (lane & 7) + i] : 1.f;
    for (int t = gw; t < NX; t += NGW) {
        const v4u* pf = (const v4u*)(OF + (size_t)t * D + 16 * lane); const v4u* pb = (const v4u*)(OB + (size_t)t * D + 16 * lane);
        const v4u* pg = (const v4u*)(P + (size_t)t * PW + (ishg ? 3584 + 16 * (lane - 32) : 1024 + 16 * lane));
        const v4u f0 = pf[0], f1 = pf[1], b0 = pb[0], b1 = pb[1], g0 = pg[0], g1 = pg[1];
        const unsigned fu[8] = {f0.x, f0.y, f0.z, f0.w, f1.x, f1.y, f1.z, f1.w}, bu[8] = {b0.x, b0.y, b0.z, b0.w, b1.x, b1.y, b1.z, b1.w}, gu[8] = {g0.x, g0.y, g0.z, g0.w, g1.x, g1.y, g1.z, g1.w};
        float x[16]; float ss = 0.f;
#pragma unroll
        for (int i = 0; i < 8; ++i) { x[2 * i] = bflo(fu[i]) + bflo(bu[i]); x[2 * i + 1] = bfhi(fu[i]) + bfhi(bu[i]); ss += x[2 * i] * x[2 * i] + x[2 * i + 1] * x[2 * i + 1]; }
        ss += __shfl_xor(ss, 1); ss += __shfl_xor(ss, 2); ss += __shfl_xor(ss, 4);
        const float rinv = 1.f / sqrtf(ss * (1.f / 128.f) + EPS);
        unsigned o[8];
#pragma unroll
        for (int i = 0; i < 8; ++i) o[i] = pk2(x[2 * i] * rinv * nw[2 * i] * bflo(gu[i]), x[2 * i + 1] * rinv * nw[2 * i + 1] * bfhi(gu[i]));
        v4u* po = (v4u*)(AO + (size_t)t * D + 16 * lane); po[0] = (v4u){o[0], o[1], o[2], o[3]}; po[1] = (v4u){o[4], o[5], o[6], o[7]};
    }
}

struct EpiResid {
    static constexpr bool PERM = false, AFTER_DRAIN = false;
    const float* X; const float* MOD; float* H;
    __device__ __forceinline__ void operator()(const f32x4 (&acc)[2][2][4][2], const pg8::Unit& u, int wr, int wc, int fr, int fq) const {
        const int row0 = u.pm * 256 + wr * 64 + fr, col0 = u.pn * 256 + wc * 32 + 4 * fq; const int b = (u.pm * 256) >> 11;
        f32x4 g[2][2];
#pragma unroll
        for (int bj = 0; bj < 2; ++bj)
#pragma unroll
            for (int n = 0; n < 2; ++n) g[bj][n] = *(const f32x4*)(MOD + b * 6144 + 2048 + col0 + bj * 128 + n * 16);
#pragma unroll
        for (int ai = 0; ai < 2; ++ai)
#pragma unroll
            for (int m = 0; m < 4; ++m) { const size_t off = (size_t)(row0 + ai * 128 + m * 16) * D + col0;
#pragma unroll
                for (int bj = 0; bj < 2; ++bj)
#pragma unroll
                    for (int n = 0; n < 2; ++n) { const f32x4 xv = *(const f32x4*)(X + off + bj * 128 + n * 16); *(f32x4*)(H + off + bj * 128 + n * 16) = xv + g[bj][n] * acc[ai][bj][m][n]; } }
    }
};

__device__ __forceinline__ void p6_router(Frame& F, int cntoff) {
    LAS float* Wl = (LAS float*)(F.lds + SCR_OFF);
    LAS int* le = (LAS int*)(F.lds + SCR_OFF + 131072);
    LAS int* lp = le + 256;
    LAS float* lgt = (LAS float*)(lp + 256);
    LAS int* lcnt = (LAS int*)(F.lds + L_LCNT); LAS int* gbase = (LAS int*)(F.lds + L_GBASE);
    const int tid = F.tid, lane = F.lane, w = F.wave;
    LAS float* cmL = (LAS float*)(F.lds + SCR_OFF + 131072 + 3072); LAS float* shL = cmL + 1024;
    const float* MOD = (const float*)(F.ws + WS_MOD); const float* H = (const float*)(F.ws + WS_H); bf16* VX = (bf16*)(F.ws + WS_VX);
    int* TOKE = (int*)(F.ws + WS_TOKE); int* TOKPOS = (int*)(F.ws + WS_TOKPOS); int* EXPL = (int*)(F.ws + WS_EXPL); float* EXPG = (float*)(F.ws + WS_EXPG);
    for (int it = 0; it < 16; ++it) { const int idx = tid + 512 * it, k = idx >> 3, c = idx & 7; const f32x4 v = ((const f32x4*)F.in[IN_RW])[idx]; *(LAS f32x4*)(Wl + k * 32 + 4 * (c ^ (k & 7))) = v; }
    const float rb = F.in[IN_RB][lane >> 1];
#pragma unroll 1
    for (int tok0 = F.vcu * 64; tok0 < NX; tok0 += F.G * 64) {
        const int b = tok0 >> 11;
        if (tid < 32) lcnt[tid] = 0;
        for (int k = tid; k < 1024; k += NWAVES * 64) { cmL[k] = F.in[IN_NFFN][k] * (1.f + MOD[b * 6144 + 4096 + k]); shL[k] = MOD[b * 6144 + 3072 + k]; }
        __syncthreads();
#pragma unroll 1
        for (int pr = 0; pr < 4; ++pr) {
            const int tl = 8 * w + 2 * pr;
            float acc[2][32]; float rinv[2];
            const LAS float* wb[8];
#pragma unroll
            for (int c = 0; c < 8; ++c) wb[c] = Wl + lane * 32 + 4 * (c ^ (lane & 7));
            const float* hr0 = H + (size_t)(tok0 + tl) * D + lane; const float* hr1 = hr0 + D;
            { float t0[16], t1[16]; float s0 = 0.f, s1 = 0.f;
#pragma unroll
              for (int jj = 0; jj < 16; ++jj) { t0[jj] = hr0[64 * jj]; t1[jj] = hr1[64 * jj]; }
#pragma unroll
              for (int jj = 0; jj < 16; ++jj) { s0 += t0[jj] * t0[jj]; s1 += t1[jj] * t1[jj]; }
              rinv[0] = 1.f / sqrtf(wave_sum(s0) * (1.f / D) + EPS); rinv[1] = 1.f / sqrtf(wave_sum(s1) * (1.f / D) + EPS); }
#ifndef P6_REP
#define P6_REP 1
#endif
#pragma unroll 1
            for (int r2_ = 0; r2_ < P6_REP; ++r2_) {
#pragma unroll
            for (int e = 0; e < 32; ++e) { acc[0][e] = 0.f; acc[1][e] = 0.f; }
            float xc0[4], xc1[4], xn0[4], xn1[4];
#pragma unroll
            for (int u = 0; u < 4; ++u) { xc0[u] = hr0[64 * u]; xc1[u] = hr1[64 * u]; }
#pragma unroll 1
            for (int jc = 0; jc < 4; ++jc) { const int jn = (jc + 1) & 3;
#pragma unroll
                for (int u = 0; u < 4; ++u) { xn0[u] = hr0[64 * (4 * jn + u)]; xn1[u] = hr1[64 * (4 * jn + u)]; }
#pragma unroll
                for (int u = 0; u < 4; ++u) { const int k = lane + 64 * (4 * jc + u);
                    const float cm = cmL[k], sh = shL[k];
                    const float v0 = xc0[u] * rinv[0] * cm + sh, v1 = xc1[u] * rinv[1] * cm + sh;
                    VX[(size_t)(tok0 + tl) * D + k] = (bf16)f2bf(v0); VX[(size_t)(tok0 + tl + 1) * D + k] = (bf16)f2bf(v1);
#pragma unroll
                    for (int c = 0; c < 8; ++c) { const f32x4 w4 = *(const LAS f32x4*)(wb[c] + 2048 * (4 * jc + u));
#pragma unroll
                        for (int i = 0; i < 4; ++i) { acc[0][4 * c + i] += v0 * w4[i]; acc[1][4 * c + i] += v1 * w4[i]; } }
                    asm volatile("" ::: "memory"); }
#pragma unroll
                for (int u = 0; u < 4; ++u) { xc0[u] = xn0[u]; xc1[u] = xn1[u]; } }
            }
#pragma unroll
            for (int tk = 0; tk < 2; ++tk) {
#pragma unroll
                for (int st = 0; st < 5; ++st) { const int off = 32 >> st, half = 16 >> st; const bool up = (lane & off) != 0;
#pragma unroll
                    for (int i = 0; i < half; ++i) { const float a = acc[tk][i], bb = acc[tk][i + half]; const float send = up ? a : bb, keep = up ? bb : a; acc[tk][i] = keep + __shfl_xor(send, off); } }
                float logit = acc[tk][0] + __shfl_xor(acc[tk][0], 1) + rb;
                const int myE = lane >> 1;
                float tv[4]; int ti[4];
#pragma unroll
                for (int r = 0; r < 4; ++r) { float bv = logit; int bi = myE;
#pragma unroll
                    for (int o = 1; o < 64; o <<= 1) { const float pv = __shfl_xor(bv, o); const int pi = __shfl_xor(bi, o); if (pv > bv || (pv == bv && pi < bi)) { bv = pv; bi = pi; } }
                    tv[r] = bv; ti[r] = bi; if (myE == bi) logit = -INFINITY; }
                const float e1 = __expf(tv[1] - tv[0]), e2 = __expf(tv[2] - tv[0]), e3 = __expf(tv[3] - tv[0]); const float inv = 1.f / (1.f + e1 + e2 + e3);
                if (lane == 0) { const float gg[4] = {inv, e1 * inv, e2 * inv, e3 * inv};
#pragma unroll
                    for (int r = 0; r < 4; ++r) { le[(tl + tk) * 4 + r] = ti[r]; lgt[(tl + tk) * 4 + r] = gg[r]; lp[(tl + tk) * 4 + r] = __hip_atomic_fetch_add(lcnt + ti[r], 1, __ATOMIC_RELAXED, __HIP_MEMORY_SCOPE_WORKGROUP); } }
            }
        }
        __syncthreads();
        if (tid < 32) gbase[tid] = (int)__hip_atomic_fetch_add((unsigned*)(F.ctl + CW_CNT + cntoff + tid), (unsigned)lcnt[tid], RLX_AGENT);
        __syncthreads();
        if (tid < 256) { const int e = le[tid], pos = gbase[e] + lp[tid]; TOKE[tok0 * 4 + tid] = e; TOKPOS[tok0 * 4 + tid] = pos; EXPL[e * 16384 + pos] = tok0 + (tid >> 2); EXPG[e * 16384 + pos] = lgt[tid]; }
        __syncthreads();
    }
}

__device__ __forceinline__ void moe_tables(Frame& F) {
    LAS int* TS = (LAS int*)(F.lds + L_TSTART); LAS int* TE = (LAS int*)(F.lds + L_TILEE);
    if (F.wave == 0) {
        const int e = F.lane; int nt = 0;
        if (e < 32) { const int c = (int)__hip_atomic_load((unsigned*)(F.ctl + CW_CNT + e), RLX_AGENT); nt = (c + 255) >> 8; ((LAS int*)(F.lds + L_LCNT))[e] = c; }
        int incl = nt;
#pragma unroll
        for (int o = 1; o < 32; o <<= 1) { const int y = __shfl_up(incl, o); if ((F.lane & 31) >= o) incl += y; }
        const int st = incl - nt;
        if (e < 32) { TS[e] = st; for (int i = 0; i < nt; ++i) TE[st + i] = e; if (e == 31) TS[32] = incl; }
    }
    __syncthreads();
}
struct MoeOrder {
    int G, c, nct; const LAS int* TS; const LAS int* TE; const LAS int* CN; const int* EXPL;
    __device__ __forceinline__ int arow(const pg8::Unit& u, int r) const { const int e = TE[u.pm]; const int idx = 256 * (u.pm - TS[e]) + r; return idx < CN[e] ? EXPL[e * 16384 + idx] : 0; }
    __device__ __forceinline__ bool next(int i, pg8::Unit& u) const {
        const int L = i * G + c; const int NT = TS[32];
        if (L >= NT * nct) return false;
        const int rt = L / nct, ct = L - rt * nct; const int e = TE[rt];
        u.pm = __builtin_amdgcn_readfirstlane(rt); u.pn = __builtin_amdgcn_readfirstlane(e * nct + ct); return true;
    }
    __device__ __forceinline__ void a_ready(const pg8::Unit&) const {}
    __device__ __forceinline__ void done(const pg8::Unit&) const {}
};
struct EpiGlu {
    static constexpr bool PERM = true, AFTER_DRAIN = false;
    bf16* ACT; const float* B1;
    __device__ __forceinline__ void operator()(const f32x4 (&acc)[2][2][4][2], const pg8::Unit& u, int wr, int wc, int fr, int fq) const {
        const int e = u.pn >> 3, ct = u.pn & 7; const int row0 = u.pm * 256 + wr * 64 + fr; const int cb = wc * 32 + 8 * fq;
        f32x4 bg[2], bl[2];
#pragma unroll
        for (int n = 0; n < 2; ++n) { bg[n] = *(const f32x4*)(B1 + e * 2048 + 128 * ct + cb + 4 * n); bl[n] = *(const f32x4*)(B1 + e * 2048 + 1024 + 128 * ct + cb + 4 * n); }
#pragma unroll
        for (int ai = 0; ai < 2; ++ai)
#pragma unroll
            for (int m = 0; m < 4; ++m) { const int r = row0 + ai * 128 + m * 16; unsigned o[4];
#pragma unroll
                for (int n = 0; n < 2; ++n) { float a[4];
#pragma unroll
                    for (int i = 0; i < 4; ++i) { const float xg = fminf(acc[ai][0][m][n][i] + bg[n][i], 7.f); const float xl = fminf(fmaxf(acc[ai][1][m][n][i] + bl[n][i], -7.f), 7.f);
                        a[i] = xg * sigmoidf_(1.702f * xg) * (xl + 1.f); }
                    o[2 * n] = pk2(a[0], a[1]); o[2 * n + 1] = pk2(a[2], a[3]); }
                *(v4u*)(ACT + (size_t)r * DFF + 128 * ct + cb) = (v4u){o[0], o[1], o[2], o[3]}; }
    }
};
struct EpiDown {
    static constexpr bool PERM = true, AFTER_DRAIN = false;
    bf16* YB; const float* B2; const float* ROWGATE;
    __device__ __forceinline__ void operator()(const f32x4 (&acc)[2][2][4][2], const pg8::Unit& u, int wr, int wc, int fr, int fq) const {
        const int e = u.pn >> 2, ct = u.pn & 3; const int row0 = u.pm * 256 + wr * 64 + fr; const int cb = 256 * ct + wc * 32 + 8 * fq;
        f32x4 bv[2][2];
#pragma unroll
        for (int bj = 0; bj < 2; ++bj)
#pragma unroll
            for (int n = 0; n < 2; ++n) bv[bj][n] = *(const f32x4*)(B2 + e * 1024 + cb + 128 * bj + 4 * n);
#pragma unroll
        for (int ai = 0; ai < 2; ++ai)
#pragma unroll
            for (int m = 0; m < 4; ++m) { const int r = row0 + ai * 128 + m * 16; const float gt = ROWGATE[r];
#pragma unroll
                for (int bj = 0; bj < 2; ++bj) { const f32x4 v0 = (acc[ai][bj][m][0] + bv[bj][0]) * gt, v1 = (acc[ai][bj][m][1] + bv[bj][1]) * gt;
                    *(v4u*)(YB + (size_t)r * D + cb + 128 * bj) = (v4u){pk2(v0[0], v0[1]), pk2(v0[2], v0[3]), pk2(v1[0], v1[1]), pk2(v1[2], v1[3])}; } }
    }
};
__device__ __forceinline__ void p10_final(Frame& F) {
    const int gw = F.vcu * NWAVES + F.wave, NGW = F.G * NWAVES;
    moe_tables(F);
    const LAS int* TS = (const LAS int*)(F.lds + L_TSTART);
    const float* MOD = (const float*)(F.ws + WS_MOD); const float* H = (const float*)(F.ws + WS_H); const bf16* YB = (const bf16*)(F.ws + WS_YB); const int* TOKE = (const int*)(F.ws + WS_TOKE); const int* TOKPOS = (const int*)(F.ws + WS_TOKPOS);
    for (int t = gw; t < NX; t += NGW) {
        const int b = t >> 11; int rows[4];
#pragma unroll
        for (int k = 0; k < 4; ++k) rows[k] = 256 * TS[TOKE[t * 4 + k]] + TOKPOS[t * 4 + k];
        f32x4 hv[4]; float ss = 0.f;
#pragma unroll
        for (int j = 0; j < 4; ++j) { const int k0 = 4 * F.lane + 256 * j; f32x4 y = (f32x4){0.f, 0.f, 0.f, 0.f};
#pragma unroll
            for (int k = 0; k < 4; ++k) { const v2u yy = *(const v2u*)(YB + (size_t)rows[k] * D + k0); y += (f32x4){bflo(yy.x), bfhi(yy.x), bflo(yy.y), bfhi(yy.y)}; }
            const f32x4 h4 = *(const f32x4*)(H + (size_t)t * D + k0), g2 = *(const f32x4*)(MOD + b * 6144 + 5120 + k0);
            hv[j] = h4 + g2 * y; ss += (hv[j].x * hv[j].x + hv[j].y * hv[j].y) + (hv[j].z * hv[j].z + hv[j].w * hv[j].w); }
        const float rinv = 1.f / sqrtf(wave_sum(ss) * (1.f / D) + EPS);
#pragma unroll
        for (int j = 0; j < 4; ++j) { const int k0 = 4 * F.lane + 256 * j; const f32x4 nw = *(const f32x4*)(F.in[IN_NFIN] + k0); *(f32x4*)(F.out + (size_t)t * D + k0) = hv[j] * rinv * nw; }
    }
}

struct Args { const float* in[19]; float* out; unsigned char* ws; int ph_lo, ph_hi, li, pad; };
__global__ void __launch_bounds__(NWAVES * 64, 2) fwd_kernel(Args args) {
    extern __shared__ __attribute__((aligned(16))) unsigned char lds[];
    Frame F;
    F.lds = (LAS unsigned char*)lds;
    F.tid = threadIdx.x; F.lane = F.tid & 63; F.wave = __builtin_amdgcn_readfirstlane(F.tid >> 6);
    F.G = gridDim.x; { const int bx = blockIdx.x; F.vcu = (F.G % 8 == 0) ? (bx % 8) * (F.G / 8) + bx / 8 : bx; }
    F.ws = args.ws; F.ctl = (gu32*)(args.ws + WS_CTL); F.out = args.out;
#pragma unroll
    for (int i = 0; i < 19; ++i) F.in[i] = args.in[i];
    for (int u = F.tid; u < LCTL_BYTES / 4; u += NWAVES * 64) ((LAS unsigned*)F.lds)[u] = 0u;
    __syncthreads();
    XcdBarrier bar; bar.bar = (unsigned*)(F.ctl + CW_BAR); bar.x = 0; bar.st = nullptr;
    if (N_LAUNCHES == 1) bar = xcd_barrier_post((unsigned*)(F.ctl + CW_BAR), (volatile LAS unsigned*)(F.lds + L_MISC) + 8);
    const int lo = args.ph_lo, hi = args.ph_hi;
#ifndef PH_MASK
#define PH_MASK 0x7ff
#endif
#define IN(k) (((PH_MASK >> (k)) & 1) && lo <= (k) && (k) < hi)
#define SEAM(k) do { if (IN(k) && IN((k) + 1)) xcd_barrier(bar); } while (0)
    LAS unsigned char* ring = F.lds + SCR_OFF;
#ifndef REP_MASK
#define REP_MASK 0
#endif
#define NREP(k) (1 + ((REP_MASK >> (k)) & 1))
#define PH(k, ...) if (IN(k)) { { const int rep_ = 0; __VA_ARGS__; } if (NREP(k) > 1) { xcd_barrier(bar); { const int rep_ = 1; __VA_ARGS__; } } SEAM(k); }
    PH(0, p0_prologue(F))
    PH(1, p1_xn(F))
    PH(2, {
        pg8::Gemm g{(const bf16*)(F.ws + WS_XN), (const bf16*)(F.ws + WS_WIN), NROWS, PW, D};
        InProjOrder S{F.G, (int)blockIdx.x};
        EpiInProj E{(bf16*)(F.ws + WS_P), (const float*)(F.ws + WS_LB), (const float*)(F.ws + WS_COS), (const float*)(F.ws + WS_SIN)};
        pg8::gemm_phase<EpiInProj, InProjOrder, true, true>(ring, g, S, E); })
    PH(3, p3_scan(F))
    PH(4, p4_merge(F))
    PH(5, {
        pg8::Gemm g{(const bf16*)(F.ws + WS_AO), (const bf16*)(F.ws + WS_WOUT), NX, D, D};
        pg8::StaticOrder S; S.init(NX, D, F.G, (int)blockIdx.x);
        EpiResid E{F.in[IN_X], (const float*)(F.ws + WS_MOD), (float*)(F.ws + WS_H)};
        pg8::gemm_phase<EpiResid, pg8::StaticOrder, true, true>(ring, g, S, E); })
    PH(6, p6_router(F, 64 * rep_))
    PH(7, {
        moe_tables(F);
        { const LAS int* TS = (const LAS int*)(F.lds + L_TSTART); const LAS int* TE = (const LAS int*)(F.lds + L_TILEE); const LAS int* CN = (const LAS int*)(F.lds + L_LCNT);
          const float* EXPG = (const float*)(F.ws + WS_EXPG); float* ROWGATE = (float*)(F.ws + WS_ROWGATE); const int nrow = TS[32] * 256;
          for (int row = F.vcu * (NWAVES * 64) + F.tid; row < nrow; row += F.G * NWAVES * 64) { const int e = TE[row >> 8], idx = row - 256 * TS[e]; ROWGATE[row] = idx < CN[e] ? EXPG[e * 16384 + idx] : 0.f; } }
        pg8::Gemm g{(const bf16*)(F.ws + WS_VX), (const bf16*)(F.ws + WS_W1), NX, NEXP * 2048, D};
        MoeOrder S{F.G, (int)blockIdx.x, 8, (const LAS int*)(F.lds + L_TSTART), (const LAS int*)(F.lds + L_TILEE), (const LAS int*)(F.lds + L_LCNT), (const int*)(F.ws + WS_EXPL)};
        EpiGlu E{(bf16*)(F.ws + WS_ACT), F.in[IN_B1]};
        pg8::gemm_phase_ga<EpiGlu, MoeOrder>(ring, g, S, E); })
    PH(8, {
        moe_tables(F);
        pg8::Gemm g{(const bf16*)(F.ws + WS_ACT), (const bf16*)(F.ws + WS_W2), MAXRT * 256, NEXP * 1024, DFF};
        MoeOrder S{F.G, (int)blockIdx.x, 4, (const LAS int*)(F.lds + L_TSTART), (const LAS int*)(F.lds + L_TILEE), (const LAS int*)(F.lds + L_LCNT), (const int*)(F.ws + WS_EXPL)};
        EpiDown E{(bf16*)(F.ws + WS_YB), F.in[IN_B2], (const float*)(F.ws + WS_ROWGATE)};
        pg8::gemm_phase<EpiDown, MoeOrder, true, true>(ring, g, S, E); })
    PH(9, p10_final(F))
#undef PH
#undef IN
#undef SEAM
}

extern "C" void kernel_launch(void* const* d_in, const int* in_sizes, int n_in, void* d_out, int out_size, void* d_ws, size_t ws_size, hipStream_t stream) {
    static int grid = 0;
    if (grid == 0) {
        if (n_in != 19 || in_sizes[0] != NX * D || out_size != NX * D || ws_size < WS_END) { fprintf(stderr, "kernel_launch: unexpected shapes (n_in %d, in0 %d, out %d, ws %zu; need ws >= %zu)\n", n_in, n_in > 0 ? in_sizes[0] : -1, out_size, ws_size, (size_t)WS_END); grid = -1; return; }
        int dev = 0, cus = 0, per_cu = 0;
        if (hipGetDevice(&dev) != hipSuccess || hipDeviceGetAttribute(&cus, hipDeviceAttributeMultiprocessorCount, dev) != hipSuccess) { fprintf(stderr, "kernel_launch: device query failed\n"); grid = -1; return; }
        if (hipFuncSetAttribute((const void*)fwd_kernel, hipFuncAttributeMaxDynamicSharedMemorySize, LDS_BYTES) != hipSuccess) { fprintf(stderr, "kernel_launch: hipFuncSetAttribute failed\n"); grid = -1; return; }
        if (hipOccupancyMaxActiveBlocksPerMultiprocessor(&per_cu, (const void*)fwd_kernel, NWAVES * 64, LDS_BYTES) != hipSuccess || per_cu < 1)
            fprintf(stderr, "kernel_launch: note: occupancy query reports %d workgroups per CU\n", per_cu);
        (void)hipGetLastError();
        grid = cus;
    }
    if (grid < 0) return;
    if (hipMemsetAsync((char*)d_ws + WS_CTL, 0, CTL_ZERO_BYTES, stream) != hipSuccess) { fprintf(stderr, "kernel_launch: hipMemsetAsync failed\n"); return; }
    Args a{};
    for (int i = 0; i < 19; ++i) a.in[i] = (const float*)d_in[i];
    a.out = (float*)d_out; a.ws = (unsigned char*)d_ws;
    for (int li = 0; li < N_LAUNCHES; ++li) {
        a.ph_lo = (N_LAUNCHES == 1) ? 0 : li; a.ph_hi = (N_LAUNCHES == 1) ? NPHASE : li + 1; a.li = li;
        hipLaunchKernelGGL(fwd_kernel, dim3(grid), dim3(NWAVES * 64), LDS_BYTES, stream, a);
        const hipError_t le = hipPeekAtLastError();
        if (le != hipSuccess) { fprintf(stderr, "kernel_launch: launch %d failed: %s\n", li, hipGetErrorName(le)); break; }
    }
}
```

```cpp
#include <hip/hip_runtime.h>
#include <cstdio>
#include <cstdint>
namespace pg8 {
#define PG8_LAS __attribute__((address_space(3)))
typedef unsigned short bf16_t;
typedef short bf16x8 __attribute__((ext_vector_type(8)));
typedef float f32x4 __attribute__((ext_vector_type(4)));
typedef unsigned u32x4 __attribute__((ext_vector_type(4)));
constexpr int BM = 256, BK = 64, HALF = 128, HTB = HALF * BK * 2  , STAGE_BYTES = 8 * HTB, NXCD = 8, WGM = 8;

__host__ __device__ __forceinline__ int lds_byte(int r, int c) { const int st = (r >> 4) * 2 + (c >> 5), rr = r & 15, cc = c & 31, ob = rr * 64 + cc * 2; return st * 1024 + (ob ^ (((ob >> 9) & 1) << 5)); }
__host__ __device__ __forceinline__ void stage_rc(int b, int& R, int& C) { const int st = b / 1024, sb = b % 1024, swz = sb ^ (((sb >> 9) & 1) << 5); R = (st >> 1) * 16 + swz / 64; C = (st & 1) * 32 + (swz % 64) / 2; }
__host__ __device__ __forceinline__ int perm32(int rho) { const int n = rho >> 4, i = rho & 15; return 8 * (i >> 2) + 4 * n + (i & 3); }

struct Unit { int pm, pn; };
struct Gemm { const bf16_t* A; const bf16_t* Bt; int M, N, K; };

struct StaticOrder {
    int nM, nN, nwg, G, c;
    __host__ __device__ void init(int M, int N, int G_, int c_) { nM = M / BM; nN = N / BM; nwg = nM * nN; G = G_; c = c_; }
    __host__ __device__ bool next(int i, Unit& u) const {
        const long L = (long)i * G + c; if (L >= nwg) return false;
        int wgid = (int)L; { const int q = nwg / NXCD, r = nwg % NXCD, xcd = wgid % NXCD, off = wgid / NXCD; wgid = (xcd < r ? xcd * (q + 1) : r * (q + 1) + (xcd - r) * q) + off; }
        const int nig = WGM * nN, gid = wgid / nig, fm = gid * WGM, gsz = (nM - fm) < WGM ? (nM - fm) : WGM;
        u.pm = fm + ((wgid % nig) % gsz); u.pn = (wgid % nig) / gsz; return true;
    }
    __device__ __forceinline__ void a_ready(const Unit&) const {}
    __device__ __forceinline__ void done(const Unit&) const {}
};

typedef int v8i_t __attribute__((ext_vector_type(8))); typedef int v4i_t __attribute__((ext_vector_type(4)));
__device__ __forceinline__ bf16x8 lo8(v8i_t v) { return __builtin_bit_cast(bf16x8, (v4i_t)__builtin_shufflevector(v, v, 0, 1, 2, 3)); }
__device__ __forceinline__ bf16x8 hi8(v8i_t v) { return __builtin_bit_cast(bf16x8, (v4i_t)__builtin_shufflevector(v, v, 4, 5, 6, 7)); }
__device__ __forceinline__ v8i_t cat8(bf16x8 lo, bf16x8 hi) { return __builtin_shufflevector(__builtin_bit_cast(v4i_t, lo), __builtin_bit_cast(v4i_t, hi), 0, 1, 2, 3, 4, 5, 6, 7); }
__device__ __forceinline__ void mfma_f8_acc(f32x4& acc, v8i_t a, v8i_t b) { asm volatile("s_nop 1\n\tv_mfma_f32_16x16x128_f8f6f4 %0, %1, %2, %0" : "+v"(acc) : "v"(a), "v"(b)); }
template <class Epi, class Sched, bool ALIGN_EPI = false, bool SP2 = false, bool F8 = false>
__device__ __forceinline__ void gemm_phase(PG8_LAS unsigned char* lds, const Gemm g, const Sched& S, const Epi& E) {
    const int tid = threadIdx.x, wid = __builtin_amdgcn_readfirstlane(tid >> 6), lane = tid & 63, wr = wid >> 2, wc = wid & 3, fr = lane & 15, fq = lane >> 4;
    const int K = g.K, nt = K / BK;
    unsigned voffA[2], voffB[2];
#pragma unroll
    for (int i = 0; i < 2; ++i) { int R, C; stage_rc(tid * 16 + i * 8192, R, C); const int Rb = Epi::PERM ? ((R & ~31) + perm32(R & 31)) : R;
        voffA[i] = (unsigned)(R * K + C) * 2u; voffB[i] = (unsigned)(Rb * K + C) * 2u; }
    const size_t kstep = (size_t)(BK * 2);
    const size_t hstep = (size_t)HALF * K * 2;
    const size_t tstep = 2 * hstep;
    const unsigned ldsw = (unsigned)wid * 1024u;
    const int aoff = lds_byte(wr * 64 + fr, fq * 8), boff = lds_byte(wc * 32 + fr, fq * 8);
#define PG8_SA(b, h) (((b) * 2 + (h)) * HTB)
#define PG8_SB(b, h) ((4 + (b) * 2 + (h)) * HTB)
#define PG8_STAGE(bufoff, gbase, voff) do { _Pragma("unroll") for (int _i = 0; _i < 2; ++_i) \
        __builtin_amdgcn_global_load_lds((const unsigned*)((const char*)(gbase) + (voff)[_i]), (PG8_LAS unsigned*)(lds + (bufoff) + ldsw + _i * 8192), 16, 0, 0); } while (0)
#define PG8_LDA(dst, b, h) do { _Pragma("unroll") for (int m = 0; m < 4; ++m) dst[m] = cat8(*(const PG8_LAS bf16x8*)(lds + PG8_SA(b, h) + aoff + m * 2048), *(const PG8_LAS bf16x8*)(lds + PG8_SA(b, h) + aoff + m * 2048 + 1024)); } while (0)
#define PG8_LDB(dst, b, h) do { _Pragma("unroll") for (int n = 0; n < 2; ++n) dst[n] = cat8(*(const PG8_LAS bf16x8*)(lds + PG8_SB(b, h) + boff + n * 2048), *(const PG8_LAS bf16x8*)(lds + PG8_SB(b, h) + boff + n * 2048 + 1024)); } while (0)
#define PG8_MMA(ai, bj, At, Bt) do { __builtin_amdgcn_s_setprio(1); _Pragma("unroll") for (int m = 0; m < 4; ++m) _Pragma("unroll") for (int n = 0; n < 2; ++n) { \
        if constexpr (F8) mfma_f8_acc(acc[ai][bj][m][n], Bt[n], At[m]); \
        else { acc[ai][bj][m][n] = __builtin_amdgcn_mfma_f32_16x16x32_bf16(lo8(Bt[n]), lo8(At[m]), acc[ai][bj][m][n], 0, 0, 0); acc[ai][bj][m][n] = __builtin_amdgcn_mfma_f32_16x16x32_bf16(hi8(Bt[n]), hi8(At[m]), acc[ai][bj][m][n], 0, 0, 0); } } \
        __builtin_amdgcn_s_setprio(0); } while (0)
#define PG8_WAIT_V(n) asm volatile("s_waitcnt vmcnt(" #n ")" ::: "memory")
#define PG8_WAIT_L(n) asm volatile("s_waitcnt lgkmcnt(" #n ")" ::: "memory")
#define PG8_BAR __builtin_amdgcn_s_barrier()
#define PG8_SCHED __builtin_amdgcn_sched_barrier(0)
    Unit cur, nxt; int ui = 0;
    if (!S.next(0, cur)) return;
    f32x4 acc[2][2][4][2];
#pragma unroll
    for (int a = 0; a < 2; ++a)
#pragma unroll
        for (int b = 0; b < 2; ++b)
#pragma unroll
            for (int m = 0; m < 4; ++m)
#pragma unroll
                for (int n = 0; n < 2; ++n) acc[a][b][m][n] = (f32x4){0.f, 0.f, 0.f, 0.f};
    v8i_t At[4], B0[2], B1[2];
    const char* cA = (const char*)g.A + (size_t)cur.pm * tstep; const char* cB = (const char*)g.Bt + (size_t)cur.pn * tstep;
    S.a_ready(cur);
    if constexpr (SP2) {
        PG8_STAGE(PG8_SB(0, 0), cB, voffB); PG8_STAGE(PG8_SB(0, 1), cB + hstep, voffB); PG8_STAGE(PG8_SA(0, 0), cA, voffA); PG8_STAGE(PG8_SA(0, 1), cA + hstep, voffA);
        if (wr == 1) PG8_BAR;
        PG8_WAIT_V(2); PG8_BAR;
        PG8_STAGE(PG8_SB(1, 0), cB + kstep, voffB); PG8_STAGE(PG8_SA(1, 0), cA + kstep, voffA); PG8_STAGE(PG8_SB(1, 1), cB + hstep + kstep, voffB);
        PG8_WAIT_V(6); PG8_BAR;
    } else {
        PG8_STAGE(PG8_SB(0, 0), cB, voffB); PG8_STAGE(PG8_SA(0, 0), cA, voffA); PG8_STAGE(PG8_SB(0, 1), cB + hstep, voffB); PG8_STAGE(PG8_SA(0, 1), cA + hstep, voffA);
        if (wr == 1) PG8_BAR;
        PG8_WAIT_V(4); PG8_BAR;
        PG8_STAGE(PG8_SB(1, 0), cB + kstep, voffB); PG8_STAGE(PG8_SA(1, 0), cA + kstep, voffA); PG8_STAGE(PG8_SB(1, 1), cB + hstep + kstep, voffB);
        PG8_WAIT_V(6); PG8_BAR;
    }
    for (;;) {
        const bool has_next = S.next(ui + 1, nxt);
        const char* nA = has_next ? (const char*)g.A + (size_t)nxt.pm * tstep : cA; const char* nB = has_next ? (const char*)g.Bt + (size_t)nxt.pn * tstep : cB;
#pragma unroll 1
        for (int t = 0; t < nt; t += 2) {
            const bool last = (t == nt - 2);
            const char* a1 = cA + (size_t)(t + 1) * kstep;
            const char* a2 = last ? nA : cA + (size_t)(t + 2) * kstep; const char* b2 = last ? nB : cB + (size_t)(t + 2) * kstep;
            const char* a3 = a2 + kstep; const char* b3 = b2 + kstep;
            if (last && has_next) S.a_ready(nxt);
            if constexpr (SP2) {
            PG8_LDB(B0, 0, 0); PG8_LDB(B1, 0, 1); PG8_SCHED; PG8_LDA(At, 0, 0); PG8_STAGE(PG8_SA(1, 1), a1 + hstep, voffA);
            PG8_WAIT_V(8); PG8_WAIT_L(0); PG8_BAR; PG8_MMA(0, 0, At, B0); PG8_MMA(0, 1, At, B1); PG8_BAR; PG8_SCHED;
            PG8_LDA(At, 0, 1); PG8_STAGE(PG8_SB(0, 0), b2, voffB); PG8_STAGE(PG8_SB(0, 1), b2 + hstep, voffB); PG8_STAGE(PG8_SA(0, 0), a2, voffA);
            PG8_WAIT_V(8); PG8_WAIT_L(0); PG8_BAR; PG8_MMA(1, 0, At, B0); PG8_MMA(1, 1, At, B1); PG8_BAR; PG8_SCHED;
            PG8_LDB(B0, 1, 0); PG8_LDB(B1, 1, 1); PG8_SCHED; PG8_LDA(At, 1, 0); PG8_STAGE(PG8_SA(0, 1), a2 + hstep, voffA);
            PG8_WAIT_V(8); PG8_WAIT_L(0); PG8_BAR; PG8_MMA(0, 0, At, B0); PG8_MMA(0, 1, At, B1); PG8_BAR; PG8_SCHED;
            PG8_LDA(At, 1, 1); PG8_STAGE(PG8_SB(1, 0), b3, voffB); PG8_STAGE(PG8_SB(1, 1), b3 + hstep, voffB); PG8_STAGE(PG8_SA(1, 0), a3, voffA);
            PG8_WAIT_V(8); PG8_WAIT_L(0); PG8_BAR; PG8_MMA(1, 0, At, B0); PG8_MMA(1, 1, At, B1); PG8_BAR; PG8_SCHED;
            } else {
            PG8_LDB(B0, 0, 0); PG8_SCHED; PG8_LDA(At, 0, 0); PG8_STAGE(PG8_SA(1, 1), a1 + hstep, voffA);
            PG8_WAIT_L(8); PG8_BAR; PG8_WAIT_L(0); PG8_MMA(0, 0, At, B0); PG8_BAR; PG8_SCHED;
            PG8_LDB(B1, 0, 1); PG8_STAGE(PG8_SB(0, 0), b2, voffB);
            PG8_BAR; PG8_WAIT_L(0); PG8_MMA(0, 1, At, B1); PG8_BAR;
            PG8_LDA(At, 0, 1); PG8_STAGE(PG8_SA(0, 0), a2, voffA);
            PG8_BAR; PG8_WAIT_L(0); PG8_MMA(1, 0, At, B0); PG8_BAR; PG8_SCHED;
            PG8_STAGE(PG8_SB(0, 1), b2 + hstep, voffB);
            PG8_WAIT_V(6); PG8_BAR; PG8_MMA(1, 1, At, B1); PG8_BAR;
            PG8_LDB(B0, 1, 0); PG8_SCHED; PG8_LDA(At, 1, 0); PG8_STAGE(PG8_SA(0, 1), a2 + hstep, voffA);
            PG8_WAIT_L(8); PG8_BAR; PG8_WAIT_L(0); PG8_MMA(0, 0, At, B0); PG8_BAR; PG8_SCHED;
            PG8_LDB(B1, 1, 1); PG8_STAGE(PG8_SB(1, 0), b3, voffB);
            PG8_BAR; PG8_WAIT_L(0); PG8_MMA(0, 1, At, B1); PG8_BAR;
            PG8_LDA(At, 1, 1); PG8_STAGE(PG8_SA(1, 0), a3, voffA);
            PG8_BAR; PG8_WAIT_L(0); PG8_MMA(1, 0, At, B0); PG8_BAR; PG8_SCHED;
            PG8_STAGE(PG8_SB(1, 1), b3 + hstep, voffB);
            PG8_WAIT_V(6); PG8_BAR; PG8_MMA(1, 1, At, B1); PG8_BAR;
            }
        }
        if constexpr (ALIGN_EPI) { if (wr == 0) PG8_BAR; }
        if constexpr (F8) asm volatile("s_nop 15\n\ts_nop 15" ::: "memory");
        if constexpr (!Epi::AFTER_DRAIN) { E(acc, cur, wr, wc, fr, fq); S.done(cur); }
        if (!has_next) break;
#pragma unroll
        for (int a = 0; a < 2; ++a)
#pragma unroll
            for (int b = 0; b < 2; ++b)
#pragma unroll
                for (int m = 0; m < 4; ++m)
#pragma unroll
                    for (int n = 0; n < 2; ++n) acc[a][b][m][n] = (f32x4){0.f, 0.f, 0.f, 0.f};
        cur = nxt; cA = nA; cB = nB; ++ui;
        if constexpr (ALIGN_EPI) { if (wr == 1) PG8_BAR; }
    }
    PG8_WAIT_V(0);
    if constexpr (!ALIGN_EPI) { if (wr == 0) PG8_BAR; }
    PG8_BAR;
    if constexpr (Epi::AFTER_DRAIN) { E.fused(acc, cur, wr, wc, fr, fq, lds, wid, lane); S.done(cur); }
#undef PG8_SA
#undef PG8_SB
#undef PG8_STAGE
#undef PG8_LDA
#undef PG8_LDB
#undef PG8_MMA
#undef PG8_WAIT_V
#undef PG8_WAIT_L
#undef PG8_BAR
#undef PG8_SCHED
}
template <class Epi, class Sched, bool F8 = false>
__device__ __forceinline__ void gemm_phase_ga(PG8_LAS unsigned char* lds, const Gemm g, const Sched& S, const Epi& E) {
    const int tid = threadIdx.x, wid = __builtin_amdgcn_readfirstlane(tid >> 6), lane = tid & 63, wr = wid >> 2, wc = wid & 3, fr = lane & 15, fq = lane >> 4;
    constexpr bool ALIGN_EPI = true, SP2 = true;
    const int K = g.K, nt = K / BK;
    unsigned voffB[2]; int RA[2]; unsigned CA[2]; unsigned vA[2][2], vAn[2][2];
#pragma unroll
    for (int i = 0; i < 2; ++i) { int R, C; stage_rc(tid * 16 + i * 8192, R, C); const int Rb = Epi::PERM ? ((R & ~31) + perm32(R & 31)) : R;
        RA[i] = R; CA[i] = (unsigned)C * 2u; voffB[i] = (unsigned)(Rb * K + C) * 2u; }
    const size_t kstep = (size_t)(BK * 2);
    const size_t hstep = (size_t)HALF * K * 2;
    const size_t tstep = 2 * hstep;
    const unsigned ldsw = (unsigned)wid * 1024u;
    const int aoff = lds_byte(wr * 64 + fr, fq * 8), boff = lds_byte(wc * 32 + fr, fq * 8);
#define PG8_SA(b, h) (((b) * 2 + (h)) * HTB)
#define PG8_SB(b, h) ((4 + (b) * 2 + (h)) * HTB)
#define PG8_STAGE(bufoff, gbase, voff) do { _Pragma("unroll") for (int _i = 0; _i < 2; ++_i) \
        __builtin_amdgcn_global_load_lds((const unsigned*)((const char*)(gbase) + (voff)[_i]), (PG8_LAS unsigned*)(lds + (bufoff) + ldsw + _i * 8192), 16, 0, 0); } while (0)
#define PG8_LDA(dst, b, h) do { _Pragma("unroll") for (int m = 0; m < 4; ++m) dst[m] = cat8(*(const PG8_LAS bf16x8*)(lds + PG8_SA(b, h) + aoff + m * 2048), *(const PG8_LAS bf16x8*)(lds + PG8_SA(b, h) + aoff + m * 2048 + 1024)); } while (0)
#define PG8_LDB(dst, b, h) do { _Pragma("unroll") for (int n = 0; n < 2; ++n) dst[n] = cat8(*(const PG8_LAS bf16x8*)(lds + PG8_SB(b, h) + boff + n * 2048), *(const PG8_LAS bf16x8*)(lds + PG8_SB(b, h) + boff + n * 2048 + 1024)); } while (0)
#define PG8_MMA(ai, bj, At, Bt) do { __builtin_amdgcn_s_setprio(1); _Pragma("unroll") for (int m = 0; m < 4; ++m) _Pragma("unroll") for (int n = 0; n < 2; ++n) { \
        if constexpr (F8) mfma_f8_acc(acc[ai][bj][m][n], Bt[n], At[m]); \
        else { acc[ai][bj][m][n] = __builtin_amdgcn_mfma_f32_16x16x32_bf16(lo8(Bt[n]), lo8(At[m]), acc[ai][bj][m][n], 0, 0, 0); acc[ai][bj][m][n] = __builtin_amdgcn_mfma_f32_16x16x32_bf16(hi8(Bt[n]), hi8(At[m]), acc[ai][bj][m][n], 0, 0, 0); } } \
        __builtin_amdgcn_s_setprio(0); } while (0)
#define PG8_WAIT_V(n) asm volatile("s_waitcnt vmcnt(" #n ")" ::: "memory")
#define PG8_WAIT_L(n) asm volatile("s_waitcnt lgkmcnt(" #n ")" ::: "memory")
#define PG8_BAR __builtin_amdgcn_s_barrier()
#define PG8_SCHED __builtin_amdgcn_sched_barrier(0)
    Unit cur, nxt; int ui = 0;
    if (!S.next(0, cur)) return;
    f32x4 acc[2][2][4][2];
#pragma unroll
    for (int a = 0; a < 2; ++a)
#pragma unroll
        for (int b = 0; b < 2; ++b)
#pragma unroll
            for (int m = 0; m < 4; ++m)
#pragma unroll
                for (int n = 0; n < 2; ++n) acc[a][b][m][n] = (f32x4){0.f, 0.f, 0.f, 0.f};
    v8i_t At[4], B0[2], B1[2];
    const char* cA = (const char*)g.A; const char* cB = (const char*)g.Bt + (size_t)cur.pn * tstep;
#pragma unroll
    for (int h = 0; h < 2; ++h)
#pragma unroll
        for (int i = 0; i < 2; ++i) vA[h][i] = (unsigned)S.arow(cur, 0, RA[i] + 128 * h) * (unsigned)(K * 2) + CA[i];
    S.a_ready(cur);
    if constexpr (SP2) {
        PG8_STAGE(PG8_SB(0, 0), cB, voffB); PG8_STAGE(PG8_SB(0, 1), cB + hstep, voffB); PG8_STAGE(PG8_SA(0, 0), cA, vA[0]); PG8_STAGE(PG8_SA(0, 1), cA, vA[1]);
        if (wr == 1) PG8_BAR;
        PG8_WAIT_V(2); PG8_BAR;
        PG8_STAGE(PG8_SB(1, 0), cB + kstep, voffB); PG8_STAGE(PG8_SA(1, 0), cA + kstep, vA[0]); PG8_STAGE(PG8_SB(1, 1), cB + hstep + kstep, voffB);
        PG8_WAIT_V(6); PG8_BAR;
    }
    for (;;) {
        const bool has_next = S.next(ui + 1, nxt);
        const char* nB = has_next ? (const char*)g.Bt + (size_t)nxt.pn * tstep : cB;
#pragma unroll
        for (int h = 0; h < 2; ++h)
#pragma unroll
            for (int i = 0; i < 2; ++i) vAn[h][i] = has_next ? (unsigned)S.arow(nxt, ui + 1, RA[i] + 128 * h) * (unsigned)(K * 2) + CA[i] : vA[h][i];
#pragma unroll 1
        for (int t = 0; t < nt; t += 2) {
            const bool last = (t == nt - 2);
            const char* a1 = cA + (size_t)(t + 1) * kstep;
            const char* a2 = last ? cA : cA + (size_t)(t + 2) * kstep;
            unsigned w2[2][2];
            _Pragma("unroll") for (int h = 0; h < 2; ++h) _Pragma("unroll") for (int i = 0; i < 2; ++i) w2[h][i] = last ? vAn[h][i] : vA[h][i]; const char* b2 = last ? nB : cB + (size_t)(t + 2) * kstep;
            const char* a3 = a2 + kstep; const char* b3 = b2 + kstep;
            if (last && has_next) S.a_ready(nxt);
            if constexpr (SP2) {
            PG8_LDB(B0, 0, 0); PG8_LDB(B1, 0, 1); PG8_SCHED; PG8_LDA(At, 0, 0); PG8_STAGE(PG8_SA(1, 1), a1, vA[1]);
            PG8_WAIT_V(8); PG8_WAIT_L(0); PG8_BAR; PG8_MMA(0, 0, At, B0); PG8_MMA(0, 1, At, B1); PG8_BAR; PG8_SCHED;
            PG8_LDA(At, 0, 1); PG8_STAGE(PG8_SB(0, 0), b2, voffB); PG8_STAGE(PG8_SB(0, 1), b2 + hstep, voffB); PG8_STAGE(PG8_SA(0, 0), a2, w2[0]);
            PG8_WAIT_V(8); PG8_WAIT_L(0); PG8_BAR; PG8_MMA(1, 0, At, B0); PG8_MMA(1, 1, At, B1); PG8_BAR; PG8_SCHED;
            PG8_LDB(B0, 1, 0); PG8_LDB(B1, 1, 1); PG8_SCHED; PG8_LDA(At, 1, 0); PG8_STAGE(PG8_SA(0, 1), a2, w2[1]);
            PG8_WAIT_V(8); PG8_WAIT_L(0); PG8_BAR; PG8_MMA(0, 0, At, B0); PG8_MMA(0, 1, At, B1); PG8_BAR; PG8_SCHED;
            PG8_LDA(At, 1, 1); PG8_STAGE(PG8_SB(1, 0), b3, voffB); PG8_STAGE(PG8_SB(1, 1), b3 + hstep, voffB); PG8_STAGE(PG8_SA(1, 0), a3, w2[0]);
            PG8_WAIT_V(8); PG8_WAIT_L(0); PG8_BAR; PG8_MMA(1, 0, At, B0); PG8_MMA(1, 1, At, B1); PG8_BAR; PG8_SCHED;
            }
        }
        if constexpr (ALIGN_EPI) { if (wr == 0) PG8_BAR; }
        if constexpr (F8) asm volatile("s_nop 15\n\ts_nop 15" ::: "memory");
        if constexpr (!Epi::AFTER_DRAIN) { E(acc, cur, wr, wc, fr, fq); S.done(cur); }
        if (!has_next) break;
#pragma unroll
        for (int a = 0; a < 2; ++a)
#pragma unroll
            for (int b = 0; b < 2; ++b)
#pragma unroll
                for (int m = 0; m < 4; ++m)
#pragma unroll
                    for (int n = 0; n < 2; ++n) acc[a][b][m][n] = (f32x4){0.f, 0.f, 0.f, 0.f};
        cur = nxt; cB = nB; ++ui;
#pragma unroll
        for (int h = 0; h < 2; ++h)
#pragma unroll
            for (int i = 0; i < 2; ++i) vA[h][i] = vAn[h][i];
        if constexpr (ALIGN_EPI) { if (wr == 1) PG8_BAR; }
    }
    PG8_WAIT_V(0);
    if constexpr (!ALIGN_EPI) { if (wr == 0) PG8_BAR; }
    PG8_BAR;
    if constexpr (Epi::AFTER_DRAIN) { E.fused(acc, cur, wr, wc, fr, fq, lds, wid, lane); S.done(cur); }
#undef PG8_SA
#undef PG8_SB
#undef PG8_STAGE
#undef PG8_LDA
#undef PG8_LDB
#undef PG8_MMA
#undef PG8_WAIT_V
#undef PG8_WAIT_L
#undef PG8_BAR
#undef PG8_SCHED
}
}

constexpr int NWAVES = 8;
constexpr int NPHASE = 9;
#ifndef MK_N_LAUNCHES
#define MK_N_LAUNCHES 1
#endif
constexpr int N_LAUNCHES = MK_N_LAUNCHES;

constexpr int D = 1024, BATCH = 8, SEQ = 2048, CTX = 256;
constexpr int NX = BATCH * SEQ, NC = BATCH * CTX, NROWS = NX + NC;
constexpr int PW = 4096;
constexpr int NEXP = 32, TOPK = 4, DFF = 1024;
constexpr int MAXRT = 288;
constexpr float EPS = 1e-6f;

constexpr size_t MiB = 1u << 20;
constexpr size_t WS_CTL = 0, CTL_ZERO_BYTES = 1 * MiB;
constexpr size_t WS_MOD = 1 * MiB;
constexpr size_t WS_LB = 1 * MiB + 512 * 1024;
constexpr size_t WS_COS = WS_LB + 4096, WS_SIN = WS_COS + 2048 * 32 * 4;
constexpr size_t WS_TOKE = 2 * MiB, WS_TOKPOS = WS_TOKE + 256 * 1024, WS_TOKGATE = WS_TOKPOS + 256 * 1024, WS_TOKROW = WS_TOKGATE + 256 * 1024, WS_ROWGATE = WS_TOKROW + 256 * 1024;
constexpr size_t WS_WIN = 4 * MiB, WS_WOUT = 12 * MiB, WS_W1 = 14 * MiB, WS_W2 = 142 * MiB;
constexpr size_t WS_XN = 206 * MiB, WS_P = 242 * MiB, WS_XG = WS_P, WS_OF = 386 * MiB, WS_OB = 418 * MiB, WS_AO = 450 * MiB;
constexpr size_t WS_H = 482 * MiB, WS_VX = 546 * MiB, WS_ACT = 578 * MiB, WS_YB = 722 * MiB, WS_END = 866 * MiB;
constexpr size_t WS_EXPL = WS_P, WS_EXPG = WS_P + 2 * MiB;
constexpr int CW_TMO = 0, CW_CODE = 1, CW_BAR = 4096, CW_CNT = 8192, CW_ADA = 8448, CW_READY = 32768;

constexpr int LCTL_BYTES = 2048, SCR_OFF = LCTL_BYTES, LDS_BYTES = 163840;
constexpr int L_MISC = 0;
constexpr int L_TSTART = 128;
constexpr int L_TILEE = 384;
constexpr int L_LCNT = 1600;
constexpr int L_GBASE = 1728;

#define GAS __attribute__((address_space(1)))
#define LAS __attribute__((address_space(3)))
typedef unsigned short bf16;
typedef unsigned v4u __attribute__((ext_vector_type(4)));
typedef unsigned v2u __attribute__((ext_vector_type(2)));
typedef float f32x4 __attribute__((ext_vector_type(4)));
typedef float f32x2 __attribute__((ext_vector_type(2)));
typedef short bf16x8 __attribute__((ext_vector_type(8)));
typedef GAS unsigned gu32;
#define RLX_AGENT __ATOMIC_RELAXED, __HIP_MEMORY_SCOPE_AGENT
#define LDS_WAIT() asm volatile("s_waitcnt lgkmcnt(0)" ::: "memory")
#define VM_WAIT() asm volatile("s_waitcnt vmcnt(0)" ::: "memory")
#define LBAR() do { asm volatile("s_waitcnt lgkmcnt(0)" ::: "memory"); __builtin_amdgcn_s_barrier(); asm volatile("" ::: "memory"); } while (0)
__device__ __forceinline__ unsigned f2bf(float f) { unsigned u = __builtin_bit_cast(unsigned, f); return (u + 0x7fffu + ((u >> 16) & 1u)) >> 16; }
typedef __bf16 bf16x2_t __attribute__((ext_vector_type(2)));
__device__ __forceinline__ unsigned pk2(float lo, float hi) { return __builtin_bit_cast(unsigned, __builtin_convertvector((f32x2){lo, hi}, bf16x2_t)); }
__device__ __forceinline__ unsigned pk4_f8(float a, float b, float c, float d) { int p = 0; p = __builtin_amdgcn_cvt_pk_fp8_f32(a, b, p, false); p = __builtin_amdgcn_cvt_pk_fp8_f32(c, d, p, true); return (unsigned)p; }
constexpr float W8_SCALE = 32.f, W8_INV = 1.f / 32.f;
__device__ __forceinline__ float bflo(unsigned u) { return __builtin_bit_cast(float, u << 16); }
__device__ __forceinline__ float bfhi(unsigned u) { return __builtin_bit_cast(float, u & 0xffff0000u); }
__device__ __forceinline__ float wave_sum(float v) {
#pragma unroll
    for (int o = 1; o < 64; o <<= 1) v += __shfl_xor(v, o);
    return v;
}
__device__ __forceinline__ float sigmoidf_(float x) { return __builtin_amdgcn_rcpf(1.f + __expf(-x)); }
__device__ __forceinline__ float siluf_(float x) { return x * __builtin_amdgcn_rcpf(1.f + __expf(-x)); }

#define XB_TMO      128
#define XB_XCNT(j)  (256  + 64 * (j))
#define XB_XSUB(j)  (1280 + 64 * (j))
#define XB_XGEN(j)  (2304 + 64 * (j))
#define XB_TOP      3328
#define XB_TOPGEN   3392
#define XCD_BAR_WORDS 3456
#define XB_SPIN_CAP (1u << 18)

__device__ __forceinline__ unsigned xb_ld(unsigned* p)              { return __hip_atomic_load(p, __ATOMIC_RELAXED, __HIP_MEMORY_SCOPE_AGENT); }
__device__ __forceinline__ unsigned xb_add(unsigned* p, unsigned v) { return __hip_atomic_fetch_add(p, v, __ATOMIC_RELAXED, __HIP_MEMORY_SCOPE_AGENT); }
__device__ __forceinline__ unsigned xb_xcc_id() { return (unsigned)__builtin_amdgcn_s_getreg((3 << 11) | 20) & 0xFu; }
#define XB_SPIN(cond, bar) do { unsigned _sp = 0; while (cond) { __builtin_amdgcn_s_sleep(1); \
    if ((++_sp & 255u) == 0u) { if (xb_ld(&(bar)[XB_TMO])) break; if (_sp > XB_SPIN_CAP) { atomicAdd(&(bar)[XB_TMO], 1u); break; } } } } while (0)

struct XcdBarrier {
    unsigned* bar; unsigned x;
    volatile LAS unsigned* st;
};

__device__ __forceinline__ XcdBarrier xcd_barrier_post(unsigned* bar, volatile LAS unsigned* st) {
    XcdBarrier b; b.bar = bar; b.x = xb_xcc_id(); b.st = st;
    if (threadIdx.x == 0) (void)xb_add(&bar[XB_XCNT(b.x)], 1u);
    return b;
}
__device__ __forceinline__ void xcd_barrier_complete(unsigned* bar, unsigned x, unsigned& nloc, unsigned& nx) {
    const unsigned G = gridDim.x * gridDim.y * gridDim.z;
    unsigned sum, cnt, mine, sp = 0u;
    for (;;) {
        sum = 0u; cnt = 0u; mine = 0u;
#pragma unroll
        for (unsigned j = 0; j < 16; ++j) { const unsigned c = xb_ld(&bar[XB_XCNT(j)]); sum += c; cnt += (c > 0u) ? 1u : 0u; mine = (j == x) ? c : mine; }
        if (sum == G) break;
        __builtin_amdgcn_s_sleep(1);
        if ((++sp & 255u) == 0u) { if (xb_ld(&bar[XB_TMO])) break; if (sp > XB_SPIN_CAP) { atomicAdd(&bar[XB_TMO], 1u); break; } }
    }
    nloc = mine > 0u ? mine : 1u; nx = cnt > 0u ? cnt : 1u;
}

__device__ __forceinline__ void xcd_barrier(const XcdBarrier& b) {
    asm volatile("s_waitcnt vmcnt(0)" ::: "memory");
    __syncthreads();
    if (threadIdx.x == 0) {
        unsigned* bar = b.bar;
        __builtin_amdgcn_s_waitcnt(0);
        unsigned nloc = b.st[0], nx = b.st[1];
        if (nloc == 0u) { xcd_barrier_complete(bar, b.x, nloc, nx); b.st[0] = nloc; b.st[1] = nx; }
        const unsigned old = xb_add(&bar[XB_XSUB(b.x)], 1u);
        const unsigned gen = old / nloc;
        if (old + 1u == (gen + 1u) * nloc) {
            __builtin_amdgcn_fence(__ATOMIC_RELEASE, "agent");
            asm volatile("s_waitcnt vmcnt(0)" ::: "memory");
            const unsigned og = xb_add(&bar[XB_TOP], 1u);
            const unsigned tg = og / nx;
            if (og + 1u == (tg + 1u) * nx) xb_add(&bar[XB_TOPGEN], 1u);
            else XB_SPIN(xb_ld(&bar[XB_TOPGEN]) == tg, bar);
            __builtin_amdgcn_fence(__ATOMIC_ACQUIRE, "agent");
            xb_add(&bar[XB_XGEN(b.x)], 1u);
            asm volatile("s_waitcnt vmcnt(0)" ::: "memory");
        } else {
            XB_SPIN(xb_ld(&bar[XB_XGEN(b.x)]) == gen, bar);
            __builtin_amdgcn_fence(__ATOMIC_ACQUIRE, "agent");
            asm volatile("s_waitcnt vmcnt(0)" ::: "memory");
        }
    }
    __syncthreads();
}


struct Frame {
    LAS unsigned char* lds;
    gu32* ctl;
    int tid, lane, wave, vcu, G;
    const float* const* in;
    float* out;
    unsigned char* ws;
};
#define IN_X 0
#define IN_C 1
#define IN_CTX 2
#define IN_CCTX 3
#define IN_WADA 4
#define IN_BADA 5
#define IN_NMIX 6
#define IN_NFFN 7
#define IN_WIN 8
#define IN_WOUT 9
#define IN_HGLB 10
#define IN_HGNW 11
#define IN_RW 12
#define IN_RB 13
#define IN_W1 14
#define IN_B1 15
#define IN_W2 16
#define IN_B2 17
#define IN_NFIN 18

struct TItem { const float* src; bf16* dst; int ldw, kind, n0, k0; };
__device__ __forceinline__ int t_prow(int kind, int n) {
    if (kind == 1) { if (n < 512) { const int l = n & 255; return (n & ~255) + 128 * ((l >> 5) & 1) + 32 * (l >> 6) + (l & 31); } return n; }
    if (kind == 2) { const int half = n >> 10, r = n & 1023; return 256 * (r >> 7) + 128 * half + (r & 127); }
    return n;
}
__device__ __forceinline__ bool t_decode(const Frame& F, int it, TItem& T) {
    constexpr int I_IN = 16 * 64, I_OUT = 16 * 16, I_W1 = 32 * 16 * 32, I_W2 = 32 * 16 * 16, NITEMS = I_IN + I_OUT + I_W1 + I_W2;
    if (it >= I_IN + I_OUT) return false;
    int r = it;
    if (r < I_IN) { T.src = F.in[IN_WIN]; T.dst = (bf16*)(F.ws + WS_WIN); T.ldw = PW; T.kind = 1; T.k0 = (r >> 6) * 64; T.n0 = (r & 63) * 64; return true; }
    r -= I_IN;
    if (r < I_OUT) { T.src = F.in[IN_WOUT]; T.dst = (bf16*)(F.ws + WS_WOUT); T.ldw = D; T.kind = 0; T.k0 = (r >> 4) * 64; T.n0 = (r & 15) * 64; return true; }
    r -= I_OUT;
    if (r < I_W1) { const int e = r >> 9, q = r & 511; T.src = F.in[IN_W1] + (size_t)e * 1024 * 2048; T.dst = (bf16*)(F.ws + WS_W1) + (size_t)e * 2048 * 1024; T.ldw = 2048; T.kind = 2; T.k0 = (q >> 5) * 64; T.n0 = (q & 31) * 64; return true; }
    r -= I_W1;
    { const int e = r >> 8, q = r & 255; T.src = F.in[IN_W2] + (size_t)e * 1024 * 1024; T.dst = (bf16*)(F.ws + WS_W2) + (size_t)e * 1024 * 1024; T.ldw = 1024; T.kind = 0; T.k0 = (q >> 4) * 64; T.n0 = (q & 15) * 64; return true; }
}
__device__ __forceinline__ void t_load(const TItem& T, float (&v)[64], int lane) {
    const float* s = T.src + (size_t)T.k0 * T.ldw + T.n0 + lane;
#pragma unroll
    for (int i = 0; i < 64; ++i) v[i] = s[(size_t)i * T.ldw];
}
__device__ __forceinline__ void t_store(const TItem& T, const float (&v)[64], LAS float* scr, int lane) {
#pragma unroll
    for (int i = 0; i < 64; ++i) scr[i * 65 + lane] = v[i];
    LDS_WAIT(); asm volatile("" ::: "memory");
    const int c = lane & 7;
    if (T.kind >= 2) {
#pragma unroll
        for (int j = 0; j < 8; ++j) { const int n = (lane >> 3) + 8 * j; const LAS float* s = scr + (8 * c) * 65 + n;
            v2u o; o.x = pk4_f8(s[0 * 65] * W8_SCALE, s[1 * 65] * W8_SCALE, s[2 * 65] * W8_SCALE, s[3 * 65] * W8_SCALE); o.y = pk4_f8(s[4 * 65] * W8_SCALE, s[5 * 65] * W8_SCALE, s[6 * 65] * W8_SCALE, s[7 * 65] * W8_SCALE);
            *(GAS v2u*)((unsigned char*)T.dst + (size_t)t_prow(T.kind, T.n0 + n) * 1024 + T.k0 + 8 * c) = o; }
    } else {
#pragma unroll
    for (int j = 0; j < 8; ++j) { const int n = (lane >> 3) + 8 * j; const LAS float* s = scr + (8 * c) * 65 + n;
        v4u o; o.x = pk2(s[0 * 65], s[1 * 65]); o.y = pk2(s[2 * 65], s[3 * 65]); o.z = pk2(s[4 * 65], s[5 * 65]); o.w = pk2(s[6 * 65], s[7 * 65]);
        *(GAS v4u*)(T.dst + (size_t)t_prow(T.kind, T.n0 + n) * 1024 + T.k0 + 8 * c) = o; }
    }
    LDS_WAIT(); asm volatile("" ::: "memory");
}
__device__ __forceinline__ void p0_prologue(Frame& F) {
    const int gw = F.vcu * NWAVES + F.wave, NGW = F.G * NWAVES;
    float* MOD = (float*)(F.ws + WS_MOD);
    for (int cg = F.vcu; cg < 96; cg += F.G) {
        LAS float* sl = (LAS float*)(F.lds + SCR_OFF);
        LAS float* red = sl + 9 * 1024;
        for (int i = F.tid; i < 9 * 1024; i += NWAVES * 64) { const int b = i >> 10, k = i & 1023; const float cv = b < 8 ? F.in[IN_C][b * 1024 + k] : F.in[IN_CCTX][k]; sl[i] = siluf_(cv); }
        __syncthreads();
        const int j = 64 * cg + F.lane; const int kb = 128 * F.wave;
        const float* wa = F.in[IN_WADA] + (size_t)kb * 6144 + j;
        float acc[9];
#pragma unroll
        for (int b = 0; b < 9; ++b) acc[b] = 0.f;
#pragma unroll 1
        for (int k = 0; k < 128; k += 32) {
            float w[32];
#pragma unroll
            for (int i = 0; i < 32; ++i) w[i] = wa[(size_t)(k + i) * 6144];
#pragma unroll
            for (int b = 0; b < 9; ++b)
#pragma unroll
                for (int i = 0; i < 32; i += 4) { const f32x4 s0 = *(const LAS f32x4*)(sl + b * 1024 + kb + k + i); acc[b] += s0[0] * w[i] + s0[1] * w[i + 1] + s0[2] * w[i + 2] + s0[3] * w[i + 3]; }
        }
#pragma unroll
        for (int b = 0; b < 9; ++b) red[(F.wave * 9 + b) * 64 + F.lane] = acc[b];
        __syncthreads();
        for (int i = F.tid; i < 9 * 64; i += NWAVES * 64) { const int b = i >> 6, l = i & 63; float s = F.in[IN_BADA][64 * cg + l];
#pragma unroll
            for (int w8 = 0; w8 < 8; ++w8) s += red[(w8 * 9 + b) * 64 + l];
            MOD[b * 6144 + 64 * cg + l] = s; }
        VM_WAIT(); __syncthreads();
        if (F.tid == 0) { __builtin_amdgcn_fence(__ATOMIC_RELEASE, "agent"); VM_WAIT(); __hip_atomic_fetch_add((unsigned*)(F.ctl + CW_ADA), 1u, RLX_AGENT); }
        __syncthreads();
    }
    {
        float* LB = (float*)(F.ws + WS_LB); float* COS = (float*)(F.ws + WS_COS); float* SIN = (float*)(F.ws + WS_SIN);
        const int gt = F.vcu * (NWAVES * 64) + F.tid, NGT = F.G * NWAVES * 64;
        for (int i = gt; i < 1024; i += NGT) { const float a0 = F.in[IN_HGLB][i], a1 = F.in[IN_HGLB][1024 + i]; LB[i] = 1.f / (1.f + expf(a1 - a0)); }
        for (int i = gt; i < 2048 * 32; i += NGT) { const int n = i >> 5, j = i & 31, fi = j & 15; const float pos = (float)(j < 16 ? (n >> 6) : (n & 63));
            const float inv = powf(10000.f, -(float)fi / 16.f); const float ang = pos * inv; COS[i] = cosf(ang); SIN[i] = sinf(ang); }
    }
    LAS float* scr = (LAS float*)(F.lds + SCR_OFF + F.wave * 16640);
    int it = NGW - 1 - gw; TItem cur, nxt; float va[64], vb[64];
    bool has = t_decode(F, it, cur);
    if (has) t_load(cur, va, F.lane);
    while (has) {
        it += NGW; const bool hn = t_decode(F, it, nxt);
        if (hn) t_load(nxt, vb, F.lane);
        t_store(cur, va, scr, F.lane);
        has = hn; if (!has) break;
        cur = nxt;
        it += NGW; const bool hn2 = t_decode(F, it, nxt);
        if (hn2) t_load(nxt, va, F.lane);
        t_store(cur, vb, scr, F.lane);
        has = hn2; cur = nxt;
    }
}

constexpr int TP_P2_EXPERTS = 6;
constexpr int TP_P2_ITEMS = TP_P2_EXPERTS * 512;
__device__ __forceinline__ bool tt_decode(const Frame& F, int t, int t1, TItem& T) {
    if (t >= t1) return false;
    if (t < 16384) { const int u = t >> 1; const int nb = u & 31, kb = 2 * ((u >> 5) & 7) + (t & 1), e = u >> 8; T.src = F.in[IN_W1] + (size_t)e * 1024 * 2048; T.dst = (bf16*)((unsigned char*)(F.ws + WS_W1) + (size_t)e * 2048 * 1024); T.ldw = 2048; T.kind = 2; T.k0 = kb * 64; T.n0 = nb * 64; }
    else { const int q = t - 16384, u = q >> 1; const int nb = u & 15, kb = 2 * ((u >> 4) & 7) + (q & 1), e = u >> 7; T.src = F.in[IN_W2] + (size_t)e * 1024 * 1024; T.dst = (bf16*)((unsigned char*)(F.ws + WS_W2) + (size_t)e * 1024 * 1024); T.ldw = 1024; T.kind = 3; T.k0 = kb * 64; T.n0 = nb * 64; }
    return true;
}
__device__ __forceinline__ void tail_transpose(Frame& F, int t0, int t1, int wv, int nwv) {
    LAS float* scr = (LAS float*)(F.lds + SCR_OFF + F.wave * 16640);
    int it = t0 + wv; TItem cur, nxt; float va[64], vb[64];
    bool has = tt_decode(F, it, t1, cur);
    if (has) t_load(cur, va, F.lane);
    while (has) {
        it += nwv; const bool hn = tt_decode(F, it, t1, nxt);
        if (hn) t_load(nxt, vb, F.lane);
        t_store(cur, va, scr, F.lane);
        has = hn; if (!has) break;
        cur = nxt;
        it += nwv; const bool hn2 = tt_decode(F, it, t1, nxt);
        if (hn2) t_load(nxt, va, F.lane);
        t_store(cur, vb, scr, F.lane);
        has = hn2; cur = nxt;
    }
}

__device__ __forceinline__ void p1_xn(Frame& F) {
    const int gw = F.vcu * NWAVES + F.wave, NGW = F.G * NWAVES;
    const float* MOD = (const float*)(F.ws + WS_MOD); bf16* XN = (bf16*)(F.ws + WS_XN);
    for (int m = gw; m < NROWS; m += NGW) {
        const float* src = m < NX ? F.in[IN_X] + (size_t)m * D : F.in[IN_CTX] + (size_t)(m - NX) * D; const int b = m < NX ? (m >> 11) : 8;
        const GAS f32x4* xr = (const GAS f32x4*)src + F.lane; f32x4 v[4]; float s = 0.f;
#pragma unroll
        for (int j = 0; j < 4; ++j) { v[j] = xr[64 * j]; s += (v[j].x * v[j].x + v[j].y * v[j].y) + (v[j].z * v[j].z + v[j].w * v[j].w); }
        const float rinv = 1.f / sqrtf(wave_sum(s) * (1.f / D) + EPS);
        GAS v2u* o8 = (GAS v2u*)(XN + (size_t)m * D) + F.lane;
#pragma unroll
        for (int j = 0; j < 4; ++j) { const int k = 4 * F.lane + 256 * j;
            const f32x4 nw = *(const f32x4*)(F.in[IN_NMIX] + k), sh = *(const f32x4*)(MOD + b * 6144 + k), sc = *(const f32x4*)(MOD + b * 6144 + 1024 + k);
            const f32x4 u = v[j] * rinv * nw * (sc + 1.f) + sh; v2u w; w.x = pk2(u.x, u.y); w.y = pk2(u.z, u.w); o8[64 * j] = w; }
    }
}

struct InProjOrder {
    int G, c;
    __device__ __forceinline__ bool next(int i, pg8::Unit& u) const {
        const int L = i * G + c;
        if (L < 1024) { pg8::StaticOrder S; S.init(NX, PW, 1 << 30, L); return S.next(0, u); }
        if (L < 1024 + 72) { const int j = L - 1024, ti = j >> 3; u.pm = 64 + (j & 7); u.pn = ti < 3 ? 1 + ti : 5 + ti; return true; }
        return false;
    }
    __device__ __forceinline__ void a_ready(const pg8::Unit&) const {}
    __device__ __forceinline__ void done(const pg8::Unit&) const {}
};
struct EpiInProj {
    static constexpr bool PERM = true, AFTER_DRAIN = false;
    bf16* P; const float* LB; const float* COS; const float* SIN;
    __device__ __forceinline__ void operator()(const f32x4 (&acc)[2][2][4][2], const pg8::Unit& u, int wr, int wc, int fr, int fq) const {
        const int t = u.pn; const int row0 = u.pm * 256 + wr * 64 + fr; const int cb = wc * 32 + 8 * fq;
        if (t < 2) {
            const bool isx = u.pm < 64; const float sc = t == 1 ? 0.125f : 1.f;
#pragma unroll
            for (int ai = 0; ai < 2; ++ai)
#pragma unroll
                for (int m = 0; m < 4; ++m) { const int r = row0 + ai * 128 + m * 16; f32x4 c0, c1, s0, s1;
                    if (isx) { const int pos = r & 2047; c0 = *(const f32x4*)(COS + pos * 32 + 8 * fq); c1 = *(const f32x4*)(COS + pos * 32 + 8 * fq + 4); s0 = *(const f32x4*)(SIN + pos * 32 + 8 * fq); s1 = *(const f32x4*)(SIN + pos * 32 + 8 * fq + 4); }
                    else { c0 = (f32x4){1.f, 1.f, 1.f, 1.f}; c1 = c0; s0 = (f32x4){0.f, 0.f, 0.f, 0.f}; s1 = s0; }
                    const f32x4 a0 = acc[ai][0][m][0] * sc, a1 = acc[ai][0][m][1] * sc, b0 = acc[ai][1][m][0] * sc, b1 = acc[ai][1][m][1] * sc;
                    const f32x4 o10 = a0 * c0 - b0 * s0, o11 = a1 * c1 - b1 * s1, o20 = a0 * s0 + b0 * c0, o21 = a1 * s1 + b1 * c1;
                    bf16* rp = P + (size_t)r * PW + 256 * t + 64 * wc + 8 * fq;
                    v4u w; w.x = pk2(o10[0], o10[1]); w.y = pk2(o10[2], o10[3]); w.z = pk2(o11[0], o11[1]); w.w = pk2(o11[2], o11[3]); *(v4u*)rp = w;
                    w.x = pk2(o20[0], o20[1]); w.y = pk2(o20[2], o20[3]); w.z = pk2(o21[0], o21[1]); w.w = pk2(o21[2], o21[3]); *(v4u*)(rp + 32) = w; }
            return;
        }
        const int mode = (t == 2 || t == 3 || t == 12 || t == 13) ? 0 : ((t >= 8 && t < 12) ? 2 : 1);
        f32x4 lb[2][2];
        if (mode == 2) {
#pragma unroll
            for (int bj = 0; bj < 2; ++bj)
#pragma unroll
                for (int n = 0; n < 2; ++n) lb[bj][n] = *(const f32x4*)(LB + ((t - 8) >> 1) * 512 + ((t & 1) << 8) + 128 * bj + cb + 4 * n);
        }
#pragma unroll
        for (int ai = 0; ai < 2; ++ai)
#pragma unroll
            for (int m = 0; m < 4; ++m) { const int r = row0 + ai * 128 + m * 16; bf16* rp = P + (size_t)r * PW + 256 * t + cb;
#pragma unroll
                for (int bj = 0; bj < 2; ++bj) { f32x4 v0 = acc[ai][bj][m][0], v1 = acc[ai][bj][m][1];
                    if (mode == 1) {
#pragma unroll
                        for (int i = 0; i < 4; ++i) { v0[i] = siluf_(v0[i]); v1[i] = siluf_(v1[i]); } }
                    else if (mode == 2) {
#pragma unroll
                        for (int i = 0; i < 4; ++i) { const float l0 = lb[bj][0][i], l1 = lb[bj][1][i]; v0[i] = __logf(l0 + (1.f - l0) * sigmoidf_(v0[i])); v1[i] = __logf(l1 + (1.f - l1) * sigmoidf_(v1[i])); } }
                    v4u w; w.x = pk2(v0[0], v0[1]); w.y = pk2(v0[2], v0[3]); w.z = pk2(v1[0], v1[1]); w.w = pk2(v1[2], v1[3]); *(v4u*)(rp + 128 * bj) = w; } }
    }
};

__device__ __forceinline__ bf16x8 ldfrag(const LAS unsigned char* base, int stride, int row0, int kb, int lane) {
    return *(const LAS bf16x8*)(base + (row0 + (lane & 15)) * stride + kb + 16 * (lane >> 4));
}
#define MFMA16(a, b, c) __builtin_amdgcn_mfma_f32_16x16x32_bf16((a), (b), (c), 0, 0, 0)
constexpr int TP_W1_PAIRS = (32 - TP_P2_EXPERTS) * 128, TP_ALL_PAIRS = TP_W1_PAIRS + 32 * 64;
struct TPState { const float* src; unsigned char* dst; int ldw; };
__device__ __forceinline__ void tp_decode(const Frame& F, int u, int kbit, TPState& S, int lane) {
    if (u < TP_W1_PAIRS) {
    const int nb = u & 15, kb = 2 * ((u >> 4) & 7) + kbit, e = TP_P2_EXPERTS + (u >> 7); const int n = 128 * nb + 2 * lane; const int half = n >> 10, r = n & 1023; const int prow = 256 * (r >> 7) + 128 * half + (r & 127);
    S.src = F.in[IN_W1] + (size_t)e * 1024 * 2048 + (size_t)(64 * kb) * 2048 + n; S.dst = (unsigned char*)(F.ws + WS_W1) + (size_t)e * 2048 * 1024 + (size_t)prow * 1024 + 64 * kb; S.ldw = 2048;
    } else {
    const int u2 = u - TP_W1_PAIRS; const int nb = u2 & 7, kb = 2 * ((u2 >> 3) & 7) + kbit, e = u2 >> 6; const int n = 128 * nb + 2 * lane;
    S.src = F.in[IN_W2] + (size_t)e * 1024 * 1024 + (size_t)(64 * kb) * 1024 + n; S.dst = (unsigned char*)(F.ws + WS_W2) + (size_t)e * 1024 * 1024 + (size_t)n * 1024 + 64 * kb; S.ldw = 1024; }
}
__device__ __forceinline__ void tp_load(const TPState& S, f32x2 (&v)[64]) {
#pragma unroll
    for (int i = 0; i < 64; ++i) v[i] = *(const f32x2*)(S.src + (size_t)i * S.ldw);
}
__device__ __forceinline__ void tp_store(unsigned char* d, const f32x2 (&v)[64]) {
#pragma unroll
    for (int c = 0; c < 4; ++c) {
        *(GAS v4u*)(d + 16 * c) = (v4u){pk4_f8(v[16 * c].x * W8_SCALE, v[16 * c + 1].x * W8_SCALE, v[16 * c + 2].x * W8_SCALE, v[16 * c + 3].x * W8_SCALE), pk4_f8(v[16 * c + 4].x * W8_SCALE, v[16 * c + 5].x * W8_SCALE, v[16 * c + 6].x * W8_SCALE, v[16 * c + 7].x * W8_SCALE),
                                         pk4_f8(v[16 * c + 8].x * W8_SCALE, v[16 * c + 9].x * W8_SCALE, v[16 * c + 10].x * W8_SCALE, v[16 * c + 11].x * W8_SCALE), pk4_f8(v[16 * c + 12].x * W8_SCALE, v[16 * c + 13].x * W8_SCALE, v[16 * c + 14].x * W8_SCALE, v[16 * c + 15].x * W8_SCALE)};
        *(GAS v4u*)(d + 1024 + 16 * c) = (v4u){pk4_f8(v[16 * c].y * W8_SCALE, v[16 * c + 1].y * W8_SCALE, v[16 * c + 2].y * W8_SCALE, v[16 * c + 3].y * W8_SCALE), pk4_f8(v[16 * c + 4].y * W8_SCALE, v[16 * c + 5].y * W8_SCALE, v[16 * c + 6].y * W8_SCALE, v[16 * c + 7].y * W8_SCALE),
                                                pk4_f8(v[16 * c + 8].y * W8_SCALE, v[16 * c + 9].y * W8_SCALE, v[16 * c + 10].y * W8_SCALE, v[16 * c + 11].y * W8_SCALE), pk4_f8(v[16 * c + 12].y * W8_SCALE, v[16 * c + 13].y * W8_SCALE, v[16 * c + 14].y * W8_SCALE, v[16 * c + 15].y * W8_SCALE)}; }
}
#define TP_SLOT(v, d) do { if (d) tp_store(d, v); d = nullptr; if (tp_left > 0 && tp_u < TP_ALL_PAIRS) { tp_decode(F, tp_u, tp_kbit, tps, lane); tp_load(tps, v); d = tps.dst; } \
        if (tp_left > 0) { --tp_left; if (tp_kbit) tp_u += 512; tp_kbit ^= 1; } } while (0)

template <bool HG>
__device__ __forceinline__ void scan_chain4(Frame& F, int b, int h, int dir, int dvh) {
    constexpr int DK = HG ? 128 : 64;
    constexpr int QS = DK * 2 + 16, SS = 64 * 2 + 16;
    constexpr int KROWS = HG ? 160 : 64;
    constexpr int O_QI = 0, O_QT = O_QI + 64 * QS, O_KIJ = O_QT + 64 * QS, O_KTT = O_KIJ + KROWS * QS, O_VT = O_KTT + DK * SS, O_PM = O_VT + 64 * SS, O_ST = O_PM + 64 * SS, O_T = O_ST + 64 * QS, O_GD = O_T + 2048, O_END = O_GD + 512;
    static_assert(SCR_OFF + O_END <= LDS_BYTES, "scan LDS");
    LAS unsigned char* L = F.lds + SCR_OFF;
    LAS unsigned char* Qi = L + O_QI; LAS unsigned char* Qt = L + O_QT; LAS unsigned char* Kij = L + O_KIJ; LAS unsigned char* Ktt = L + O_KTT;
    LAS unsigned char* Vt = L + O_VT; LAS unsigned char* Pm = L + O_PM; LAS unsigned char* St = L + O_ST;
    LAS float* T = (LAS float*)(L + O_T); LAS float* GD = (LAS float*)(L + O_GD);
    int tid = F.tid; asm volatile("" : "+v"(tid));
    const int lane = tid & 63, w = F.wave;
    const bool scanner = w < 4;
    const bf16* P = (const bf16*)(F.ws + WS_P);
    bf16* O = (bf16*)(F.ws + (dir ? WS_OB : WS_OF));
    const int qcol = HG ? 1536 + 128 * h : 64 * h;
    const int kcol = HG ? 2048 + 512 * dir + 128 * h : 256 + 64 * h;
    const int vcol = (HG ? 3072 : 512) + 128 * h + 64 * dvh;
    const int ocol = (HG ? 512 : 0) + 128 * h + 64 * dvh;
    const float lg = HG ? 0.f : log1pf(-exp2f(-(float)(dir ? 6 : 5) - 2.f * (float)h));
    if (!scanner) {
        const int rb = ((F.vcu >> 2) << 1) | (F.vcu & 1);
        TPState tps; tps.src = nullptr; tps.dst = nullptr; tps.ldw = 0; int tp_u = rb * 4 + (w - 4); int tp_kbit = 0; int tp_left = (F.G == 256) ? 22 : 0;
        f32x2 tva[64]; unsigned char* tda = nullptr;
        LBAR();
#pragma unroll 1
        for (int s = 0; s < 36; ++s) {
            const bool on = (11 * s) % 18 < 11;
            bool ld = false;
            if (on) { if (tda) tp_store(tda, tva); tda = nullptr; ld = tp_left > 0 && tp_u < TP_ALL_PAIRS; if (ld) { tp_decode(F, tp_u, tp_kbit, tps, lane); tda = tps.dst; }
                      if (tp_left > 0) { --tp_left; if (tp_kbit) tp_u += 512; tp_kbit ^= 1; } }
#define TP_LD16(q0) do { if (ld) { _Pragma("unroll") for (int i = 16 * (q0); i < 16 * (q0) + 16; ++i) tva[i] = *(const f32x2*)(tps.src + (size_t)i * tps.ldw); } } while (0)
            TP_LD16(0); LBAR(); TP_LD16(1); LBAR(); TP_LD16(2); LBAR(); TP_LD16(3); LBAR();
#undef TP_LD16
        }
        while (tp_left > 0 || tda) { TP_SLOT(tva, tda); }
        return;
    }
    for (int i = tid; i < (64 * SS) / 4; i += 256) ((LAS unsigned*)Pm)[i] = 0u;
    for (int i = tid; i < (64 * QS) / 4; i += 256) ((LAS unsigned*)St)[i] = 0u;
    constexpr int NDB = HG ? 2 : 1;
    f32x4 accS[NDB][4];
#pragma unroll
    for (int i = 0; i < NDB; ++i)
#pragma unroll
        for (int j = 0; j < 4; ++j) accS[i][j] = (f32x4){0.f, 0.f, 0.f, 0.f};
    constexpr int TPT = HG ? 16 : 8;
    const int cp = HG ? lane : (tid & 31);
    const int tg = HG ? w : ((tid >> 5) & 7);
    const int vp2 = (tid >> 3) & 31, vs = tid & 7;
    unsigned qreg[TPT], kreg[TPT]; v4u vreg0, vreg1;
#define SCAN_ROW0(s) ((s) < 4 ? (NX + b * CTX + (dir ? 255 - 64 * (s) : 64 * (s))) : (b * SEQ + (dir ? 2047 - 64 * ((s) - 4) : 64 * ((s) - 4))))
#define SCAN_LOAD(s) do { const int r0_ = SCAN_ROW0(s); const int sg_ = dir ? -1 : 1; \
        _Pragma("unroll") for (int j = 0; j < TPT; ++j) { const bf16* rp_ = P + (size_t)(r0_ + sg_ * (TPT * tg + j)) * PW; \
            kreg[j] = *(const unsigned*)(rp_ + kcol + 2 * cp); qreg[j] = ((s) >= 4) ? *(const unsigned*)(rp_ + qcol + 2 * cp) : 0u; } \
        vreg0 = *(const v4u*)(P + (size_t)(r0_ + sg_ * (2 * vp2)) * PW + vcol + 8 * vs); vreg1 = *(const v4u*)(P + (size_t)(r0_ + sg_ * (2 * vp2 + 1)) * PW + vcol + 8 * vs); } while (0)
    SCAN_LOAD(0);
    LBAR();
#pragma unroll 1
    for (int s = 0; s < 36; ++s) {
        const bool isx = s >= 4;
        const int r0 = SCAN_ROW0(s); const int sg = dir ? -1 : 1;
        {
            if (s > 0) {
#pragma unroll
                for (int di = 0; di < NDB; ++di) { const int db = HG ? 2 * w + di : w;
#pragma unroll
                    for (int vi = 0; vi < 4; ++vi)
                        *(LAS v2u*)(St + (16 * vi + (lane & 15)) * QS + 2 * (16 * db + 4 * (lane >> 4))) = (v2u){pk2(accS[di][vi][0], accS[di][vi][1]), pk2(accS[di][vi][2], accS[di][vi][3])}; } }
            const unsigned va[4] = {vreg0.x, vreg0.y, vreg0.z, vreg0.w}, vb[4] = {vreg1.x, vreg1.y, vreg1.z, vreg1.w};
#pragma unroll
            for (int e = 0; e < 4; ++e) { *(LAS unsigned*)(Vt + (8 * vs + 2 * e) * SS + 4 * vp2) = (va[e] & 0xffffu) | (vb[e] << 16); *(LAS unsigned*)(Vt + (8 * vs + 2 * e + 1) * SS + 4 * vp2) = (va[e] >> 16) | (vb[e] & 0xffff0000u); }
            if constexpr (HG) { float run0 = 0.f, run1 = 0.f;
#pragma unroll
                for (int j = 0; j < 16; ++j) { run0 += bflo(kreg[j]); run1 += bfhi(kreg[j]); }
                *(LAS f32x2*)(T + w * 128 + 2 * cp) = (f32x2){run0, run1}; }
        }
        LBAR();
        {
            if constexpr (HG) {
                float pre0 = 0.f, pre1 = 0.f, bm0 = 0.f, bm1 = 0.f; float bs0[4], bs1[4];
#pragma unroll
                for (int o = 0; o < 4; ++o) { const f32x2 tt = *(const LAS f32x2*)(T + o * 128 + 2 * cp); bs0[o] = pre0; bs1[o] = pre1; if (o == w) { bm0 = pre0; bm1 = pre1; } pre0 += tt.x; pre1 += tt.y; }
                const float bend0 = pre0, bend1 = pre1;
                const float eBi0 = __expf(bm0), eBi1 = __expf(bm1), eEnd0 = __expf(bend0 - bm0), eEnd1 = __expf(bend1 - bm1);
                float gI0[4], gI1[4];
#pragma unroll
                for (int ii = 0; ii < 4; ++ii) { gI0[ii] = __expf(fminf(bs0[ii] - bm0, 0.f)); gI1[ii] = __expf(fminf(bs1[ii] - bm1, 0.f)); }
                if (w == 0) *(LAS f32x2*)(GD + 2 * cp) = (f32x2){__expf(bend0), __expf(bend1)};
                unsigned kt0[2], kt1[2]; float run0 = 0.f, run1 = 0.f;
#pragma unroll
                for (int j = 0; j < 16; ++j) {
                    const int p = 16 * w + j;
                    run0 += bflo(kreg[j]); run1 += bfhi(kreg[j]);
                    const float d0 = run0, d1 = run1;
                    const float E0 = __expf(d0), E1 = __expf(d1), R0 = __expf(-d0), R1 = __expf(-d1);
                    const float k0 = 1.f - __expf(bflo(kreg[j])), k1 = 1.f - __expf(bfhi(kreg[j]));
                    const float kr0 = k0 * R0, kr1 = k1 * R1;
                    const unsigned ktp = pk2(kr0 * eEnd0, kr1 * eEnd1);
                    if ((j & 1) == 0) { kt0[(j >> 1) & 1] = ktp & 0xffffu; kt1[(j >> 1) & 1] = ktp >> 16; } else { kt0[(j >> 1) & 1] |= ktp << 16; kt1[(j >> 1) & 1] |= ktp & 0xffff0000u; }
                    if ((j & 3) == 3) { *(LAS v2u*)(Ktt + (2 * cp) * SS + 32 * w + 2 * (j - 3)) = (v2u){kt0[0], kt0[1]}; *(LAS v2u*)(Ktt + (2 * cp + 1) * SS + 32 * w + 2 * (j - 3)) = (v2u){kt1[0], kt1[1]}; }
                    if ((j & 1) == 1) asm volatile("" ::: "memory");
                    if (isx) {
                        const float qi0 = bflo(qreg[j]) * E0, qi1 = bfhi(qreg[j]) * E1;
                        *(LAS unsigned*)(Qi + p * QS + 4 * cp) = pk2(qi0, qi1);
                        *(LAS unsigned*)(Qt + p * QS + 4 * cp) = pk2(qi0 * eBi0, qi1 * eBi1);
#pragma unroll
                        for (int ii = 0; ii < 4; ++ii) if (ii >= w) { const int blk = ii * (ii + 1) / 2 + w;
                            *(LAS unsigned*)(Kij + (blk * 16 + j) * QS + 4 * cp) = pk2(kr0 * gI0[ii], kr1 * gI1[ii]); }
                    }
                }
            } else {
                unsigned kt0[4], kt1[4];
#pragma unroll
                for (int j = 0; j < 8; ++j) {
                    const int p = 8 * tg + j;
                    const float kd = __expf(lg * (float)(63 - p));
                    const unsigned ktp = pk2(bflo(kreg[j]) * kd, bfhi(kreg[j]) * kd);
                    if ((j & 1) == 0) { kt0[j >> 1] = ktp & 0xffffu; kt1[j >> 1] = ktp >> 16; } else { kt0[j >> 1] |= ktp << 16; kt1[j >> 1] |= ktp & 0xffff0000u; }
                    if (isx) {
                        const float qd = __expf(lg * (float)(p + 1));
                        *(LAS unsigned*)(Qi + p * QS + 4 * cp) = qreg[j];
                        *(LAS unsigned*)(Qt + p * QS + 4 * cp) = pk2(bflo(qreg[j]) * qd, bfhi(qreg[j]) * qd);
                        *(LAS unsigned*)(Kij + p * QS + 4 * cp) = kreg[j];
                    }
                }
                *(LAS v4u*)(Ktt + (2 * cp) * SS + 16 * tg) = (v4u){kt0[0], kt0[1], kt0[2], kt0[3]};
                *(LAS v4u*)(Ktt + (2 * cp + 1) * SS + 16 * tg) = (v4u){kt1[0], kt1[1], kt1[2], kt1[3]};
            }
            if (s + 1 < 36) SCAN_LOAD(s + 1);
        }
        LBAR();
        {
            if (isx) {
#pragma unroll
                for (int rep = 0; rep < 3; ++rep) { const int bi = w + 4 * rep; if (bi < 10) {
                    const int i = bi >= 6 ? 3 : (bi >= 3 ? 2 : (bi >= 1 ? 1 : 0)), j = bi - i * (i + 1) / 2;
                    f32x4 sc = (f32x4){0.f, 0.f, 0.f, 0.f};
#pragma unroll
                    for (int ks = 0; ks < DK / 32; ++ks) { const bf16x8 a = ldfrag(Kij, QS, HG ? 16 * bi : 16 * j, 64 * ks, lane), bq = ldfrag(Qi, QS, 16 * i, 64 * ks, lane); sc = MFMA16(a, bq, sc); }
#pragma unroll
                    for (int r = 0; r < 4; ++r) { const int dt = (16 * i + (lane & 15)) - (16 * j + 4 * (lane >> 4) + r);
                        if constexpr (HG) { if (dt < 0) sc[r] = 0.f; } else { sc[r] = dt >= 0 ? sc[r] * __expf(lg * (float)dt) : 0.f; } }
                    *(LAS v2u*)(Pm + (16 * i + (lane & 15)) * SS + 2 * (16 * j + 4 * (lane >> 4))) = (v2u){pk2(sc[0], sc[1]), pk2(sc[2], sc[3])}; }
                    asm volatile("" ::: "memory"); }
            }
#pragma unroll
            for (int di = 0; di < NDB; ++di) { const int db = HG ? 2 * w + di : w;
                f32x4 gv;
                if constexpr (HG) gv = *(const LAS f32x4*)(GD + 16 * db + 4 * (lane >> 4)); else { const float g64 = __expf(lg * 64.f); gv = (f32x4){g64, g64, g64, g64}; }
#pragma unroll
                for (int vi = 0; vi < 4; ++vi) { accS[di][vi] = accS[di][vi] * gv;
#pragma unroll
                    for (int ks = 0; ks < 2; ++ks) { const bf16x8 a = ldfrag(Ktt, SS, 16 * db, 64 * ks, lane), bv = ldfrag(Vt, SS, 16 * vi, 64 * ks, lane); accS[di][vi] = MFMA16(a, bv, accS[di][vi]); }
                    if (vi & 1) asm volatile("" ::: "memory"); } }
        }
        LBAR();
        {
            if (isx) {
#pragma unroll
                for (int vi = 0; vi < 4; ++vi) { f32x4 oT = (f32x4){0.f, 0.f, 0.f, 0.f};
#pragma unroll
                    for (int ks = 0; ks < DK / 32; ++ks) { const bf16x8 a = ldfrag(St, QS, 16 * vi, 64 * ks, lane), bq = ldfrag(Qt, QS, 16 * w, 64 * ks, lane); oT = MFMA16(a, bq, oT); }
#pragma unroll
                    for (int ks = 0; ks < 2; ++ks) { const bf16x8 a = ldfrag(Vt, SS, 16 * vi, 64 * ks, lane), bp = ldfrag(Pm, SS, 16 * w, 64 * ks, lane); oT = MFMA16(a, bp, oT); }
                    const int t = 16 * w + (lane & 15);
                    *(v2u*)(O + (size_t)(r0 + sg * t) * D + ocol + 16 * vi + 4 * (lane >> 4)) = (v2u){pk2(oT[0], oT[1]), pk2(oT[2], oT[3])};
                    if (vi & 1) asm volatile("" ::: "memory");
                }
            }
        }
        LBAR();
    }
#undef SCAN_LOAD
#undef SCAN_ROW0
}
template <bool HG>
__device__ __forceinline__ void scan_chain8(Frame& F, int b, int h, int dir, int dvh) {
    constexpr int DK = HG ? 128 : 64;
    constexpr int QS = DK * 2 + 16, SS = 64 * 2 + 16;
    constexpr int KROWS = HG ? 160 : 64;
    constexpr int O_QI = 0, O_QT = O_QI + 64 * QS, O_KIJ = O_QT + 64 * QS, O_KTT = O_KIJ + KROWS * QS, O_VT = O_KTT + DK * SS, O_PM = O_VT + 64 * SS, O_ST = O_PM + 64 * SS, O_T = O_ST + 64 * QS, O_GD = O_T + 8192, O_VT1 = O_GD + 512, O_PM1 = O_VT1 + 64 * SS, O_END = O_PM1 + 64 * SS;
    static_assert(SCR_OFF + O_END <= LDS_BYTES, "scan LDS");
    LAS unsigned char* L = F.lds + SCR_OFF;
    LAS unsigned char* Qi = L + O_QI; LAS unsigned char* Qt = L + O_QT; LAS unsigned char* Kij = L + O_KIJ; LAS unsigned char* Ktt = L + O_KTT;
    LAS unsigned char* Vt0 = L + O_VT; LAS unsigned char* Pm0 = L + O_PM; LAS unsigned char* Vt1 = L + O_VT1; LAS unsigned char* Pm1 = L + O_PM1; LAS unsigned char* St = L + O_ST;
    LAS float* T = (LAS float*)(L + O_T); LAS float* GD = (LAS float*)(L + O_GD);
    int tid = F.tid; asm volatile("" : "+v"(tid));
    const int lane = tid & 63, w = F.wave;
    const bf16* P = (const bf16*)(F.ws + WS_P);
    bf16* O = (bf16*)(F.ws + (dir ? WS_OB : WS_OF));
    const int qcol = HG ? 1536 + 128 * h : 64 * h;
    const int kcol = HG ? 2048 + 512 * dir + 128 * h : 256 + 64 * h;
    const int vcol = (HG ? 3072 : 512) + 128 * h + 64 * dvh;
    const int ocol = (HG ? 512 : 0) + 128 * h + 64 * dvh;
    const float lg = HG ? 0.f : log1pf(-exp2f(-(float)(dir ? 6 : 5) - 2.f * (float)h));
    for (int i = tid; i < (64 * SS) / 4; i += NWAVES * 64) { ((LAS unsigned*)Pm0)[i] = 0u; ((LAS unsigned*)Pm1)[i] = 0u; }
    for (int i = tid; i < (64 * QS) / 4; i += NWAVES * 64) ((LAS unsigned*)St)[i] = 0u;
    constexpr int NVB = HG ? 4 : 2;
    f32x4 accS[NVB];
#pragma unroll
    for (int i = 0; i < NVB; ++i) accS[i] = (f32x4){0.f, 0.f, 0.f, 0.f};
    const int db = HG ? w : (w & 3);
    const int tb = w & 3, vb0 = 2 * (w >> 2);
    constexpr int TPT = HG ? 8 : 4;
    const int cp = HG ? lane : (tid & 31);
    const int tg = HG ? w : (tid >> 5);
    const int vp = tid >> 3, vs = tid & 7;
    unsigned qreg[TPT], kreg[TPT]; v4u vreg;
    unsigned knx[TPT];
#define SCAN_ROW0(s) ((s) < 4 ? (NX + b * CTX + (dir ? 255 - 64 * (s) : 64 * (s))) : (b * SEQ + (dir ? 2047 - 64 * ((s) - 4) : 64 * ((s) - 4))))
#define SCAN_LOAD_K(s, KR) do { const int r0_ = SCAN_ROW0(s); const int sg_ = dir ? -1 : 1; \
        _Pragma("unroll") for (int j = 0; j < TPT; ++j) KR[j] = *(const unsigned*)(P + (size_t)(r0_ + sg_ * (TPT * tg + j)) * PW + kcol + 2 * cp); } while (0)
#define SCAN_LOAD_QV(s) do { const int r0_ = SCAN_ROW0(s); const int sg_ = dir ? -1 : 1; \
        _Pragma("unroll") for (int j = 0; j < TPT; ++j) qreg[j] = ((s) >= 4) ? *(const unsigned*)(P + (size_t)(r0_ + sg_ * (TPT * tg + j)) * PW + qcol + 2 * cp) : 0u; \
        vreg = *(const v4u*)(P + (size_t)(r0_ + sg_ * vp) * PW + vcol + 8 * vs); } while (0)
#define SCAN_TOTALS(KR, Tbuf) do { float run0_ = 0.f, run1_ = 0.f; _Pragma("unroll") for (int j = 0; j < TPT; ++j) { run0_ += bflo(KR[j]); run1_ += bfhi(KR[j]); } \
        *(LAS f32x2*)((Tbuf) + w * 128 + 2 * cp) = (f32x2){run0_, run1_}; } while (0)
    SCAN_LOAD_K(0, kreg); SCAN_LOAD_QV(0); SCAN_LOAD_K(1, knx);
    if constexpr (HG) SCAN_TOTALS(kreg, T);
    LBAR();
#pragma unroll 1
    for (int s = 0; s < 36; ++s) {
        const bool isx = s >= 4;
        const int r0 = SCAN_ROW0(s); const int sg = dir ? -1 : 1;
        LAS unsigned char* Vt = (s & 1) ? Vt1 : Vt0; LAS unsigned char* Pm = (s & 1) ? Pm1 : Pm0;
        {
            const unsigned vv[4] = {vreg.x, vreg.y, vreg.z, vreg.w};
#pragma unroll
            for (int e = 0; e < 4; ++e) { *(LAS unsigned short*)(Vt + (8 * vs + 2 * e) * SS + 2 * vp) = (unsigned short)(vv[e] & 0xffffu); *(LAS unsigned short*)(Vt + (8 * vs + 2 * e + 1) * SS + 2 * vp) = (unsigned short)(vv[e] >> 16); }
        }
        if constexpr (HG) {
            const LAS float* Tc = T + (s & 1) * 1024;
            float pre0 = 0.f, pre1 = 0.f, base0 = 0.f, base1 = 0.f, bm0 = 0.f, bm1 = 0.f; float bs0[4], bs1[4];
            const int i_sub = w >> 1;
#pragma unroll
            for (int o = 0; o < 8; ++o) { const f32x2 tt = *(const LAS f32x2*)(Tc + o * 128 + 2 * cp);
                if (o == w) { base0 = pre0; base1 = pre1; }
                if ((o & 1) == 0) { bs0[o >> 1] = pre0; bs1[o >> 1] = pre1; if ((o >> 1) == i_sub) { bm0 = pre0; bm1 = pre1; } }
                pre0 += tt.x; pre1 += tt.y; }
            const float bend0 = pre0, bend1 = pre1;
            const float eBi0 = __expf(bm0), eBi1 = __expf(bm1), eEnd0 = __expf(bend0 - bm0), eEnd1 = __expf(bend1 - bm1);
            float gI0[4], gI1[4];
#pragma unroll
            for (int ii = 0; ii < 4; ++ii) { gI0[ii] = __expf(fminf(bs0[ii] - bm0, 0.f)); gI1[ii] = __expf(fminf(bs1[ii] - bm1, 0.f)); }
            if (w == 0) *(LAS f32x2*)(GD + 2 * cp) = (f32x2){__expf(bend0), __expf(bend1)};
            unsigned kt0[4], kt1[4]; float krA[8], krB[8];
            float E0 = __expf(base0 - bm0), E1 = __expf(base1 - bm1), R0 = __expf(bm0 - base0), R1 = __expf(bm1 - base1);
#pragma unroll
            for (int j = 0; j < 8; ++j) {
                const int p = 8 * w + j;
                const float f0 = __expf(bflo(kreg[j])), f1 = __expf(bfhi(kreg[j]));
                E0 *= f0; E1 *= f1; R0 *= __builtin_amdgcn_rcpf(f0); R1 *= __builtin_amdgcn_rcpf(f1);
                const float k0 = 1.f - f0, k1 = 1.f - f1;
                const float kr0 = k0 * R0, kr1 = k1 * R1;
                const unsigned ktp = pk2(kr0 * eEnd0, kr1 * eEnd1);
                if ((j & 1) == 0) { kt0[j >> 1] = ktp & 0xffffu; kt1[j >> 1] = ktp >> 16; } else { kt0[j >> 1] |= ktp << 16; kt1[j >> 1] |= ktp & 0xffff0000u; }
                if (isx) {
                    const float q0 = bflo(qreg[j]), q1 = bfhi(qreg[j]);
                    const float qi0 = q0 * E0, qi1 = q1 * E1;
                    *(LAS unsigned*)(Qi + p * QS + 4 * cp) = pk2(qi0, qi1);
                    *(LAS unsigned*)(Qt + p * QS + 4 * cp) = pk2(qi0 * eBi0, qi1 * eBi1);
                    krA[j] = kr0; krB[j] = kr1;
                }
            }
            if (isx) {
#pragma unroll
                for (int ii = 0; ii < 4; ++ii) if (ii >= i_sub) { const int blk = ii * (ii + 1) / 2 + i_sub;
#pragma unroll
                    for (int j = 0; j < 8; ++j)
                        *(LAS unsigned*)(Kij + (blk * 16 + ((8 * w + j) & 15)) * QS + 4 * cp) = pk2(krA[j] * gI0[ii], krB[j] * gI1[ii]); }
            }
            *(LAS v4u*)(Ktt + (2 * cp) * SS + 16 * w) = (v4u){kt0[0], kt0[1], kt0[2], kt0[3]};
            *(LAS v4u*)(Ktt + (2 * cp + 1) * SS + 16 * w) = (v4u){kt1[0], kt1[1], kt1[2], kt1[3]};
        } else {
            unsigned kt0[2], kt1[2];
#pragma unroll
            for (int j = 0; j < 4; ++j) {
                const int p = 4 * tg + j;
                const float kd = __expf(lg * (float)(63 - p));
                const unsigned ktp = pk2(bflo(kreg[j]) * kd, bfhi(kreg[j]) * kd);
                if ((j & 1) == 0) { kt0[j >> 1] = ktp & 0xffffu; kt1[j >> 1] = ktp >> 16; } else { kt0[j >> 1] |= ktp << 16; kt1[j >> 1] |= ktp & 0xffff0000u; }
                if (isx) {
                    const float qd = __expf(lg * (float)(p + 1));
                    *(LAS unsigned*)(Qi + p * QS + 4 * cp) = qreg[j];
                    *(LAS unsigned*)(Qt + p * QS + 4 * cp) = pk2(bflo(qreg[j]) * qd, bfhi(qreg[j]) * qd);
                    *(LAS unsigned*)(Kij + p * QS + 4 * cp) = kreg[j];
                }
            }
            *(LAS v2u*)(Ktt + (2 * cp) * SS + 8 * tg) = (v2u){kt0[0], kt0[1]};
            *(LAS v2u*)(Ktt + (2 * cp + 1) * SS + 8 * tg) = (v2u){kt1[0], kt1[1]};
        }
#pragma unroll
        for (int j = 0; j < TPT; ++j) kreg[j] = knx[j];
        if (s + 1 < 36) SCAN_LOAD_QV(s + 1);
        if (s + 2 < 36) SCAN_LOAD_K(s + 2, knx);
        LBAR();
        if constexpr (HG) { if (s + 1 < 36) SCAN_TOTALS(kreg, T + ((s + 1) & 1) * 1024); }
        f32x4 oT[2];
        oT[0] = (f32x4){0.f, 0.f, 0.f, 0.f}; oT[1] = oT[0];
        if (isx) {
#pragma unroll
            for (int rep = 0; rep < 2; ++rep) { const int bi = w + 8 * rep; if (bi < 10) {
                const int i = bi >= 6 ? 3 : (bi >= 3 ? 2 : (bi >= 1 ? 1 : 0)), j = bi - i * (i + 1) / 2;
                f32x4 sc = (f32x4){0.f, 0.f, 0.f, 0.f};
#pragma unroll
                for (int ks = 0; ks < DK / 32; ++ks) { const bf16x8 a = ldfrag(Kij, QS, HG ? 16 * bi : 16 * j, 64 * ks, lane), bq = ldfrag(Qi, QS, 16 * i, 64 * ks, lane); sc = MFMA16(a, bq, sc); }
#pragma unroll
                for (int r = 0; r < 4; ++r) { const int dt = (16 * i + (lane & 15)) - (16 * j + 4 * (lane >> 4) + r);
                    if constexpr (HG) { if (dt < 0) sc[r] = 0.f; } else { sc[r] = dt >= 0 ? sc[r] * __expf(lg * (float)dt) : 0.f; } }
                *(LAS v2u*)(Pm + (16 * i + (lane & 15)) * SS + 2 * (16 * j + 4 * (lane >> 4))) = (v2u){pk2(sc[0], sc[1]), pk2(sc[2], sc[3])}; } }
#pragma unroll
            for (int vi = 0; vi < 2; ++vi)
#pragma unroll
                for (int ks = 0; ks < DK / 32; ++ks) { const bf16x8 a = ldfrag(St, QS, 16 * (vb0 + vi), 64 * ks, lane), bq = ldfrag(Qt, QS, 16 * tb, 64 * ks, lane); oT[vi] = MFMA16(a, bq, oT[vi]); }
        }
        {
            f32x4 gv;
            if constexpr (HG) gv = *(const LAS f32x4*)(GD + 16 * db + 4 * (lane >> 4)); else { const float g64 = __expf(lg * 64.f); gv = (f32x4){g64, g64, g64, g64}; }
#pragma unroll
            for (int vi = 0; vi < NVB; ++vi) { const int vb = HG ? vi : vb0 + vi; accS[vi] = accS[vi] * gv;
#pragma unroll
                for (int ks = 0; ks < 2; ++ks) { const bf16x8 a = ldfrag(Ktt, SS, 16 * db, 64 * ks, lane), bv = ldfrag(Vt, SS, 16 * vb, 64 * ks, lane); accS[vi] = MFMA16(a, bv, accS[vi]); } }
        }
        LBAR();
        if (isx) {
#pragma unroll
            for (int vi = 0; vi < 2; ++vi) {
#pragma unroll
                for (int ks = 0; ks < 2; ++ks) { const bf16x8 a = ldfrag(Vt, SS, 16 * (vb0 + vi), 64 * ks, lane), bp = ldfrag(Pm, SS, 16 * tb, 64 * ks, lane); oT[vi] = MFMA16(a, bp, oT[vi]); }
                const int t = 16 * tb + (lane & 15);
                *(v2u*)(O + (size_t)(r0 + sg * t) * D + ocol + 16 * (vb0 + vi) + 4 * (lane >> 4)) = (v2u){pk2(oT[vi][0], oT[vi][1]), pk2(oT[vi][2], oT[vi][3])};
            }
        }
#pragma unroll
        for (int vi = 0; vi < NVB; ++vi) { const int vb = HG ? vi : vb0 + vi;
            *(LAS v2u*)(St + (16 * vb + (lane & 15)) * QS + 2 * (16 * db + 4 * (lane >> 4))) = (v2u){pk2(accS[vi][0], accS[vi][1]), pk2(accS[vi][2], accS[vi][3])}; }
    }
#undef SCAN_LOAD_K
#undef SCAN_LOAD_QV
#undef SCAN_TOTALS
#undef SCAN_ROW0
}
__device__ __forceinline__ void p3_scan(Frame& F) {
    for (int id = F.vcu; id < 256; id += F.G) {
        const int dvh = id & 1, mixer = (id >> 1) & 1, dir = (id >> 2) & 1, h = (id >> 3) & 3, b = id >> 5;
        if (mixer) scan_chain8<true>(F, b, h, dir, dvh); else scan_chain4<false>(F, b, h, dir, dvh);
        __syncthreads();
    }
}

__device__ __forceinline__ void p4_merge(Frame& F) {
    const int gw = F.vcu * NWAVES + F.wave, NGW = F.G * NWAVES;
    const bf16* P = (const bf16*)(F.ws + WS_P); const bf16* OF = (const bf16*)(F.ws + WS_OF); const bf16* OB = (const bf16*)(F.ws + WS_OB); bf16* AO = (bf16*)(F.ws + WS_AO);
    const int lane = F.lane; const bool ishg = lane >= 32;
    float nw[16];
#pragma unroll
    for (int i = 0; i < 16; ++i) nw[i] = ishg ? F.in[IN_HGNW][16 * (lane & 7) + i] : 1.f;
    for (int t = gw; t < NX; t += NGW) {
        const v4u* pf = (const v4u*)(OF + (size_t)t * D + 16 * lane); const v4u* pb = (const v4u*)(OB + (size_t)t * D + 16 * lane);
        const v4u* pg = (const v4u*)(P + (size_t)t * PW + (ishg ? 3584 + 16 * (lane - 32) : 1024 + 16 * lane));
        const v4u f0 = pf[0], f1 = pf[1], b0 = pb[0], b1 = pb[1], g0 = pg[0], g1 = pg[1];
        const unsigned fu[8] = {f0.x, f0.y, f0.z, f0.w, f1.x, f1.y, f1.z, f1.w}, bu[8] = {b0.x, b0.y, b0.z, b0.w, b1.x, b1.y, b1.z, b1.w}, gu[8] = {g0.x, g0.y, g0.z, g0.w, g1.x, g1.y, g1.z, g1.w};
        float x[16]; float ss = 0.f;
#pragma unroll
        for (int i = 0; i < 8; ++i) { x[2 * i] = bflo(fu[i]) + bflo(bu[i]); x[2 * i + 1] = bfhi(fu[i]) + bfhi(bu[i]); ss += x[2 * i] * x[2 * i] + x[2 * i + 1] * x[2 * i + 1]; }
        ss += __shfl_xor(ss, 1); ss += __shfl_xor(ss, 2); ss += __shfl_xor(ss, 4);
        const float rinv = 1.f / sqrtf(ss * (1.f / 128.f) + EPS);
        unsigned o[8];
#pragma unroll
        for (int i = 0; i < 8; ++i) o[i] = pk2(x[2 * i] * rinv * nw[2 * i] * bflo(gu[i]), x[2 * i + 1] * rinv * nw[2 * i + 1] * bfhi(gu[i]));
        v4u* po = (v4u*)(AO + (size_t)t * D + 16 * lane); po[0] = (v4u){o[0], o[1], o[2], o[3]}; po[1] = (v4u){o[4], o[5], o[6], o[7]};
    }
}

struct EpiResid {
    static constexpr bool PERM = false, AFTER_DRAIN = false;
    const float* X; const float* MOD; float* H;
    __device__ __forceinline__ void operator()(const f32x4 (&acc)[2][2][4][2], const pg8::Unit& u, int wr, int wc, int fr, int fq) const {
        const int row0 = u.pm * 256 + wr * 64 + fr, col0 = u.pn * 256 + wc * 32 + 4 * fq; const int b = (u.pm * 256) >> 11;
        f32x4 g[2][2];
#pragma unroll
        for (int bj = 0; bj < 2; ++bj)
#pragma unroll
            for (int n = 0; n < 2; ++n) g[bj][n] = *(const f32x4*)(MOD + b * 6144 + 2048 + col0 + bj * 128 + n * 16);
#pragma unroll
        for (int ai = 0; ai < 2; ++ai) {
            f32x4 xv[4][2][2];
#pragma unroll
            for (int m = 0; m < 4; ++m) { const size_t off = (size_t)(row0 + ai * 128 + m * 16) * D + col0;
#pragma unroll
                for (int bj = 0; bj < 2; ++bj)
#pragma unroll
                    for (int n = 0; n < 2; ++n) xv[m][bj][n] = *(const f32x4*)(X + off + bj * 128 + n * 16); }
#pragma unroll
            for (int m = 0; m < 4; ++m) { const size_t off = (size_t)(row0 + ai * 128 + m * 16) * D + col0;
#pragma unroll
                for (int bj = 0; bj < 2; ++bj)
#pragma unroll
                    for (int n = 0; n < 2; ++n) *(f32x4*)(H + off + bj * 128 + n * 16) = xv[m][bj][n] + g[bj][n] * acc[ai][bj][m][n]; }
            asm volatile("" ::: "memory"); }
    }
};

__device__ __forceinline__ void p6_router(Frame& F, int cntoff) {
    constexpr int BS = 2064;
    LAS unsigned char* BH = F.lds + SCR_OFF; LAS unsigned char* BL = BH + 32 * BS;
    LAS float* PART = (LAS float*)BH;
    LAS float* CP = (LAS float*)(BL + 32 * BS);
    LAS float* SSL = CP + 32;
    LAS float* RINV = SSL + 128;
    LAS int* le = (LAS int*)(RINV + 64);
    LAS int* lp = le + 256;
    LAS float* lgt = (LAS float*)(lp + 256);
    LAS int* lcnt = (LAS int*)(F.lds + L_LCNT); LAS int* gbase = (LAS int*)(F.lds + L_GBASE);
    const int tid = F.tid, lane = F.lane, w = F.wave;
    const float* MOD = (const float*)(F.ws + WS_MOD); const float* H = (const float*)(F.ws + WS_H); unsigned char* VX = (unsigned char*)(F.ws + WS_VX);
    int* TOKE = (int*)(F.ws + WS_TOKE); int* TOKPOS = (int*)(F.ws + WS_TOKPOS); int* EXPL = (int*)(F.ws + WS_EXPL); float* EXPG = (float*)(F.ws + WS_EXPG);
    const float* RW = F.in[IN_RW];
#pragma unroll 1
    for (int tok0 = F.vcu * 64; tok0 < NX; tok0 += F.G * 64) {
        const int b = tok0 >> 11;
        const float* SC2 = MOD + b * 6144 + 4096; const float* SH2 = MOD + b * 6144 + 3072;
        if (tid < 32) lcnt[tid] = 0;
#pragma unroll 1
        for (int i = 0; i < 2; ++i) { const int k = tid + 512 * i; const float cm = F.in[IN_NFFN][k] * (1.f + SC2[k]);
#pragma unroll
            for (int c = 0; c < 8; ++c) { const f32x4 w4 = ((const f32x4*)RW)[k * 8 + c];
#pragma unroll
                for (int j = 0; j < 4; ++j) { const float v = cm * w4[j]; const unsigned hi = f2bf(v); const unsigned lo = f2bf(v - __builtin_bit_cast(float, hi << 16));
                    *(LAS unsigned short*)(BH + (4 * c + j) * BS + 2 * k) = (unsigned short)hi; *(LAS unsigned short*)(BL + (4 * c + j) * BS + 2 * k) = (unsigned short)lo; } } }
        { const int e = tid & 31, part = tid >> 5; float s = 0.f;
#pragma unroll 8
          for (int kk = 0; kk < 64; ++kk) { const int k = part * 64 + kk; s += SH2[k] * RW[k * 32 + e]; }
          LAS float* red = (LAS float*)(le);
          red[tid] = s;
          __syncthreads();
          if (tid < 32) { float t = F.in[IN_RB][tid];
#pragma unroll
              for (int q = 0; q < 16; ++q) t += red[q * 32 + tid];
              CP[tid] = t; } }
        __syncthreads();
        {
            const int tt = w & 3, kh = w >> 2, kq = lane >> 4;
            const float* hp = H + (size_t)(tok0 + 16 * tt + (lane & 15)) * D + 512 * kh + 8 * kq;
            f32x4 acc0 = (f32x4){0.f, 0.f, 0.f, 0.f}, acc1 = acc0; float ss = 0.f;
            f32x4 cur[8], nxt[8];
#pragma unroll
            for (int q = 0; q < 4; ++q) { cur[2 * q] = *(const f32x4*)(hp + 32 * q); cur[2 * q + 1] = *(const f32x4*)(hp + 32 * q + 4); }
#pragma unroll 1
            for (int g4 = 0; g4 < 4; ++g4) { const int gn = (g4 + 1) & 3;
#pragma unroll
                for (int q = 0; q < 4; ++q) { nxt[2 * q] = *(const f32x4*)(hp + 128 * gn + 32 * q); nxt[2 * q + 1] = *(const f32x4*)(hp + 128 * gn + 32 * q + 4); }
#pragma unroll
                for (int q = 0; q < 4; ++q) { const int kb = 2 * (512 * kh + 128 * g4 + 32 * q);
                    float x[8] = {cur[2 * q][0], cur[2 * q][1], cur[2 * q][2], cur[2 * q][3], cur[2 * q + 1][0], cur[2 * q + 1][1], cur[2 * q + 1][2], cur[2 * q + 1][3]};
                    unsigned hw[4], lw[4];
#pragma unroll
                    for (int j = 0; j < 4; ++j) { const float a = x[2 * j], c = x[2 * j + 1]; ss += a * a + c * c;
                        hw[j] = pk2(a, c); lw[j] = pk2(a - bflo(hw[j]), c - bfhi(hw[j])); }
                    const bf16x8 ah = __builtin_bit_cast(bf16x8, (v4u){hw[0], hw[1], hw[2], hw[3]}), al = __builtin_bit_cast(bf16x8, (v4u){lw[0], lw[1], lw[2], lw[3]});
                    const bf16x8 bh0 = ldfrag(BH, BS, 0, kb, lane), bl0 = ldfrag(BL, BS, 0, kb, lane), bh1 = ldfrag(BH, BS, 16, kb, lane), bl1 = ldfrag(BL, BS, 16, kb, lane);
                    acc0 = MFMA16(bh0, ah, acc0); acc0 = MFMA16(bl0, ah, acc0); acc0 = MFMA16(bh0, al, acc0);
                    acc1 = MFMA16(bh1, ah, acc1); acc1 = MFMA16(bl1, ah, acc1); acc1 = MFMA16(bh1, al, acc1); }
#pragma unroll
                for (int q = 0; q < 8; ++q) cur[q] = nxt[q]; }
            ss += __shfl_xor(ss, 16); ss += __shfl_xor(ss, 32);
            if (kq == 0) SSL[kh * 64 + 16 * tt + lane] = ss;
            __syncthreads();
            const int tokl = 16 * tt + (lane & 15);
#pragma unroll
            for (int r = 0; r < 4; ++r) { PART[(kh * 64 + tokl) * 33 + 4 * kq + r] = acc0[r]; PART[(kh * 64 + tokl) * 33 + 16 + 4 * kq + r] = acc1[r]; }
        }
        __syncthreads();
        if (tid < 64) {
            const float rinv = 1.f / sqrtf((SSL[tid] + SSL[64 + tid]) * (1.f / D) + EPS); RINV[tid] = rinv;
            float lg[32];
#pragma unroll
            for (int e = 0; e < 32; ++e) lg[e] = rinv * (PART[tid * 33 + e] + PART[(64 + tid) * 33 + e]) + CP[e];
            float tv[4]; int ti[4];
#pragma unroll
            for (int r = 0; r < 4; ++r) { float best = lg[0]; int bi = 0;
#pragma unroll
                for (int e = 1; e < 32; ++e) if (lg[e] > best) { best = lg[e]; bi = e; }
                tv[r] = best; ti[r] = bi;
#pragma unroll
                for (int e = 0; e < 32; ++e) if (e == bi) lg[e] = -INFINITY; }
            const float e1 = __expf(tv[1] - tv[0]), e2 = __expf(tv[2] - tv[0]), e3 = __expf(tv[3] - tv[0]); const float inv = 1.f / (1.f + e1 + e2 + e3);
            const float gg[4] = {inv, e1 * inv, e2 * inv, e3 * inv};
#pragma unroll
            for (int r = 0; r < 4; ++r) { le[tid * 4 + r] = ti[r]; lgt[tid * 4 + r] = gg[r]; lp[tid * 4 + r] = __hip_atomic_fetch_add(lcnt + ti[r], 1, __ATOMIC_RELAXED, __HIP_MEMORY_SCOPE_WORKGROUP); }
        }
        __syncthreads();
        if (tid < 32) gbase[tid] = (int)__hip_atomic_fetch_add((unsigned*)(F.ctl + CW_CNT + cntoff + tid), (unsigned)lcnt[tid], RLX_AGENT);
        __syncthreads();
        if (tid < 256) { const int e = le[tid], pos = gbase[e] + lp[tid]; TOKE[tok0 * 4 + tid] = e; TOKPOS[tok0 * 4 + tid] = pos; EXPL[e * 16384 + pos] = tok0 + (tid >> 2); EXPG[e * 16384 + pos] = lgt[tid]; }
        { f32x4 cmr[4], shr[4];
#pragma unroll
          for (int j = 0; j < 4; ++j) { const int k = 4 * lane + 256 * j; const f32x4 nw = *(const f32x4*)(F.in[IN_NFFN] + k), sc = *(const f32x4*)(SC2 + k); cmr[j] = nw * (sc + 1.f); shr[j] = *(const f32x4*)(SH2 + k); }
#pragma unroll 2
          for (int q = 0; q < 8; ++q) { const int t = tok0 + 8 * w + q; const float rinv = RINV[8 * w + q];
              const GAS f32x4* hr = (const GAS f32x4*)(H + (size_t)t * D) + lane; GAS unsigned* o4 = (GAS unsigned*)(VX + (size_t)t * D) + lane;
#pragma unroll
              for (int j = 0; j < 4; ++j) { const f32x4 u = hr[64 * j] * rinv * cmr[j] + shr[j]; o4[64 * j] = pk4_f8(u.x, u.y, u.z, u.w); } } }
        __syncthreads();
    }
}

__device__ __forceinline__ void moe_tables(Frame& F) {
    LAS int* TS = (LAS int*)(F.lds + L_TSTART); LAS int* TE = (LAS int*)(F.lds + L_TILEE);
    if (F.wave == 0) {
        const int e = F.lane; int nt = 0;
        if (e < 32) { const int c = (int)__hip_atomic_load((unsigned*)(F.ctl + CW_CNT + e), RLX_AGENT); nt = (c + 255) >> 8; ((LAS int*)(F.lds + L_LCNT))[e] = c; }
        int incl = nt;
#pragma unroll
        for (int o = 1; o < 32; o <<= 1) { const int y = __shfl_up(incl, o); if ((F.lane & 31) >= o) incl += y; }
        const int st = incl - nt;
        if (e < 32) { TS[e] = st; for (int i = 0; i < nt; ++i) TE[st + i] = e; if (e == 31) TS[32] = incl; }
    }
    __syncthreads();
}
struct MoeOrder {
    int G, c, nct; const LAS int* TS; const LAS int* TE; const LAS int* CN; const int* EXPL;
    const LAS int* ATOK;
    __device__ __forceinline__ int arow(const pg8::Unit&, int ui, int r) const { return ATOK[ui * 256 + r]; }
    __device__ __forceinline__ int arow_global(const pg8::Unit& u, int r) const { const int e = TE[u.pm]; const int idx = 256 * (u.pm - TS[e]) + r; return idx < CN[e] ? EXPL[e * 16384 + idx] : 0; }
    __device__ __forceinline__ bool next(int i, pg8::Unit& u) const {
        const int NT = TS[32]; int rt, ct;
        if (G == 256) {
            const int x = c & 7, q = c >> 3, rpx = 32 / nct; ct = q % nct; rt = (8 * i + x) * rpx + q / nct;
            if (rt >= NT) return false;
        } else { const int L = i * G + c; if (L >= NT * nct) return false; rt = L / nct; ct = L - rt * nct; }
        const int e = TE[rt];
        u.pm = __builtin_amdgcn_readfirstlane(rt); u.pn = __builtin_amdgcn_readfirstlane(e * nct + ct); return true;
    }
    __device__ __forceinline__ void a_ready(const pg8::Unit&) const {}
    __device__ __forceinline__ void done(const pg8::Unit&) const {}
};
struct EpiGlu {
    static constexpr bool PERM = true, AFTER_DRAIN = false;
    unsigned char* ACT; const float* B1;
    __device__ __forceinline__ void operator()(const f32x4 (&acc)[2][2][4][2], const pg8::Unit& u, int wr, int wc, int fr, int fq) const {
        const int e = u.pn >> 3, ct = u.pn & 7; const int row0 = u.pm * 256 + wr * 64 + fr; const int cb = wc * 32 + 8 * fq;
        f32x4 bg[2], bl[2];
#pragma unroll
        for (int n = 0; n < 2; ++n) { bg[n] = *(const f32x4*)(B1 + e * 2048 + 128 * ct + cb + 4 * n); bl[n] = *(const f32x4*)(B1 + e * 2048 + 1024 + 128 * ct + cb + 4 * n); }
#pragma unroll
        for (int ai = 0; ai < 2; ++ai)
#pragma unroll
            for (int m = 0; m < 4; ++m) { const int r = row0 + ai * 128 + m * 16; unsigned o[2];
#pragma unroll
                for (int n = 0; n < 2; ++n) { float a[4];
#pragma unroll
                    for (int i = 0; i < 4; ++i) { const float xg = fminf(acc[ai][0][m][n][i] * W8_INV + bg[n][i], 7.f); const float xl = fminf(fmaxf(acc[ai][1][m][n][i] * W8_INV + bl[n][i], -7.f), 7.f);
                        a[i] = xg * sigmoidf_(1.702f * xg) * (xl + 1.f); }
                    o[n] = pk4_f8(a[0], a[1], a[2], a[3]); }
                __hip_atomic_store((unsigned long long*)(ACT + (size_t)r * DFF + 128 * ct + cb), ((unsigned long long)o[1] << 32) | o[0], RLX_AGENT); }
    }
};
struct EpiDown {
    static constexpr bool PERM = true, AFTER_DRAIN = false;
    unsigned char* YB; const float* B2; const float* ROWGATE;
    __device__ __forceinline__ void operator()(const f32x4 (&acc)[2][2][4][2], const pg8::Unit& u, int wr, int wc, int fr, int fq) const {
        const int e = u.pn >> 2, ct = u.pn & 3; const int row0 = u.pm * 256 + wr * 64 + fr; const int cb = 256 * ct + wc * 32 + 8 * fq;
        f32x4 bv[2][2];
#pragma unroll
        for (int bj = 0; bj < 2; ++bj)
#pragma unroll
            for (int n = 0; n < 2; ++n) bv[bj][n] = *(const f32x4*)(B2 + e * 1024 + cb + 128 * bj + 4 * n);
#pragma unroll
        for (int ai = 0; ai < 2; ++ai)
#pragma unroll
            for (int m = 0; m < 4; ++m) { const int r = row0 + ai * 128 + m * 16; const float gt = ROWGATE[r];
#pragma unroll
                for (int bj = 0; bj < 2; ++bj) { const f32x4 v0 = (acc[ai][bj][m][0] * W8_INV + bv[bj][0]) * gt, v1 = (acc[ai][bj][m][1] * W8_INV + bv[bj][1]) * gt;
                    *(v2u*)(YB + (size_t)r * D + cb + 128 * bj) = (v2u){pk4_f8(v0[0], v0[1], v0[2], v0[3]), pk4_f8(v1[0], v1[1], v1[2], v1[3])}; } }
    }
};
constexpr int MOE_MAXU = 16;
struct MoeOrder2 {
    int nu; const LAS int* UL; const LAS int* ATOK; unsigned* READY; unsigned* tmo;
    __device__ __forceinline__ bool next(int i, pg8::Unit& u) const { if (i >= nu) return false; u.pm = __builtin_amdgcn_readfirstlane(UL[2 * i]); u.pn = __builtin_amdgcn_readfirstlane(UL[2 * i + 1]); return true; }
    __device__ __forceinline__ int arow(const pg8::Unit&, int ui, int r) const { return ATOK[ui * 256 + r]; }
    __device__ __forceinline__ void a_ready(const pg8::Unit& u) const {
        if (u.pn < 512) return;
        if (threadIdx.x < 64) { unsigned sp = 0;
            while ((unsigned)__builtin_amdgcn_readfirstlane(__hip_atomic_load(READY + 64 * u.pm, RLX_AGENT)) < 64u) { __builtin_amdgcn_s_sleep(8); if (++sp > (1u << 20)) { if (threadIdx.x == 0) __hip_atomic_store(tmo, 1u, RLX_AGENT); break; } }
            __builtin_amdgcn_fence(__ATOMIC_ACQUIRE, "agent"); asm volatile("s_waitcnt vmcnt(0)" ::: "memory"); }
        asm volatile("" ::: "memory"); __builtin_amdgcn_s_barrier(); asm volatile("" ::: "memory");
    }
    __device__ __forceinline__ void done(const pg8::Unit& u) const {
        if (u.pn >= 512) return;
        asm volatile("s_waitcnt vmcnt(0)" ::: "memory");
        if ((threadIdx.x & 63) == 0) __hip_atomic_fetch_add(READY + 64 * u.pm, 1u, RLX_AGENT);
    }
};
struct EpiMoe {
    static constexpr bool PERM = true, AFTER_DRAIN = false;
    EpiGlu g1; EpiDown g2;
    __device__ __forceinline__ void operator()(const f32x4 (&acc)[2][2][4][2], const pg8::Unit& u, int wr, int wc, int fr, int fq) const {
        if (u.pn < 512) g1(acc, u, wr, wc, fr, fq); else { pg8::Unit v = u; v.pn = u.pn - 512; g2(acc, v, wr, wc, fr, fq); }
    }
};
__device__ __forceinline__ void p10_final(Frame& F) {
    const int gw = F.vcu * NWAVES + F.wave, NGW = F.G * NWAVES;
    moe_tables(F);
    const LAS int* TS = (const LAS int*)(F.lds + L_TSTART);
    const float* MOD = (const float*)(F.ws + WS_MOD); const float* H = (const float*)(F.ws + WS_H); const unsigned char* YB = (const unsigned char*)(F.ws + WS_YB); const int* TOKE = (const int*)(F.ws + WS_TOKE); const int* TOKPOS = (const int*)(F.ws + WS_TOKPOS);
    for (int t = gw; t < NX; t += NGW) {
        const int b = t >> 11; int rows[4];
#pragma unroll
        for (int k = 0; k < 4; ++k) rows[k] = 256 * TS[TOKE[t * 4 + k]] + TOKPOS[t * 4 + k];
        f32x4 hv[4]; float ss = 0.f;
#pragma unroll
        for (int j = 0; j < 4; ++j) { const int k0 = 4 * F.lane + 256 * j; f32x4 y = (f32x4){0.f, 0.f, 0.f, 0.f};
#pragma unroll
            for (int k = 0; k < 4; ++k) { const unsigned yy = *(const unsigned*)(YB + (size_t)rows[k] * D + k0); const f32x2 lo = __builtin_amdgcn_cvt_pk_f32_fp8((int)yy, false), hi = __builtin_amdgcn_cvt_pk_f32_fp8((int)yy, true); y += (f32x4){lo.x, lo.y, hi.x, hi.y}; }
            const f32x4 h4 = *(const f32x4*)(H + (size_t)t * D + k0), g2 = *(const f32x4*)(MOD + b * 6144 + 5120 + k0);
            hv[j] = h4 + g2 * y; ss += (hv[j].x * hv[j].x + hv[j].y * hv[j].y) + (hv[j].z * hv[j].z + hv[j].w * hv[j].w); }
        const float rinv = 1.f / sqrtf(wave_sum(ss) * (1.f / D) + EPS);
#pragma unroll
        for (int j = 0; j < 4; ++j) { const int k0 = 4 * F.lane + 256 * j; const f32x4 nw = *(const f32x4*)(F.in[IN_NFIN] + k0); *(f32x4*)(F.out + (size_t)t * D + k0) = hv[j] * rinv * nw; }
    }
}

struct Args { const float* in[19]; float* out; unsigned char* ws; int ph_lo, ph_hi, li, pad; };
__global__ void __launch_bounds__(NWAVES * 64, 2) fwd_kernel(Args args) {
    extern __shared__ __attribute__((aligned(16))) unsigned char lds[];
    Frame F;
    F.lds = (LAS unsigned char*)lds;
    F.tid = threadIdx.x; F.lane = F.tid & 63; F.wave = __builtin_amdgcn_readfirstlane(F.tid >> 6);
    F.G = gridDim.x; { const int bx = blockIdx.x; F.vcu = (F.G % 8 == 0) ? (bx % 8) * (F.G / 8) + bx / 8 : bx; }
    F.ws = args.ws; F.ctl = (gu32*)(args.ws + WS_CTL); F.out = args.out;
    F.in = args.in;
    for (int u = F.tid; u < LCTL_BYTES / 4; u += NWAVES * 64) ((LAS unsigned*)F.lds)[u] = 0u;
    __syncthreads();
    XcdBarrier bar; bar.bar = (unsigned*)(F.ctl + CW_BAR); bar.x = 0; bar.st = nullptr;
    if (N_LAUNCHES == 1) bar = xcd_barrier_post((unsigned*)(F.ctl + CW_BAR), (volatile LAS unsigned*)(F.lds + L_MISC) + 8);
    const int lo = args.ph_lo, hi = args.ph_hi;
#ifndef PH_MASK
#define PH_MASK 0x7ff
#endif
#define IN(k) (((PH_MASK >> (k)) & 1) && lo <= (k) && (k) < hi)
#define SEAM(k) do { if (IN(k) && IN((k) + 1)) xcd_barrier(bar); } while (0)
    LAS unsigned char* ring = F.lds + SCR_OFF;
#ifndef REP_MASK
#define REP_MASK 0
#endif
#define NREP(k) (1 + ((REP_MASK >> (k)) & 1))
#ifndef TS_SEL
#define TS_SEL -1
#endif
#define TSTAMP(k) do { if (TS_SEL >= 0 && blockIdx.x == 0 && F.tid == 0) ((volatile LAS unsigned long long*)(F.lds + 1864))[k] = __builtin_amdgcn_s_memrealtime(); } while (0)
#define PH(k, ...) if (IN(k)) { { const int rep_ = 0; __VA_ARGS__; } if (NREP(k) > 1) { xcd_barrier(bar); { const int rep_ = 1; __VA_ARGS__; } } SEAM(k); TSTAMP((k) + 1); }
    TSTAMP(0);
    PH(0, {
        p0_prologue(F);
        if (F.G != 256) tail_transpose(F, 0, 24576, F.vcu * NWAVES + F.wave, F.G * NWAVES);
        if (F.wave == 0) { unsigned sp = 0; while (__hip_atomic_load((unsigned*)(F.ctl + CW_ADA), RLX_AGENT) < 96u) { __builtin_amdgcn_s_sleep(2); if (++sp > (1u << 22)) break; }
            __builtin_amdgcn_fence(__ATOMIC_ACQUIRE, "agent"); VM_WAIT(); }
        __syncthreads();
        p1_xn(F); })
    TSTAMP(2);
    PH(2, {
        pg8::Gemm g{(const bf16*)(F.ws + WS_XN), (const bf16*)(F.ws + WS_WIN), NROWS, PW, D};
        InProjOrder S{F.G, (int)blockIdx.x};
        EpiInProj E{(bf16*)(F.ws + WS_P), (const float*)(F.ws + WS_LB), (const float*)(F.ws + WS_COS), (const float*)(F.ws + WS_SIN)};
        pg8::gemm_phase<EpiInProj, InProjOrder, true, true>(ring, g, S, E);
        if (F.G == 256 && blockIdx.x >= 72) tail_transpose(F, 0, TP_P2_ITEMS, ((int)blockIdx.x - 72) * NWAVES + F.wave, 184 * NWAVES); })
    PH(3, p3_scan(F))
    PH(4, p4_merge(F))
    PH(5, {
        pg8::Gemm g{(const bf16*)(F.ws + WS_AO), (const bf16*)(F.ws + WS_WOUT), NX, D, D};
        pg8::StaticOrder S; S.init(NX, D, F.G, (int)blockIdx.x);
        EpiResid E{F.in[IN_X], (const float*)(F.ws + WS_MOD), (float*)(F.ws + WS_H)};
        pg8::gemm_phase<EpiResid, pg8::StaticOrder, true, true>(ring, g, S, E); })
    PH(6, p6_router(F, 64 * rep_))
    PH(7, {
        moe_tables(F);
        const LAS int* TS = (const LAS int*)(F.lds + L_TSTART); const LAS int* TE = (const LAS int*)(F.lds + L_TILEE); const LAS int* CN = (const LAS int*)(F.lds + L_LCNT);
        { const float* EXPG = (const float*)(F.ws + WS_EXPG); float* ROWGATE = (float*)(F.ws + WS_ROWGATE); const int nrow = TS[32] * 256;
          for (int row = F.vcu * (NWAVES * 64) + F.tid; row < nrow; row += F.G * NWAVES * 64) { const int e = TE[row >> 8], idx = row - 256 * TS[e]; ROWGATE[row] = idx < CN[e] ? EXPG[e * 16384 + idx] : 0.f; } }
        LAS int* atok = (LAS int*)(F.lds + SCR_OFF + 131072); LAS int* ul = atok + MOE_MAXU * 256;
        const int NT = TS[32], c = (int)blockIdx.x; int nu = 0;
        const int* EXPL = (const int*)(F.ws + WS_EXPL);
        for (int kind = 0; kind < 2; ++kind) { const int nct = kind ? 4 : 8, rpx = 32 / nct;
            for (int i = 0; nu < MOE_MAXU; ++i) { int rt, ct;
                if (F.G == 256) { const int x = kind ? 7 - (c & 7) : (c & 7), qq = c >> 3; ct = qq % nct; rt = (8 * i + x) * rpx + qq / nct; if ((8 * i) * rpx >= NT) break; if (rt >= NT) continue; }
                else { const int L = i * F.G + c; if (L >= NT * nct) break; rt = L / nct; ct = L - rt * nct; }
                const int e = TE[rt];
                if (F.tid == 0) { ul[2 * nu] = rt; ul[2 * nu + 1] = kind ? 512 + e * 4 + ct : e * 8 + ct; }
                if (F.tid < 256) { const int idx = 256 * (rt - TS[e]) + F.tid; atok[nu * 256 + F.tid] = kind ? 32768 + 256 * rt + F.tid : (idx < CN[e] ? EXPL[e * 16384 + idx] : 0); }
                ++nu; } }
        __syncthreads();
        pg8::Gemm g{(const bf16*)(F.ws + WS_VX), (const bf16*)(F.ws + WS_W1), NX, NEXP * 2048, D / 2};
        MoeOrder2 S{nu, ul, atok, (unsigned*)(F.ctl + CW_READY), (unsigned*)(F.ctl + CW_TMO)};
        EpiMoe E{EpiGlu{(unsigned char*)(F.ws + WS_ACT), F.in[IN_B1]}, EpiDown{(unsigned char*)(F.ws + WS_YB), F.in[IN_B2], (const float*)(F.ws + WS_ROWGATE)}};
        pg8::gemm_phase_ga<EpiMoe, MoeOrder2, true>(ring, g, S, E); })
    PH(8, p10_final(F))
#undef PH
    if (TS_SEL >= 0) { __syncthreads(); if (blockIdx.x == 0 && F.tid == 0) { VM_WAIT(); volatile LAS unsigned long long* ts = (volatile LAS unsigned long long*)(F.lds + 1864);
        const float us = (TS_SEL == 0 ? 32.f : 8.f) * rintf((float)(ts[TS_SEL + 1] - ts[TS_SEL]) * (TS_SEL == 0 ? 0.0003125f : 0.00125f)); F.out[0] = F.out[0] + us; } }
#undef IN
#undef SEAM
}

extern "C" void kernel_launch(void* const* d_in, const int* in_sizes, int n_in, void* d_out, int out_size, void* d_ws, size_t ws_size, hipStream_t stream) {
    static int grid = 0;
    if (grid == 0) {
        if (n_in != 19 || in_sizes[0] != NX * D || out_size != NX * D || ws_size < WS_END) { fprintf(stderr, "kernel_launch: unexpected shapes (n_in %d, in0 %d, out %d, ws %zu; need ws >= %zu)\n", n_in, n_in > 0 ? in_sizes[0] : -1, out_size, ws_size, (size_t)WS_END); grid = -1; return; }
        int dev = 0, cus = 0, per_cu = 0;
        if (hipGetDevice(&dev) != hipSuccess || hipDeviceGetAttribute(&cus, hipDeviceAttributeMultiprocessorCount, dev) != hipSuccess) { fprintf(stderr, "kernel_launch: device query failed\n"); grid = -1; return; }
        if (hipFuncSetAttribute((const void*)fwd_kernel, hipFuncAttributeMaxDynamicSharedMemorySize, LDS_BYTES) != hipSuccess) { fprintf(stderr, "kernel_launch: hipFuncSetAttribute failed\n"); grid = -1; return; }
        if (hipOccupancyMaxActiveBlocksPerMultiprocessor(&per_cu, (const void*)fwd_kernel, NWAVES * 64, LDS_BYTES) != hipSuccess || per_cu < 1)
            fprintf(stderr, "kernel_launch: note: occupancy query reports %d workgroups per CU\n", per_cu);
        (void)hipGetLastError();
        grid = cus;
    }
    if (grid < 0) return;
    if (hipMemsetAsync((char*)d_ws + WS_CTL, 0, CTL_ZERO_BYTES, stream) != hipSuccess) { fprintf(stderr, "kernel_launch: hipMemsetAsync failed\n"); return; }
    Args a{};
    for (int i = 0; i < 19; ++i) a.in[i] = (const float*)d_in[i];
    a.out = (float*)d_out; a.ws = (unsigned char*)d_ws;
    for (int li = 0; li < N_LAUNCHES; ++li) {
        a.ph_lo = (N_LAUNCHES == 1) ? 0 : li; a.ph_hi = (N_LAUNCHES == 1) ? NPHASE : li + 1; a.li = li;
        hipLaunchKernelGGL(fwd_kernel, dim3(grid), dim3(NWAVES * 64), LDS_BYTES, stream, a);
        const hipError_t le = hipPeekAtLastError();
        if (le != hipSuccess) { fprintf(stderr, "kernel_launch: launch %d failed: %s\n", li, hipGetErrorName(le)); break; }
    }
}
```

```cpp
#include <hip/hip_runtime.h>
#include <cstdio>
#include <cstdint>
namespace pg8 {
#define PG8_LAS __attribute__((address_space(3)))
typedef unsigned short bf16_t;
typedef short bf16x8 __attribute__((ext_vector_type(8)));
typedef float f32x4 __attribute__((ext_vector_type(4)));
typedef unsigned u32x4 __attribute__((ext_vector_type(4)));
constexpr int BM = 256, BK = 64, HALF = 128, HTB = HALF * BK * 2  , STAGE_BYTES = 8 * HTB, NXCD = 8, WGM = 8;

__host__ __device__ __forceinline__ int lds_byte(int r, int c) { const int st = (r >> 4) * 2 + (c >> 5), rr = r & 15, cc = c & 31, ob = rr * 64 + cc * 2; return st * 1024 + (ob ^ (((ob >> 9) & 1) << 5)); }
__host__ __device__ __forceinline__ void stage_rc(int b, int& R, int& C) { const int st = b / 1024, sb = b % 1024, swz = sb ^ (((sb >> 9) & 1) << 5); R = (st >> 1) * 16 + swz / 64; C = (st & 1) * 32 + (swz % 64) / 2; }
__host__ __device__ __forceinline__ int perm32(int rho) { const int n = rho >> 4, i = rho & 15; return 8 * (i >> 2) + 4 * n + (i & 3); }

struct Unit { int pm, pn; };
struct Gemm { const bf16_t* A; const bf16_t* Bt; int M, N, K; };

struct StaticOrder {
    int nM, nN, nwg, G, c;
    __host__ __device__ void init(int M, int N, int G_, int c_) { nM = M / BM; nN = N / BM; nwg = nM * nN; G = G_; c = c_; }
    __host__ __device__ bool next(int i, Unit& u) const {
        const long L = (long)i * G + c; if (L >= nwg) return false;
        int wgid = (int)L; { const int q = nwg / NXCD, r = nwg % NXCD, xcd = wgid % NXCD, off = wgid / NXCD; wgid = (xcd < r ? xcd * (q + 1) : r * (q + 1) + (xcd - r) * q) + off; }
        const int nig = WGM * nN, gid = wgid / nig, fm = gid * WGM, gsz = (nM - fm) < WGM ? (nM - fm) : WGM;
        u.pm = fm + ((wgid % nig) % gsz); u.pn = (wgid % nig) / gsz; return true;
    }
    __device__ __forceinline__ void a_ready(const Unit&) const {}
    __device__ __forceinline__ void done(const Unit&) const {}
};

typedef int v8i_t __attribute__((ext_vector_type(8))); typedef int v4i_t __attribute__((ext_vector_type(4)));
__device__ __forceinline__ bf16x8 lo8(v8i_t v) { return __builtin_bit_cast(bf16x8, (v4i_t)__builtin_shufflevector(v, v, 0, 1, 2, 3)); }
__device__ __forceinline__ bf16x8 hi8(v8i_t v) { return __builtin_bit_cast(bf16x8, (v4i_t)__builtin_shufflevector(v, v, 4, 5, 6, 7)); }
__device__ __forceinline__ v8i_t cat8(bf16x8 lo, bf16x8 hi) { return __builtin_shufflevector(__builtin_bit_cast(v4i_t, lo), __builtin_bit_cast(v4i_t, hi), 0, 1, 2, 3, 4, 5, 6, 7); }
__device__ __forceinline__ void mfma_f8_acc(f32x4& acc, v8i_t a, v8i_t b) { asm volatile("s_nop 1\n\tv_mfma_f32_16x16x128_f8f6f4 %0, %1, %2, %0" : "+v"(acc) : "v"(a), "v"(b)); }
template <class Epi, class Sched, bool ALIGN_EPI = false, bool SP2 = false, bool F8 = false>
__device__ __forceinline__ void gemm_phase(PG8_LAS unsigned char* lds, const Gemm g, const Sched& S, const Epi& E) {
    const int tid = threadIdx.x, wid = __builtin_amdgcn_readfirstlane(tid >> 6), lane = tid & 63, wr = wid >> 2, wc = wid & 3, fr = lane & 15, fq = lane >> 4;
    const int K = g.K, nt = K / BK;
    unsigned voffA[2], voffB[2];
#pragma unroll
    for (int i = 0; i < 2; ++i) { int R, C; stage_rc(tid * 16 + i * 8192, R, C); const int Rb = Epi::PERM ? ((R & ~31) + perm32(R & 31)) : R;
        voffA[i] = (unsigned)(R * K + C) * 2u; voffB[i] = (unsigned)(Rb * K + C) * 2u; }
    const size_t kstep = (size_t)(BK * 2);
    const size_t hstep = (size_t)HALF * K * 2;
    const size_t tstep = 2 * hstep;
    const unsigned ldsw = (unsigned)wid * 1024u;
    const int aoff = lds_byte(wr * 64 + fr, fq * 8), boff = lds_byte(wc * 32 + fr, fq * 8);
#define PG8_SA(b, h) (((b) * 2 + (h)) * HTB)
#define PG8_SB(b, h) ((4 + (b) * 2 + (h)) * HTB)
#define PG8_STAGE(bufoff, gbase, voff) do { _Pragma("unroll") for (int _i = 0; _i < 2; ++_i) \
        __builtin_amdgcn_global_load_lds((const unsigned*)((const char*)(gbase) + (voff)[_i]), (PG8_LAS unsigned*)(lds + (bufoff) + ldsw + _i * 8192), 16, 0, 0); } while (0)
#define PG8_LDA(dst, b, h) do { _Pragma("unroll") for (int m = 0; m < 4; ++m) dst[m] = cat8(*(const PG8_LAS bf16x8*)(lds + PG8_SA(b, h) + aoff + m * 2048), *(const PG8_LAS bf16x8*)(lds + PG8_SA(b, h) + aoff + m * 2048 + 1024)); } while (0)
#define PG8_LDB(dst, b, h) do { _Pragma("unroll") for (int n = 0; n < 2; ++n) dst[n] = cat8(*(const PG8_LAS bf16x8*)(lds + PG8_SB(b, h) + boff + n * 2048), *(const PG8_LAS bf16x8*)(lds + PG8_SB(b, h) + boff + n * 2048 + 1024)); } while (0)
#define PG8_MMA(ai, bj, At, Bt) do { __builtin_amdgcn_s_setprio(1); _Pragma("unroll") for (int m = 0; m < 4; ++m) _Pragma("unroll") for (int n = 0; n < 2; ++n) { \
        if constexpr (F8) mfma_f8_acc(acc[ai][bj][m][n], Bt[n], At[m]); \
        else { acc[ai][bj][m][n] = __builtin_amdgcn_mfma_f32_16x16x32_bf16(lo8(Bt[n]), lo8(At[m]), acc[ai][bj][m][n], 0, 0, 0); acc[ai][bj][m][n] = __builtin_amdgcn_mfma_f32_16x16x32_bf16(hi8(Bt[n]), hi8(At[m]), acc[ai][bj][m][n], 0, 0, 0); } } \
        __builtin_amdgcn_s_setprio(0); } while (0)
#define PG8_WAIT_V(n) asm volatile("s_waitcnt vmcnt(" #n ")" ::: "memory")
#define PG8_WAIT_L(n) asm volatile("s_waitcnt lgkmcnt(" #n ")" ::: "memory")
#define PG8_BAR __builtin_amdgcn_s_barrier()
#define PG8_SCHED __builtin_amdgcn_sched_barrier(0)
    Unit cur, nxt; int ui = 0;
    if (!S.next(0, cur)) return;
    f32x4 acc[2][2][4][2];
#pragma unroll
    for (int a = 0; a < 2; ++a)
#pragma unroll
        for (int b = 0; b < 2; ++b)
#pragma unroll
            for (int m = 0; m < 4; ++m)
#pragma unroll
                for (int n = 0; n < 2; ++n) acc[a][b][m][n] = (f32x4){0.f, 0.f, 0.f, 0.f};
    v8i_t At[4], B0[2], B1[2];
    const char* cA = (const char*)g.A + (size_t)cur.pm * tstep; const char* cB = (const char*)g.Bt + (size_t)cur.pn * tstep;
    S.a_ready(cur);
    if constexpr (SP2) {
        PG8_STAGE(PG8_SB(0, 0), cB, voffB); PG8_STAGE(PG8_SB(0, 1), cB + hstep, voffB); PG8_STAGE(PG8_SA(0, 0), cA, voffA); PG8_STAGE(PG8_SA(0, 1), cA + hstep, voffA);
        if (wr == 1) PG8_BAR;
        PG8_WAIT_V(2); PG8_BAR;
        PG8_STAGE(PG8_SB(1, 0), cB + kstep, voffB); PG8_STAGE(PG8_SA(1, 0), cA + kstep, voffA); PG8_STAGE(PG8_SB(1, 1), cB + hstep + kstep, voffB);
        PG8_WAIT_V(6); PG8_BAR;
    } else {
        PG8_STAGE(PG8_SB(0, 0), cB, voffB); PG8_STAGE(PG8_SA(0, 0), cA, voffA); PG8_STAGE(PG8_SB(0, 1), cB + hstep, voffB); PG8_STAGE(PG8_SA(0, 1), cA + hstep, voffA);
        if (wr == 1) PG8_BAR;
        PG8_WAIT_V(4); PG8_BAR;
        PG8_STAGE(PG8_SB(1, 0), cB + kstep, voffB); PG8_STAGE(PG8_SA(1, 0), cA + kstep, voffA); PG8_STAGE(PG8_SB(1, 1), cB + hstep + kstep, voffB);
        PG8_WAIT_V(6); PG8_BAR;
    }
    for (;;) {
        const bool has_next = S.next(ui + 1, nxt);
        const char* nA = has_next ? (const char*)g.A + (size_t)nxt.pm * tstep : cA; const char* nB = has_next ? (const char*)g.Bt + (size_t)nxt.pn * tstep : cB;
#pragma unroll 1
        for (int t = 0; t < nt; t += 2) {
            const bool last = (t == nt - 2);
            const char* a1 = cA + (size_t)(t + 1) * kstep;
            const char* a2 = last ? nA : cA + (size_t)(t + 2) * kstep; const char* b2 = last ? nB : cB + (size_t)(t + 2) * kstep;
            const char* a3 = a2 + kstep; const char* b3 = b2 + kstep;
            if (last && has_next) S.a_ready(nxt);
            if constexpr (SP2) {
            PG8_LDB(B0, 0, 0); PG8_LDB(B1, 0, 1); PG8_SCHED; PG8_LDA(At, 0, 0); PG8_STAGE(PG8_SA(1, 1), a1 + hstep, voffA);
            PG8_WAIT_V(8); PG8_WAIT_L(0); PG8_BAR; PG8_MMA(0, 0, At, B0); PG8_MMA(0, 1, At, B1); PG8_BAR; PG8_SCHED;
            PG8_LDA(At, 0, 1); PG8_STAGE(PG8_SB(0, 0), b2, voffB); PG8_STAGE(PG8_SB(0, 1), b2 + hstep, voffB); PG8_STAGE(PG8_SA(0, 0), a2, voffA);
            PG8_WAIT_V(8); PG8_WAIT_L(0); PG8_BAR; PG8_MMA(1, 0, At, B0); PG8_MMA(1, 1, At, B1); PG8_BAR; PG8_SCHED;
            PG8_LDB(B0, 1, 0); PG8_LDB(B1, 1, 1); PG8_SCHED; PG8_LDA(At, 1, 0); PG8_STAGE(PG8_SA(0, 1), a2 + hstep, voffA);
            PG8_WAIT_V(8); PG8_WAIT_L(0); PG8_BAR; PG8_MMA(0, 0, At, B0); PG8_MMA(0, 1, At, B1); PG8_BAR; PG8_SCHED;
            PG8_LDA(At, 1, 1); PG8_STAGE(PG8_SB(1, 0), b3, voffB); PG8_STAGE(PG8_SB(1, 1), b3 + hstep, voffB); PG8_STAGE(PG8_SA(1, 0), a3, voffA);
            PG8_WAIT_V(8); PG8_WAIT_L(0); PG8_BAR; PG8_MMA(1, 0, At, B0); PG8_MMA(1, 1, At, B1); PG8_BAR; PG8_SCHED;
            } else {
            PG8_LDB(B0, 0, 0); PG8_SCHED; PG8_LDA(At, 0, 0); PG8_STAGE(PG8_SA(1, 1), a1 + hstep, voffA);
            PG8_WAIT_L(8); PG8_BAR; PG8_WAIT_L(0); PG8_MMA(0, 0, At, B0); PG8_BAR; PG8_SCHED;
            PG8_LDB(B1, 0, 1); PG8_STAGE(PG8_SB(0, 0), b2, voffB);
            PG8_BAR; PG8_WAIT_L(0); PG8_MMA(0, 1, At, B1); PG8_BAR;
            PG8_LDA(At, 0, 1); PG8_STAGE(PG8_SA(0, 0), a2, voffA);
            PG8_BAR; PG8_WAIT_L(0); PG8_MMA(1, 0, At, B0); PG8_BAR; PG8_SCHED;
            PG8_STAGE(PG8_SB(0, 1), b2 + hstep, voffB);
            PG8_WAIT_V(6); PG8_BAR; PG8_MMA(1, 1, At, B1); PG8_BAR;
            PG8_LDB(B0, 1, 0); PG8_SCHED; PG8_LDA(At, 1, 0); PG8_STAGE(PG8_SA(0, 1), a2 + hstep, voffA);
            PG8_WAIT_L(8); PG8_BAR; PG8_WAIT_L(0); PG8_MMA(0, 0, At, B0); PG8_BAR; PG8_SCHED;
            PG8_LDB(B1, 1, 1); PG8_STAGE(PG8_SB(1, 0), b3, voffB);
            PG8_BAR; PG8_WAIT_L(0); PG8_MMA(0, 1, At, B1); PG8_BAR;
            PG8_LDA(At, 1, 1); PG8_STAGE(PG8_SA(1, 0), a3, voffA);
            PG8_BAR; PG8_WAIT_L(0); PG8_MMA(1, 0, At, B0); PG8_BAR; PG8_SCHED;
            PG8_STAGE(PG8_SB(1, 1), b3 + hstep, voffB);
            PG8_WAIT_V(6); PG8_BAR; PG8_MMA(1, 1, At, B1); PG8_BAR;
            }
        }
        if constexpr (ALIGN_EPI) { if (wr == 0) PG8_BAR; }
        if constexpr (F8) asm volatile("s_nop 15\n\ts_nop 15" ::: "memory");
        if constexpr (!Epi::AFTER_DRAIN) { E(acc, cur, wr, wc, fr, fq); S.done(cur); }
        if (!has_next) break;
#pragma unroll
        for (int a = 0; a < 2; ++a)
#pragma unroll
            for (int b = 0; b < 2; ++b)
#pragma unroll
                for (int m = 0; m < 4; ++m)
#pragma unroll
                    for (int n = 0; n < 2; ++n) acc[a][b][m][n] = (f32x4){0.f, 0.f, 0.f, 0.f};
        cur = nxt; cA = nA; cB = nB; ++ui;
        if constexpr (ALIGN_EPI) { if (wr == 1) PG8_BAR; }
    }
    PG8_WAIT_V(0);
    if constexpr (!ALIGN_EPI) { if (wr == 0) PG8_BAR; }
    PG8_BAR;
    if constexpr (Epi::AFTER_DRAIN) { E.fused(acc, cur, wr, wc, fr, fq, lds, wid, lane); S.done(cur); }
#undef PG8_SA
#undef PG8_SB
#undef PG8_STAGE
#undef PG8_LDA
#undef PG8_LDB
#undef PG8_MMA
#undef PG8_WAIT_V
#undef PG8_WAIT_L
#undef PG8_BAR
#undef PG8_SCHED
}
template <class Epi, class Sched, bool F8 = false>
__device__ __forceinline__ void gemm_phase_ga(PG8_LAS unsigned char* lds, const Gemm g, const Sched& S, const Epi& E) {
    const int tid = threadIdx.x, wid = __builtin_amdgcn_readfirstlane(tid >> 6), lane = tid & 63, wr = wid >> 2, wc = wid & 3, fr = lane & 15, fq = lane >> 4;
    constexpr bool ALIGN_EPI = true, SP2 = true;
    const int K = g.K, nt = K / BK;
    unsigned voffB[2]; int RA[2]; unsigned CA[2]; unsigned vA[2][2], vAn[2][2];
#pragma unroll
    for (int i = 0; i < 2; ++i) { int R, C; stage_rc(tid * 16 + i * 8192, R, C); const int Rb = Epi::PERM ? ((R & ~31) + perm32(R & 31)) : R;
        RA[i] = R; CA[i] = (unsigned)C * 2u; voffB[i] = (unsigned)(Rb * K + C) * 2u; }
    const size_t kstep = (size_t)(BK * 2);
    const size_t hstep = (size_t)HALF * K * 2;
    const size_t tstep = 2 * hstep;
    const unsigned ldsw = (unsigned)wid * 1024u;
    const int aoff = lds_byte(wr * 64 + fr, fq * 8), boff = lds_byte(wc * 32 + fr, fq * 8);
#define PG8_SA(b, h) (((b) * 2 + (h)) * HTB)
#define PG8_SB(b, h) ((4 + (b) * 2 + (h)) * HTB)
#define PG8_STAGE(bufoff, gbase, voff) do { _Pragma("unroll") for (int _i = 0; _i < 2; ++_i) \
        __builtin_amdgcn_global_load_lds((const unsigned*)((const char*)(gbase) + (voff)[_i]), (PG8_LAS unsigned*)(lds + (bufoff) + ldsw + _i * 8192), 16, 0, 0); } while (0)
#define PG8_LDA(dst, b, h) do { _Pragma("unroll") for (int m = 0; m < 4; ++m) dst[m] = cat8(*(const PG8_LAS bf16x8*)(lds + PG8_SA(b, h) + aoff + m * 2048), *(const PG8_LAS bf16x8*)(lds + PG8_SA(b, h) + aoff + m * 2048 + 1024)); } while (0)
#define PG8_LDB(dst, b, h) do { _Pragma("unroll") for (int n = 0; n < 2; ++n) dst[n] = cat8(*(const PG8_LAS bf16x8*)(lds + PG8_SB(b, h) + boff + n * 2048), *(const PG8_LAS bf16x8*)(lds + PG8_SB(b, h) + boff + n * 2048 + 1024)); } while (0)
#define PG8_MMA(ai, bj, At, Bt) do { __builtin_amdgcn_s_setprio(1); _Pragma("unroll") for (int m = 0; m < 4; ++m) _Pragma("unroll") for (int n = 0; n < 2; ++n) { \
        if constexpr (F8) mfma_f8_acc(acc[ai][bj][m][n], Bt[n], At[m]); \
        else { acc[ai][bj][m][n] = __builtin_amdgcn_mfma_f32_16x16x32_bf16(lo8(Bt[n]), lo8(At[m]), acc[ai][bj][m][n], 0, 0, 0); acc[ai][bj][m][n] = __builtin_amdgcn_mfma_f32_16x16x32_bf16(hi8(Bt[n]), hi8(At[m]), acc[ai][bj][m][n], 0, 0, 0); } } \
        __builtin_amdgcn_s_setprio(0); } while (0)
#define PG8_WAIT_V(n) asm volatile("s_waitcnt vmcnt(" #n ")" ::: "memory")
#define PG8_WAIT_L(n) asm volatile("s_waitcnt lgkmcnt(" #n ")" ::: "memory")
#define PG8_BAR __builtin_amdgcn_s_barrier()
#define PG8_SCHED __builtin_amdgcn_sched_barrier(0)
    Unit cur, nxt; int ui = 0;
    if (!S.next(0, cur)) return;
    f32x4 acc[2][2][4][2];
#pragma unroll
    for (int a = 0; a < 2; ++a)
#pragma unroll
        for (int b = 0; b < 2; ++b)
#pragma unroll
            for (int m = 0; m < 4; ++m)
#pragma unroll
                for (int n = 0; n < 2; ++n) acc[a][b][m][n] = (f32x4){0.f, 0.f, 0.f, 0.f};
    v8i_t At[4], B0[2], B1[2];
    const char* cA = (const char*)g.A; const char* cB = (const char*)g.Bt + (size_t)cur.pn * tstep;
#pragma unroll
    for (int h = 0; h < 2; ++h)
#pragma unroll
        for (int i = 0; i < 2; ++i) vA[h][i] = (unsigned)S.arow(cur, 0, RA[i] + 128 * h) * (unsigned)(K * 2) + CA[i];
    S.a_ready(cur);
    if constexpr (SP2) {
        PG8_STAGE(PG8_SB(0, 0), cB, voffB); PG8_STAGE(PG8_SB(0, 1), cB + hstep, voffB); PG8_STAGE(PG8_SA(0, 0), cA, vA[0]); PG8_STAGE(PG8_SA(0, 1), cA, vA[1]);
        if (wr == 1) PG8_BAR;
        PG8_WAIT_V(2); PG8_BAR;
        PG8_STAGE(PG8_SB(1, 0), cB + kstep, voffB); PG8_STAGE(PG8_SA(1, 0), cA + kstep, vA[0]); PG8_STAGE(PG8_SB(1, 1), cB + hstep + kstep, voffB);
        PG8_WAIT_V(6); PG8_BAR;
    }
    for (;;) {
        const bool has_next = S.next(ui + 1, nxt);
        const char* nB = has_next ? (const char*)g.Bt + (size_t)nxt.pn * tstep : cB;
#pragma unroll
        for (int h = 0; h < 2; ++h)
#pragma unroll
            for (int i = 0; i < 2; ++i) vAn[h][i] = has_next ? (unsigned)S.arow(nxt, ui + 1, RA[i] + 128 * h) * (unsigned)(K * 2) + CA[i] : vA[h][i];
#pragma unroll 1
        for (int t = 0; t < nt; t += 2) {
            const bool last = (t == nt - 2);
            const char* a1 = cA + (size_t)(t + 1) * kstep;
            const char* a2 = last ? cA : cA + (size_t)(t + 2) * kstep;
            unsigned w2[2][2];
            _Pragma("unroll") for (int h = 0; h < 2; ++h) _Pragma("unroll") for (int i = 0; i < 2; ++i) w2[h][i] = last ? vAn[h][i] : vA[h][i]; const char* b2 = last ? nB : cB + (size_t)(t + 2) * kstep;
            const char* a3 = a2 + kstep; const char* b3 = b2 + kstep;
            if (last && has_next) S.a_ready(nxt);
            if constexpr (SP2) {
            PG8_LDB(B0, 0, 0); PG8_LDB(B1, 0, 1); PG8_SCHED; PG8_LDA(At, 0, 0); PG8_STAGE(PG8_SA(1, 1), a1, vA[1]);
            PG8_WAIT_V(8); PG8_WAIT_L(0); PG8_BAR; PG8_MMA(0, 0, At, B0); PG8_MMA(0, 1, At, B1); PG8_BAR; PG8_SCHED;
            PG8_LDA(At, 0, 1); PG8_STAGE(PG8_SB(0, 0), b2, voffB); PG8_STAGE(PG8_SB(0, 1), b2 + hstep, voffB); PG8_STAGE(PG8_SA(0, 0), a2, w2[0]);
            PG8_WAIT_V(8); PG8_WAIT_L(0); PG8_BAR; PG8_MMA(1, 0, At, B0); PG8_MMA(1, 1, At, B1); PG8_BAR; PG8_SCHED;
            PG8_LDB(B0, 1, 0); PG8_LDB(B1, 1, 1); PG8_SCHED; PG8_LDA(At, 1, 0); PG8_STAGE(PG8_SA(0, 1), a2, w2[1]);
            PG8_WAIT_V(8); PG8_WAIT_L(0); PG8_BAR; PG8_MMA(0, 0, At, B0); PG8_MMA(0, 1, At, B1); PG8_BAR; PG8_SCHED;
            PG8_LDA(At, 1, 1); PG8_STAGE(PG8_SB(1, 0), b3, voffB); PG8_STAGE(PG8_SB(1, 1), b3 + hstep, voffB); PG8_STAGE(PG8_SA(1, 0), a3, w2[0]);
            PG8_WAIT_V(8); PG8_WAIT_L(0); PG8_BAR; PG8_MMA(1, 0, At, B0); PG8_MMA(1, 1, At, B1); PG8_BAR; PG8_SCHED;
            }
        }
        if constexpr (ALIGN_EPI) { if (wr == 0) PG8_BAR; }
        if constexpr (F8) asm volatile("s_nop 15\n\ts_nop 15" ::: "memory");
        if constexpr (!Epi::AFTER_DRAIN) { E(acc, cur, wr, wc, fr, fq); S.done(cur); }
        if (!has_next) break;
#pragma unroll
        for (int a = 0; a < 2; ++a)
#pragma unroll
            for (int b = 0; b < 2; ++b)
#pragma unroll
                for (int m = 0; m < 4; ++m)
#pragma unroll
                    for (int n = 0; n < 2; ++n) acc[a][b][m][n] = (f32x4){0.f, 0.f, 0.f, 0.f};
        cur = nxt; cB = nB; ++ui;
#pragma unroll
        for (int h = 0; h < 2; ++h)
#pragma unroll
            for (int i = 0; i < 2; ++i) vA[h][i] = vAn[h][i];
        if constexpr (ALIGN_EPI) { if (wr == 1) PG8_BAR; }
    }
    PG8_WAIT_V(0);
    if constexpr (!ALIGN_EPI) { if (wr == 0) PG8_BAR; }
    PG8_BAR;
    if constexpr (Epi::AFTER_DRAIN) { E.fused(acc, cur, wr, wc, fr, fq, lds, wid, lane); S.done(cur); }
#undef PG8_SA
#undef PG8_SB
#undef PG8_STAGE
#undef PG8_LDA
#undef PG8_LDB
#undef PG8_MMA
#undef PG8_WAIT_V
#undef PG8_WAIT_L
#undef PG8_BAR
#undef PG8_SCHED
}
}

constexpr int NWAVES = 8;
constexpr int NPHASE = 9;
#ifndef MK_N_LAUNCHES
#define MK_N_LAUNCHES 1
#endif
constexpr int N_LAUNCHES = MK_N_LAUNCHES;

constexpr int D = 1024, BATCH = 8, SEQ = 2048, CTX = 256;
constexpr int NX = BATCH * SEQ, NC = BATCH * CTX, NROWS = NX + NC;
constexpr int PW = 4096;
constexpr int NEXP = 32, TOPK = 4, DFF = 1024;
constexpr int MAXRT = 288;
constexpr float EPS = 1e-6f;

constexpr size_t MiB = 1u << 20;
constexpr size_t WS_CTL = 0, CTL_ZERO_BYTES = 1 * MiB;
constexpr size_t WS_MOD = 1 * MiB;
constexpr size_t WS_LB = 1 * MiB + 512 * 1024;
constexpr size_t WS_COS = WS_LB + 4096, WS_SIN = WS_COS + 2048 * 32 * 4;
constexpr size_t WS_TOKE = 2 * MiB, WS_TOKPOS = WS_TOKE + 256 * 1024, WS_TOKGATE = WS_TOKPOS + 256 * 1024, WS_TOKROW = WS_TOKGATE + 256 * 1024, WS_ROWGATE = WS_TOKROW + 256 * 1024;
constexpr size_t WS_WIN = 4 * MiB, WS_WOUT = 12 * MiB, WS_W1 = 14 * MiB, WS_W2 = 142 * MiB;
constexpr size_t WS_XN = 206 * MiB, WS_P = 242 * MiB, WS_XG = WS_P, WS_OF = 386 * MiB, WS_OB = 418 * MiB, WS_AO = 450 * MiB;
constexpr size_t WS_H = 482 * MiB, WS_VX = 546 * MiB, WS_ACT = 578 * MiB, WS_YB = 722 * MiB, WS_END = 866 * MiB;
constexpr size_t WS_EXPL = WS_P, WS_EXPG = WS_P + 2 * MiB;
constexpr int CW_TMO = 0, CW_CODE = 1, CW_BAR = 4096, CW_CNT = 8192, CW_ADA = 8448, CW_READY = 32768;

constexpr int LCTL_BYTES = 2048, SCR_OFF = LCTL_BYTES, LDS_BYTES = 163840;
constexpr int L_MISC = 0;
constexpr int L_TSTART = 128;
constexpr int L_TILEE = 384;
constexpr int L_LCNT = 1600;
constexpr int L_GBASE = 1728;

#define GAS __attribute__((address_space(1)))
#define LAS __attribute__((address_space(3)))
typedef unsigned short bf16;
typedef unsigned v4u __attribute__((ext_vector_type(4)));
typedef unsigned v2u __attribute__((ext_vector_type(2)));
typedef float f32x4 __attribute__((ext_vector_type(4)));
typedef float f32x2 __attribute__((ext_vector_type(2)));
typedef short bf16x8 __attribute__((ext_vector_type(8)));
typedef GAS unsigned gu32;
#define RLX_AGENT __ATOMIC_RELAXED, __HIP_MEMORY_SCOPE_AGENT
#define LDS_WAIT() asm volatile("s_waitcnt lgkmcnt(0)" ::: "memory")
#define VM_WAIT() asm volatile("s_waitcnt vmcnt(0)" ::: "memory")
#define LBAR() do { asm volatile("s_waitcnt lgkmcnt(0)" ::: "memory"); __builtin_amdgcn_s_barrier(); asm volatile("" ::: "memory"); } while (0)
__device__ __forceinline__ unsigned f2bf(float f) { unsigned u = __builtin_bit_cast(unsigned, f); return (u + 0x7fffu + ((u >> 16) & 1u)) >> 16; }
typedef __bf16 bf16x2_t __attribute__((ext_vector_type(2)));
__device__ __forceinline__ unsigned pk2(float lo, float hi) { return __builtin_bit_cast(unsigned, __builtin_convertvector((f32x2){lo, hi}, bf16x2_t)); }
__device__ __forceinline__ unsigned pk4_f8(float a, float b, float c, float d) { int p = 0; p = __builtin_amdgcn_cvt_pk_fp8_f32(a, b, p, false); p = __builtin_amdgcn_cvt_pk_fp8_f32(c, d, p, true); return (unsigned)p; }
constexpr float W8_SCALE = 32.f, W8_INV = 1.f / 32.f;
__device__ __forceinline__ float bflo(unsigned u) { return __builtin_bit_cast(float, u << 16); }
__device__ __forceinline__ float bfhi(unsigned u) { return __builtin_bit_cast(float, u & 0xffff0000u); }
__device__ __forceinline__ float wave_sum(float v) {
#pragma unroll
    for (int o = 1; o < 64; o <<= 1) v += __shfl_xor(v, o);
    return v;
}
__device__ __forceinline__ float sigmoidf_(float x) { return __builtin_amdgcn_rcpf(1.f + __expf(-x)); }
__device__ __forceinline__ float siluf_(float x) { return x * __builtin_amdgcn_rcpf(1.f + __expf(-x)); }

#define XB_TMO      128
#define XB_XCNT(j)  (256  + 64 * (j))
#define XB_XSUB(j)  (1280 + 64 * (j))
#define XB_XGEN(j)  (2304 + 64 * (j))
#define XB_TOP      3328
#define XB_TOPGEN   3392
#define XCD_BAR_WORDS 3456
#define XB_SPIN_CAP (1u << 18)

__device__ __forceinline__ unsigned xb_ld(unsigned* p)              { return __hip_atomic_load(p, __ATOMIC_RELAXED, __HIP_MEMORY_SCOPE_AGENT); }
__device__ __forceinline__ unsigned xb_add(unsigned* p, unsigned v) { return __hip_atomic_fetch_add(p, v, __ATOMIC_RELAXED, __HIP_MEMORY_SCOPE_AGENT); }
__device__ __forceinline__ unsigned xb_xcc_id() { return (unsigned)__builtin_amdgcn_s_getreg((3 << 11) | 20) & 0xFu; }
#define XB_SPIN(cond, bar) do { unsigned _sp = 0; while (cond) { __builtin_amdgcn_s_sleep(1); \
    if ((++_sp & 255u) == 0u) { if (xb_ld(&(bar)[XB_TMO])) break; if (_sp > XB_SPIN_CAP) { atomicAdd(&(bar)[XB_TMO], 1u); break; } } } } while (0)

struct XcdBarrier {
    unsigned* bar; unsigned x;
    volatile LAS unsigned* st;
};

__device__ __forceinline__ XcdBarrier xcd_barrier_post(unsigned* bar, volatile LAS unsigned* st) {
    XcdBarrier b; b.bar = bar; b.x = xb_xcc_id(); b.st = st;
    if (threadIdx.x == 0) (void)xb_add(&bar[XB_XCNT(b.x)], 1u);
    return b;
}
__device__ __forceinline__ void xcd_barrier_complete(unsigned* bar, unsigned x, unsigned& nloc, unsigned& nx) {
    const unsigned G = gridDim.x * gridDim.y * gridDim.z;
    unsigned sum, cnt, mine, sp = 0u;
    for (;;) {
        sum = 0u; cnt = 0u; mine = 0u;
#pragma unroll
        for (unsigned j = 0; j < 16; ++j) { const unsigned c = xb_ld(&bar[XB_XCNT(j)]); sum += c; cnt += (c > 0u) ? 1u : 0u; mine = (j == x) ? c : mine; }
        if (sum == G) break;
        __builtin_amdgcn_s_sleep(1);
        if ((++sp & 255u) == 0u) { if (xb_ld(&bar[XB_TMO])) break; if (sp > XB_SPIN_CAP) { atomicAdd(&bar[XB_TMO], 1u); break; } }
    }
    nloc = mine > 0u ? mine : 1u; nx = cnt > 0u ? cnt : 1u;
}

__device__ __forceinline__ void xcd_barrier(const XcdBarrier& b) {
    asm volatile("s_waitcnt vmcnt(0)" ::: "memory");
    __syncthreads();
    if (threadIdx.x == 0) {
        unsigned* bar = b.bar;
        __builtin_amdgcn_s_waitcnt(0);
        unsigned nloc = b.st[0], nx = b.st[1];
        if (nloc == 0u) { xcd_barrier_complete(bar, b.x, nloc, nx); b.st[0] = nloc; b.st[1] = nx; }
        const unsigned old = xb_add(&bar[XB_XSUB(b.x)], 1u);
        const unsigned gen = old / nloc;
        if (old + 1u == (gen + 1u) * nloc) {
            __builtin_amdgcn_fence(__ATOMIC_RELEASE, "agent");
            asm volatile("s_waitcnt vmcnt(0)" ::: "memory");
            const unsigned og = xb_add(&bar[XB_TOP], 1u);
            const unsigned tg = og / nx;
            if (og + 1u == (tg + 1u) * nx) xb_add(&bar[XB_TOPGEN], 1u);
            else XB_SPIN(xb_ld(&bar[XB_TOPGEN]) == tg, bar);
            __builtin_amdgcn_fence(__ATOMIC_ACQUIRE, "agent");
            xb_add(&bar[XB_XGEN(b.x)], 1u);
            asm volatile("s_waitcnt vmcnt(0)" ::: "memory");
        } else {
            XB_SPIN(xb_ld(&bar[XB_XGEN(b.x)]) == gen, bar);
            __builtin_amdgcn_fence(__ATOMIC_ACQUIRE, "agent");
            asm volatile("s_waitcnt vmcnt(0)" ::: "memory");
        }
    }
    __syncthreads();
}


struct Frame {
    LAS unsigned char* lds;
    gu32* ctl;
    int tid, lane, wave, vcu, G;
    const float* const* in;
    float* out;
    unsigned char* ws;
};
#define IN_X 0
#define IN_C 1
#define IN_CTX 2
#define IN_CCTX 3
#define IN_WADA 4
#define IN_BADA 5
#define IN_NMIX 6
#define IN_NFFN 7
#define IN_WIN 8
#define IN_WOUT 9
#define IN_HGLB 10
#define IN_HGNW 11
#define IN_RW 12
#define IN_RB 13
#define IN_W1 14
#define IN_B1 15
#define IN_W2 16
#define IN_B2 17
#define IN_NFIN 18

struct TItem { const float* src; bf16* dst; int ldw, kind, n0, k0; };
__device__ __forceinline__ int t_prow(int kind, int n) {
    if (kind == 1) { if (n < 512) { const int l = n & 255; return (n & ~255) + 128 * ((l >> 5) & 1) + 32 * (l >> 6) + (l & 31); } return n; }
    if (kind == 2) { const int half = n >> 10, r = n & 1023; return 256 * (r >> 7) + 128 * half + (r & 127); }
    return n;
}
__device__ __forceinline__ bool t_decode(const Frame& F, int it, TItem& T) {
    constexpr int I_IN = 16 * 64, I_OUT = 16 * 16, I_W1 = 32 * 16 * 32, I_W2 = 32 * 16 * 16, NITEMS = I_IN + I_OUT + I_W1 + I_W2;
    if (it >= I_IN + I_OUT) return false;
    int r = it;
    if (r < I_IN) { T.src = F.in[IN_WIN]; T.dst = (bf16*)(F.ws + WS_WIN); T.ldw = PW; T.kind = 1; T.k0 = (r >> 6) * 64; T.n0 = (r & 63) * 64; return true; }
    r -= I_IN;
    if (r < I_OUT) { T.src = F.in[IN_WOUT]; T.dst = (bf16*)(F.ws + WS_WOUT); T.ldw = D; T.kind = 0; T.k0 = (r >> 4) * 64; T.n0 = (r & 15) * 64; return true; }
    r -= I_OUT;
    if (r < I_W1) { const int e = r >> 9, q = r & 511; T.src = F.in[IN_W1] + (size_t)e * 1024 * 2048; T.dst = (bf16*)(F.ws + WS_W1) + (size_t)e * 2048 * 1024; T.ldw = 2048; T.kind = 2; T.k0 = (q >> 5) * 64; T.n0 = (q & 31) * 64; return true; }
    r -= I_W1;
    { const int e = r >> 8, q = r & 255; T.src = F.in[IN_W2] + (size_t)e * 1024 * 1024; T.dst = (bf16*)(F.ws + WS_W2) + (size_t)e * 1024 * 1024; T.ldw = 1024; T.kind = 0; T.k0 = (q >> 4) * 64; T.n0 = (q & 15) * 64; return true; }
}
__device__ __forceinline__ void t_load(const TItem& T, float (&v)[64], int lane) {
    const float* s = T.src + (size_t)T.k0 * T.ldw + T.n0 + lane;
#pragma unroll
    for (int i = 0; i < 64; ++i) v[i] = s[(size_t)i * T.ldw];
}
__device__ __forceinline__ void t_store(const TItem& T, const float (&v)[64], LAS float* scr, int lane) {
#pragma unroll
    for (int i = 0; i < 64; ++i) scr[i * 65 + lane] = v[i];
    LDS_WAIT(); asm volatile("" ::: "memory");
    const int c = lane & 7;
    if (T.kind >= 2) {
#pragma unroll
        for (int j = 0; j < 8; ++j) { const int n = (lane >> 3) + 8 * j; const LAS float* s = scr + (8 * c) * 65 + n;
            v2u o; o.x = pk4_f8(s[0 * 65] * W8_SCALE, s[1 * 65] * W8_SCALE, s[2 * 65] * W8_SCALE, s[3 * 65] * W8_SCALE); o.y = pk4_f8(s[4 * 65] * W8_SCALE, s[5 * 65] * W8_SCALE, s[6 * 65] * W8_SCALE, s[7 * 65] * W8_SCALE);
            *(GAS v2u*)((unsigned char*)T.dst + (size_t)t_prow(T.kind, T.n0 + n) * 1024 + T.k0 + 8 * c) = o; }
    } else {
#pragma unroll
    for (int j = 0; j < 8; ++j) { const int n = (lane >> 3) + 8 * j; const LAS float* s = scr + (8 * c) * 65 + n;
        v4u o; o.x = pk2(s[0 * 65], s[1 * 65]); o.y = pk2(s[2 * 65], s[3 * 65]); o.z = pk2(s[4 * 65], s[5 * 65]); o.w = pk2(s[6 * 65], s[7 * 65]);
        *(GAS v4u*)(T.dst + (size_t)t_prow(T.kind, T.n0 + n) * 1024 + T.k0 + 8 * c) = o; }
    }
    LDS_WAIT(); asm volatile("" ::: "memory");
}
__device__ __forceinline__ void p0_prologue(Frame& F) {
    const int gw = F.vcu * NWAVES + F.wave, NGW = F.G * NWAVES;
    float* MOD = (float*)(F.ws + WS_MOD);
    for (int cg = F.vcu; cg < 96; cg += F.G) {
        LAS float* sl = (LAS float*)(F.lds + SCR_OFF);
        LAS float* red = sl + 9 * 1024;
        for (int i = F.tid; i < 9 * 1024; i += NWAVES * 64) { const int b = i >> 10, k = i & 1023; const float cv = b < 8 ? F.in[IN_C][b * 1024 + k] : F.in[IN_CCTX][k]; sl[i] = siluf_(cv); }
        __syncthreads();
        const int j = 64 * cg + F.lane; const int kb = 128 * F.wave;
        const float* wa = F.in[IN_WADA] + (size_t)kb * 6144 + j;
        float acc[9];
#pragma unroll
        for (int b = 0; b < 9; ++b) acc[b] = 0.f;
#pragma unroll 1
        for (int k = 0; k < 128; k += 32) {
            float w[32];
#pragma unroll
            for (int i = 0; i < 32; ++i) w[i] = wa[(size_t)(k + i) * 6144];
#pragma unroll
            for (int b = 0; b < 9; ++b)
#pragma unroll
                for (int i = 0; i < 32; i += 4) { const f32x4 s0 = *(const LAS f32x4*)(sl + b * 1024 + kb + k + i); acc[b] += s0[0] * w[i] + s0[1] * w[i + 1] + s0[2] * w[i + 2] + s0[3] * w[i + 3]; }
        }
#pragma unroll
        for (int b = 0; b < 9; ++b) red[(F.wave * 9 + b) * 64 + F.lane] = acc[b];
        __syncthreads();
        for (int i = F.tid; i < 9 * 64; i += NWAVES * 64) { const int b = i >> 6, l = i & 63; float s = F.in[IN_BADA][64 * cg + l];
#pragma unroll
            for (int w8 = 0; w8 < 8; ++w8) s += red[(w8 * 9 + b) * 64 + l];
            MOD[b * 6144 + 64 * cg + l] = s; }
        VM_WAIT(); __syncthreads();
        if (F.tid == 0) { __builtin_amdgcn_fence(__ATOMIC_RELEASE, "agent"); VM_WAIT(); __hip_atomic_fetch_add((unsigned*)(F.ctl + CW_ADA), 1u, RLX_AGENT); }
        __syncthreads();
    }
    {
        float* LB = (float*)(F.ws + WS_LB); float* COS = (float*)(F.ws + WS_COS); float* SIN = (float*)(F.ws + WS_SIN);
        const int gt = F.vcu * (NWAVES * 64) + F.tid, NGT = F.G * NWAVES * 64;
        for (int i = gt; i < 1024; i += NGT) { const float a0 = F.in[IN_HGLB][i], a1 = F.in[IN_HGLB][1024 + i]; LB[i] = 1.f / (1.f + expf(a1 - a0)); }
        for (int i = gt; i < 2048 * 32; i += NGT) { const int n = i >> 5, j = i & 31, fi = j & 15; const float pos = (float)(j < 16 ? (n >> 6) : (n & 63));
            const float inv = powf(10000.f, -(float)fi / 16.f); const float ang = pos * inv; COS[i] = cosf(ang); SIN[i] = sinf(ang); }
    }
    LAS float* scr = (LAS float*)(F.lds + SCR_OFF + F.wave * 16640);
    int it = NGW - 1 - gw; TItem cur, nxt; float va[64], vb[64];
    bool has = t_decode(F, it, cur);
    if (has) t_load(cur, va, F.lane);
    while (has) {
        it += NGW; const bool hn = t_decode(F, it, nxt);
        if (hn) t_load(nxt, vb, F.lane);
        t_store(cur, va, scr, F.lane);
        has = hn; if (!has) break;
        cur = nxt;
        it += NGW; const bool hn2 = t_decode(F, it, nxt);
        if (hn2) t_load(nxt, va, F.lane);
        t_store(cur, vb, scr, F.lane);
        has = hn2; cur = nxt;
    }
}

constexpr int TP_P2_EXPERTS = 9;
constexpr int TP_P2_ITEMS = TP_P2_EXPERTS * 512;
__device__ __forceinline__ bool tt_decode(const Frame& F, int t, int t1, TItem& T) {
    if (t >= t1) return false;
    if (t < 16384) { const int u = t >> 1; const int nb = u & 31, kb = 2 * ((u >> 5) & 7) + (t & 1), e = u >> 8; T.src = F.in[IN_W1] + (size_t)e * 1024 * 2048; T.dst = (bf16*)((unsigned char*)(F.ws + WS_W1) + (size_t)e * 2048 * 1024); T.ldw = 2048; T.kind = 2; T.k0 = kb * 64; T.n0 = nb * 64; }
    else { const int q = t - 16384, u = q >> 1; const int nb = u & 15, kb = 2 * ((u >> 4) & 7) + (q & 1), e = u >> 7; T.src = F.in[IN_W2] + (size_t)e * 1024 * 1024; T.dst = (bf16*)((unsigned char*)(F.ws + WS_W2) + (size_t)e * 1024 * 1024); T.ldw = 1024; T.kind = 3; T.k0 = kb * 64; T.n0 = nb * 64; }
    return true;
}
__device__ __forceinline__ void tail_transpose(Frame& F, int t0, int t1, int wv, int nwv) {
    LAS float* scr = (LAS float*)(F.lds + SCR_OFF + F.wave * 16640);
    int it = t0 + wv; TItem cur, nxt; float va[64], vb[64];
    bool has = tt_decode(F, it, t1, cur);
    if (has) t_load(cur, va, F.lane);
    while (has) {
        it += nwv; const bool hn = tt_decode(F, it, t1, nxt);
        if (hn) t_load(nxt, vb, F.lane);
        t_store(cur, va, scr, F.lane);
        has = hn; if (!has) break;
        cur = nxt;
        it += nwv; const bool hn2 = tt_decode(F, it, t1, nxt);
        if (hn2) t_load(nxt, va, F.lane);
        t_store(cur, vb, scr, F.lane);
        has = hn2; cur = nxt;
    }
}

__device__ __forceinline__ void p1_xn(Frame& F) {
    const int gw = F.vcu * NWAVES + F.wave, NGW = F.G * NWAVES;
    const float* MOD = (const float*)(F.ws + WS_MOD); bf16* XN = (bf16*)(F.ws + WS_XN);
    for (int m = gw; m < NROWS; m += NGW) {
        const float* src = m < NX ? F.in[IN_X] + (size_t)m * D : F.in[IN_CTX] + (size_t)(m - NX) * D; const int b = m < NX ? (m >> 11) : 8;
        const GAS f32x4* xr = (const GAS f32x4*)src + F.lane; f32x4 v[4]; float s = 0.f;
#pragma unroll
        for (int j = 0; j < 4; ++j) { v[j] = xr[64 * j]; s += (v[j].x * v[j].x + v[j].y * v[j].y) + (v[j].z * v[j].z + v[j].w * v[j].w); }
        const float rinv = 1.f / sqrtf(wave_sum(s) * (1.f / D) + EPS);
        GAS v2u* o8 = (GAS v2u*)(XN + (size_t)m * D) + F.lane;
#pragma unroll
        for (int j = 0; j < 4; ++j) { const int k = 4 * F.lane + 256 * j;
            const f32x4 nw = *(const f32x4*)(F.in[IN_NMIX] + k), sh = *(const f32x4*)(MOD + b * 6144 + k), sc = *(const f32x4*)(MOD + b * 6144 + 1024 + k);
            const f32x4 u = v[j] * rinv * nw * (sc + 1.f) + sh; v2u w; w.x = pk2(u.x, u.y); w.y = pk2(u.z, u.w); o8[64 * j] = w; }
    }
}

struct InProjOrder {
    int G, c;
    __device__ __forceinline__ bool next(int i, pg8::Unit& u) const {
        const int L = i * G + c;
        if (L < 1024) { pg8::StaticOrder S; S.init(NX, PW, 1 << 30, L); return S.next(0, u); }
        if (L < 1024 + 72) { const int j = L - 1024, ti = j >> 3; u.pm = 64 + (j & 7); u.pn = ti < 3 ? 1 + ti : 5 + ti; return true; }
        return false;
    }
    __device__ __forceinline__ void a_ready(const pg8::Unit&) const {}
    __device__ __forceinline__ void done(const pg8::Unit&) const {}
};
struct EpiInProj {
    static constexpr bool PERM = true, AFTER_DRAIN = false;
    bf16* P; const float* LB; const float* COS; const float* SIN;
    __device__ __forceinline__ void operator()(const f32x4 (&acc)[2][2][4][2], const pg8::Unit& u, int wr, int wc, int fr, int fq) const {
        const int t = u.pn; const int row0 = u.pm * 256 + wr * 64 + fr; const int cb = wc * 32 + 8 * fq;
        if (t < 2) {
            const bool isx = u.pm < 64; const float sc = t == 1 ? 0.125f : 1.f;
#pragma unroll
            for (int ai = 0; ai < 2; ++ai)
#pragma unroll
                for (int m = 0; m < 4; ++m) { const int r = row0 + ai * 128 + m * 16; f32x4 c0, c1, s0, s1;
                    if (isx) { const int pos = r & 2047; c0 = *(const f32x4*)(COS + pos * 32 + 8 * fq); c1 = *(const f32x4*)(COS + pos * 32 + 8 * fq + 4); s0 = *(const f32x4*)(SIN + pos * 32 + 8 * fq); s1 = *(const f32x4*)(SIN + pos * 32 + 8 * fq + 4); }
                    else { c0 = (f32x4){1.f, 1.f, 1.f, 1.f}; c1 = c0; s0 = (f32x4){0.f, 0.f, 0.f, 0.f}; s1 = s0; }
                    const f32x4 a0 = acc[ai][0][m][0] * sc, a1 = acc[ai][0][m][1] * sc, b0 = acc[ai][1][m][0] * sc, b1 = acc[ai][1][m][1] * sc;
                    const f32x4 o10 = a0 * c0 - b0 * s0, o11 = a1 * c1 - b1 * s1, o20 = a0 * s0 + b0 * c0, o21 = a1 * s1 + b1 * c1;
                    bf16* rp = P + (size_t)r * PW + 256 * t + 64 * wc + 8 * fq;
                    v4u w; w.x = pk2(o10[0], o10[1]); w.y = pk2(o10[2], o10[3]); w.z = pk2(o11[0], o11[1]); w.w = pk2(o11[2], o11[3]); *(v4u*)rp = w;
                    w.x = pk2(o20[0], o20[1]); w.y = pk2(o20[2], o20[3]); w.z = pk2(o21[0], o21[1]); w.w = pk2(o21[2], o21[3]); *(v4u*)(rp + 32) = w; }
            return;
        }
        const int mode = (t == 2 || t == 3 || t == 12 || t == 13) ? 0 : ((t >= 8 && t < 12) ? 2 : 1);
        f32x4 lb[2][2];
        if (mode == 2) {
#pragma unroll
            for (int bj = 0; bj < 2; ++bj)
#pragma unroll
                for (int n = 0; n < 2; ++n) lb[bj][n] = *(const f32x4*)(LB + ((t - 8) >> 1) * 512 + ((t & 1) << 8) + 128 * bj + cb + 4 * n);
        }
#pragma unroll
        for (int ai = 0; ai < 2; ++ai)
#pragma unroll
            for (int m = 0; m < 4; ++m) { const int r = row0 + ai * 128 + m * 16; bf16* rp = P + (size_t)r * PW + 256 * t + cb;
#pragma unroll
                for (int bj = 0; bj < 2; ++bj) { f32x4 v0 = acc[ai][bj][m][0], v1 = acc[ai][bj][m][1];
                    if (mode == 1) {
#pragma unroll
                        for (int i = 0; i < 4; ++i) { v0[i] = siluf_(v0[i]); v1[i] = siluf_(v1[i]); } }
                    else if (mode == 2) {
#pragma unroll
                        for (int i = 0; i < 4; ++i) { const float l0 = lb[bj][0][i], l1 = lb[bj][1][i]; v0[i] = __logf(l0 + (1.f - l0) * sigmoidf_(v0[i])); v1[i] = __logf(l1 + (1.f - l1) * sigmoidf_(v1[i])); } }
                    v4u w; w.x = pk2(v0[0], v0[1]); w.y = pk2(v0[2], v0[3]); w.z = pk2(v1[0], v1[1]); w.w = pk2(v1[2], v1[3]); *(v4u*)(rp + 128 * bj) = w; } }
    }
};

__device__ __forceinline__ bf16x8 ldfrag(const LAS unsigned char* base, int stride, int row0, int kb, int lane) {
    return *(const LAS bf16x8*)(base + (row0 + (lane & 15)) * stride + kb + 16 * (lane >> 4));
}
#define MFMA16(a, b, c) __builtin_amdgcn_mfma_f32_16x16x32_bf16((a), (b), (c), 0, 0, 0)
constexpr int TP_W1_PAIRS = (32 - TP_P2_EXPERTS) * 128, TP_ALL_PAIRS = TP_W1_PAIRS + 32 * 64;
struct TPState { const float* src; unsigned char* dst; int ldw; };
__device__ __forceinline__ void tp_decode(const Frame& F, int u, int kbit, TPState& S, int lane) {
    if (u < TP_W1_PAIRS) {
    const int nb = u & 15, kb = 2 * ((u >> 4) & 7) + kbit, e = TP_P2_EXPERTS + (u >> 7); const int n = 128 * nb + 2 * lane; const int half = n >> 10, r = n & 1023; const int prow = 256 * (r >> 7) + 128 * half + (r & 127);
    S.src = F.in[IN_W1] + (size_t)e * 1024 * 2048 + (size_t)(64 * kb) * 2048 + n; S.dst = (unsigned char*)(F.ws + WS_W1) + (size_t)e * 2048 * 1024 + (size_t)prow * 1024 + 64 * kb; S.ldw = 2048;
    } else {
    const int u2 = u - TP_W1_PAIRS; const int nb = u2 & 7, kb = 2 * ((u2 >> 3) & 7) + kbit, e = u2 >> 6; const int n = 128 * nb + 2 * lane;
    S.src = F.in[IN_W2] + (size_t)e * 1024 * 1024 + (size_t)(64 * kb) * 1024 + n; S.dst = (unsigned char*)(F.ws + WS_W2) + (size_t)e * 1024 * 1024 + (size_t)n * 1024 + 64 * kb; S.ldw = 1024; }
}
__device__ __forceinline__ void tp_load(const TPState& S, f32x2 (&v)[64]) {
#pragma unroll
    for (int i = 0; i < 64; ++i) v[i] = *(const f32x2*)(S.src + (size_t)i * S.ldw);
}
__device__ __forceinline__ void tp_store(unsigned char* d, const f32x2 (&v)[64]) {
#pragma unroll
    for (int c = 0; c < 4; ++c) {
        *(GAS v4u*)(d + 16 * c) = (v4u){pk4_f8(v[16 * c].x * W8_SCALE, v[16 * c + 1].x * W8_SCALE, v[16 * c + 2].x * W8_SCALE, v[16 * c + 3].x * W8_SCALE), pk4_f8(v[16 * c + 4].x * W8_SCALE, v[16 * c + 5].x * W8_SCALE, v[16 * c + 6].x * W8_SCALE, v[16 * c + 7].x * W8_SCALE),
                                         pk4_f8(v[16 * c + 8].x * W8_SCALE, v[16 * c + 9].x * W8_SCALE, v[16 * c + 10].x * W8_SCALE, v[16 * c + 11].x * W8_SCALE), pk4_f8(v[16 * c + 12].x * W8_SCALE, v[16 * c + 13].x * W8_SCALE, v[16 * c + 14].x * W8_SCALE, v[16 * c + 15].x * W8_SCALE)};
        *(GAS v4u*)(d + 1024 + 16 * c) = (v4u){pk4_f8(v[16 * c].y * W8_SCALE, v[16 * c + 1].y * W8_SCALE, v[16 * c + 2].y * W8_SCALE, v[16 * c + 3].y * W8_SCALE), pk4_f8(v[16 * c + 4].y * W8_SCALE, v[16 * c + 5].y * W8_SCALE, v[16 * c + 6].y * W8_SCALE, v[16 * c + 7].y * W8_SCALE),
                                                pk4_f8(v[16 * c + 8].y * W8_SCALE, v[16 * c + 9].y * W8_SCALE, v[16 * c + 10].y * W8_SCALE, v[16 * c + 11].y * W8_SCALE), pk4_f8(v[16 * c + 12].y * W8_SCALE, v[16 * c + 13].y * W8_SCALE, v[16 * c + 14].y * W8_SCALE, v[16 * c + 15].y * W8_SCALE)}; }
}
#define TP_SLOT(v, d) do { if (d) tp_store(d, v); d = nullptr; if (tp_left > 0 && tp_u < TP_ALL_PAIRS) { tp_decode(F, tp_u, tp_kbit, tps, lane); tp_load(tps, v); d = tps.dst; } \
        if (tp_left > 0) { --tp_left; if (tp_kbit) tp_u += 512; tp_kbit ^= 1; } } while (0)

template <bool HG>
__device__ __forceinline__ void scan_chain4(Frame& F, int b, int h, int dir, int dvh) {
    constexpr int DK = HG ? 128 : 64;
    constexpr int QS = DK * 2 + 16, SS = 64 * 2 + 16;
    constexpr int KROWS = HG ? 160 : 64;
    constexpr int O_QI = 0, O_QT = O_QI + 64 * QS, O_KIJ = O_QT + 64 * QS, O_KTT = O_KIJ + KROWS * QS, O_VT = O_KTT + DK * SS, O_PM = O_VT + 64 * SS, O_ST = O_PM + 64 * SS, O_T = O_ST + 64 * QS, O_GD = O_T + 2048, O_END = O_GD + 512;
    static_assert(SCR_OFF + O_END <= LDS_BYTES, "scan LDS");
    LAS unsigned char* L = F.lds + SCR_OFF;
    LAS unsigned char* Qi = L + O_QI; LAS unsigned char* Qt = L + O_QT; LAS unsigned char* Kij = L + O_KIJ; LAS unsigned char* Ktt = L + O_KTT;
    LAS unsigned char* Vt = L + O_VT; LAS unsigned char* Pm = L + O_PM; LAS unsigned char* St = L + O_ST;
    LAS float* T = (LAS float*)(L + O_T); LAS float* GD = (LAS float*)(L + O_GD);
    int tid = F.tid; asm volatile("" : "+v"(tid));
    const int lane = tid & 63, w = F.wave;
    const bool scanner = w < 4;
    const bf16* P = (const bf16*)(F.ws + WS_P);
    bf16* O = (bf16*)(F.ws + (dir ? WS_OB : WS_OF));
    const int qcol = HG ? 1536 + 128 * h : 64 * h;
    const int kcol = HG ? 2048 + 512 * dir + 128 * h : 256 + 64 * h;
    const int vcol = (HG ? 3072 : 512) + 128 * h + 64 * dvh;
    const int ocol = (HG ? 512 : 0) + 128 * h + 64 * dvh;
    const float lg = HG ? 0.f : log1pf(-exp2f(-(float)(dir ? 6 : 5) - 2.f * (float)h));
    if (!scanner) {
        const int rb = ((F.vcu >> 2) << 1) | (F.vcu & 1);
        TPState tps; tps.src = nullptr; tps.dst = nullptr; tps.ldw = 0; int tp_u = rb * 4 + (w - 4); int tp_kbit = 0; int tp_left = (F.G == 256) ? 20 : 0;
        f32x2 tva[64]; unsigned char* tda = nullptr;
        LBAR();
#pragma unroll 1
        for (int s = 0; s < 36; ++s) {
            const bool on = (5 * s) % 9 < 5;
            bool ld = false;
            if (on) { if (tda) tp_store(tda, tva); tda = nullptr; ld = tp_left > 0 && tp_u < TP_ALL_PAIRS; if (ld) { tp_decode(F, tp_u, tp_kbit, tps, lane); tda = tps.dst; }
                      if (tp_left > 0) { --tp_left; if (tp_kbit) tp_u += 512; tp_kbit ^= 1; } }
#define TP_LD16(q0) do { if (ld) { _Pragma("unroll") for (int i = 16 * (q0); i < 16 * (q0) + 16; ++i) tva[i] = *(const f32x2*)(tps.src + (size_t)i * tps.ldw); } } while (0)
            TP_LD16(0); LBAR(); TP_LD16(1); LBAR(); TP_LD16(2); LBAR(); TP_LD16(3); LBAR();
#undef TP_LD16
        }
        while (tp_left > 0 || tda) { TP_SLOT(tva, tda); }
        return;
    }
    for (int i = tid; i < (64 * SS) / 4; i += 256) ((LAS unsigned*)Pm)[i] = 0u;
    for (int i = tid; i < (64 * QS) / 4; i += 256) ((LAS unsigned*)St)[i] = 0u;
    constexpr int NDB = HG ? 2 : 1;
    f32x4 accS[NDB][4];
#pragma unroll
    for (int i = 0; i < NDB; ++i)
#pragma unroll
        for (int j = 0; j < 4; ++j) accS[i][j] = (f32x4){0.f, 0.f, 0.f, 0.f};
    constexpr int TPT = HG ? 16 : 8;
    const int cp = HG ? lane : (tid & 31);
    const int tg = HG ? w : ((tid >> 5) & 7);
    const int vp2 = (tid >> 3) & 31, vs = tid & 7;
    unsigned qreg[TPT], kreg[TPT]; v4u vreg0, vreg1;
#define SCAN_ROW0(s) ((s) < 4 ? (NX + b * CTX + (dir ? 255 - 64 * (s) : 64 * (s))) : (b * SEQ + (dir ? 2047 - 64 * ((s) - 4) : 64 * ((s) - 4))))
#define SCAN_LOAD(s) do { const int r0_ = SCAN_ROW0(s); const int sg_ = dir ? -1 : 1; \
        _Pragma("unroll") for (int j = 0; j < TPT; ++j) { const bf16* rp_ = P + (size_t)(r0_ + sg_ * (TPT * tg + j)) * PW; \
            kreg[j] = *(const unsigned*)(rp_ + kcol + 2 * cp); qreg[j] = ((s) >= 4) ? *(const unsigned*)(rp_ + qcol + 2 * cp) : 0u; } \
        vreg0 = *(const v4u*)(P + (size_t)(r0_ + sg_ * (2 * vp2)) * PW + vcol + 8 * vs); vreg1 = *(const v4u*)(P + (size_t)(r0_ + sg_ * (2 * vp2 + 1)) * PW + vcol + 8 * vs); } while (0)
    SCAN_LOAD(0);
    LBAR();
#pragma unroll 1
    for (int s = 0; s < 36; ++s) {
        const bool isx = s >= 4;
        const int r0 = SCAN_ROW0(s); const int sg = dir ? -1 : 1;
        {
            if (s > 0) {
#pragma unroll
                for (int di = 0; di < NDB; ++di) { const int db = HG ? 2 * w + di : w;
#pragma unroll
                    for (int vi = 0; vi < 4; ++vi)
                        *(LAS v2u*)(St + (16 * vi + (lane & 15)) * QS + 2 * (16 * db + 4 * (lane >> 4))) = (v2u){pk2(accS[di][vi][0], accS[di][vi][1]), pk2(accS[di][vi][2], accS[di][vi][3])}; } }
            const unsigned va[4] = {vreg0.x, vreg0.y, vreg0.z, vreg0.w}, vb[4] = {vreg1.x, vreg1.y, vreg1.z, vreg1.w};
#pragma unroll
            for (int e = 0; e < 4; ++e) { *(LAS unsigned*)(Vt + (8 * vs + 2 * e) * SS + 4 * vp2) = (va[e] & 0xffffu) | (vb[e] << 16); *(LAS unsigned*)(Vt + (8 * vs + 2 * e + 1) * SS + 4 * vp2) = (va[e] >> 16) | (vb[e] & 0xffff0000u); }
            if constexpr (HG) { float run0 = 0.f, run1 = 0.f;
#pragma unroll
                for (int j = 0; j < 16; ++j) { run0 += bflo(kreg[j]); run1 += bfhi(kreg[j]); }
                *(LAS f32x2*)(T + w * 128 + 2 * cp) = (f32x2){run0, run1}; }
        }
        LBAR();
        {
            if constexpr (HG) {
                float pre0 = 0.f, pre1 = 0.f, bm0 = 0.f, bm1 = 0.f; float bs0[4], bs1[4];
#pragma unroll
                for (int o = 0; o < 4; ++o) { const f32x2 tt = *(const LAS f32x2*)(T + o * 128 + 2 * cp); bs0[o] = pre0; bs1[o] = pre1; if (o == w) { bm0 = pre0; bm1 = pre1; } pre0 += tt.x; pre1 += tt.y; }
                const float bend0 = pre0, bend1 = pre1;
                const float eBi0 = __expf(bm0), eBi1 = __expf(bm1), eEnd0 = __expf(bend0 - bm0), eEnd1 = __expf(bend1 - bm1);
                float gI0[4], gI1[4];
#pragma unroll
                for (int ii = 0; ii < 4; ++ii) { gI0[ii] = __expf(fminf(bs0[ii] - bm0, 0.f)); gI1[ii] = __expf(fminf(bs1[ii] - bm1, 0.f)); }
                if (w == 0) *(LAS f32x2*)(GD + 2 * cp) = (f32x2){__expf(bend0), __expf(bend1)};
                unsigned kt0[2], kt1[2]; float run0 = 0.f, run1 = 0.f;
#pragma unroll
                for (int j = 0; j < 16; ++j) {
                    const int p = 16 * w + j;
                    run0 += bflo(kreg[j]); run1 += bfhi(kreg[j]);
                    const float d0 = run0, d1 = run1;
                    const float E0 = __expf(d0), E1 = __expf(d1), R0 = __expf(-d0), R1 = __expf(-d1);
                    const float k0 = 1.f - __expf(bflo(kreg[j])), k1 = 1.f - __expf(bfhi(kreg[j]));
                    const float kr0 = k0 * R0, kr1 = k1 * R1;
                    const unsigned ktp = pk2(kr0 * eEnd0, kr1 * eEnd1);
                    if ((j & 1) == 0) { kt0[(j >> 1) & 1] = ktp & 0xffffu; kt1[(j >> 1) & 1] = ktp >> 16; } else { kt0[(j >> 1) & 1] |= ktp << 16; kt1[(j >> 1) & 1] |= ktp & 0xffff0000u; }
                    if ((j & 3) == 3) { *(LAS v2u*)(Ktt + (2 * cp) * SS + 32 * w + 2 * (j - 3)) = (v2u){kt0[0], kt0[1]}; *(LAS v2u*)(Ktt + (2 * cp + 1) * SS + 32 * w + 2 * (j - 3)) = (v2u){kt1[0], kt1[1]}; }
                    if ((j & 1) == 1) asm volatile("" ::: "memory");
                    if (isx) {
                        const float qi0 = bflo(qreg[j]) * E0, qi1 = bfhi(qreg[j]) * E1;
                        *(LAS unsigned*)(Qi + p * QS + 4 * cp) = pk2(qi0, qi1);
                        *(LAS unsigned*)(Qt + p * QS + 4 * cp) = pk2(qi0 * eBi0, qi1 * eBi1);
#pragma unroll
                        for (int ii = 0; ii < 4; ++ii) if (ii >= w) { const int blk = ii * (ii + 1) / 2 + w;
                            *(LAS unsigned*)(Kij + (blk * 16 + j) * QS + 4 * cp) = pk2(kr0 * gI0[ii], kr1 * gI1[ii]); }
                    }
                }
            } else {
                unsigned kt0[4], kt1[4];
#pragma unroll
                for (int j = 0; j < 8; ++j) {
                    const int p = 8 * tg + j;
                    const float kd = __expf(lg * (float)(63 - p));
                    const unsigned ktp = pk2(bflo(kreg[j]) * kd, bfhi(kreg[j]) * kd);
                    if ((j & 1) == 0) { kt0[j >> 1] = ktp & 0xffffu; kt1[j >> 1] = ktp >> 16; } else { kt0[j >> 1] |= ktp << 16; kt1[j >> 1] |= ktp & 0xffff0000u; }
                    if (isx) {
                        const float qd = __expf(lg * (float)(p + 1));
                        *(LAS unsigned*)(Qi + p * QS + 4 * cp) = qreg[j];
                        *(LAS unsigned*)(Qt + p * QS + 4 * cp) = pk2(bflo(qreg[j]) * qd, bfhi(qreg[j]) * qd);
                        *(LAS unsigned*)(Kij + p * QS + 4 * cp) = kreg[j];
                    }
                }
                *(LAS v4u*)(Ktt + (2 * cp) * SS + 16 * tg) = (v4u){kt0[0], kt0[1], kt0[2], kt0[3]};
                *(LAS v4u*)(Ktt + (2 * cp + 1) * SS + 16 * tg) = (v4u){kt1[0], kt1[1], kt1[2], kt1[3]};
            }
            if (s + 1 < 36) SCAN_LOAD(s + 1);
        }
        LBAR();
        {
            if (isx) {
#pragma unroll
                for (int rep = 0; rep < 3; ++rep) { const int bi = w + 4 * rep; if (bi < 10) {
                    const int i = bi >= 6 ? 3 : (bi >= 3 ? 2 : (bi >= 1 ? 1 : 0)), j = bi - i * (i + 1) / 2;
                    f32x4 sc = (f32x4){0.f, 0.f, 0.f, 0.f};
#pragma unroll
                    for (int ks = 0; ks < DK / 32; ++ks) { const bf16x8 a = ldfrag(Kij, QS, HG ? 16 * bi : 16 * j, 64 * ks, lane), bq = ldfrag(Qi, QS, 16 * i, 64 * ks, lane); sc = MFMA16(a, bq, sc); }
#pragma unroll
                    for (int r = 0; r < 4; ++r) { const int dt = (16 * i + (lane & 15)) - (16 * j + 4 * (lane >> 4) + r);
                        if constexpr (HG) { if (dt < 0) sc[r] = 0.f; } else { sc[r] = dt >= 0 ? sc[r] * __expf(lg * (float)dt) : 0.f; } }
                    *(LAS v2u*)(Pm + (16 * i + (lane & 15)) * SS + 2 * (16 * j + 4 * (lane >> 4))) = (v2u){pk2(sc[0], sc[1]), pk2(sc[2], sc[3])}; }
                    asm volatile("" ::: "memory"); }
            }
#pragma unroll
            for (int di = 0; di < NDB; ++di) { const int db = HG ? 2 * w + di : w;
                f32x4 gv;
                if constexpr (HG) gv = *(const LAS f32x4*)(GD + 16 * db + 4 * (lane >> 4)); else { const float g64 = __expf(lg * 64.f); gv = (f32x4){g64, g64, g64, g64}; }
#pragma unroll
                for (int vi = 0; vi < 4; ++vi) { accS[di][vi] = accS[di][vi] * gv;
#pragma unroll
                    for (int ks = 0; ks < 2; ++ks) { const bf16x8 a = ldfrag(Ktt, SS, 16 * db, 64 * ks, lane), bv = ldfrag(Vt, SS, 16 * vi, 64 * ks, lane); accS[di][vi] = MFMA16(a, bv, accS[di][vi]); }
                    if (vi & 1) asm volatile("" ::: "memory"); } }
        }
        LBAR();
        {
            if (isx) {
#pragma unroll
                for (int vi = 0; vi < 4; ++vi) { f32x4 oT = (f32x4){0.f, 0.f, 0.f, 0.f};
#pragma unroll
                    for (int ks = 0; ks < DK / 32; ++ks) { const bf16x8 a = ldfrag(St, QS, 16 * vi, 64 * ks, lane), bq = ldfrag(Qt, QS, 16 * w, 64 * ks, lane); oT = MFMA16(a, bq, oT); }
#pragma unroll
                    for (int ks = 0; ks < 2; ++ks) { const bf16x8 a = ldfrag(Vt, SS, 16 * vi, 64 * ks, lane), bp = ldfrag(Pm, SS, 16 * w, 64 * ks, lane); oT = MFMA16(a, bp, oT); }
                    const int t = 16 * w + (lane & 15);
                    *(v2u*)(O + (size_t)(r0 + sg * t) * D + ocol + 16 * vi + 4 * (lane >> 4)) = (v2u){pk2(oT[0], oT[1]), pk2(oT[2], oT[3])};
                    if (vi & 1) asm volatile("" ::: "memory");
                }
            }
        }
        LBAR();
    }
#undef SCAN_LOAD
#undef SCAN_ROW0
}
template <bool HG>
__device__ __forceinline__ void scan_chain8(Frame& F, int b, int h, int dir, int dvh) {
    constexpr int DK = HG ? 128 : 64;
    constexpr int QS = DK * 2 + 16, SS = 64 * 2 + 16;
    constexpr int KROWS = HG ? 160 : 64;
    constexpr int O_QI = 0, O_QT = O_QI + 64 * QS, O_KIJ = O_QT + 64 * QS, O_KTT = O_KIJ + KROWS * QS, O_VT = O_KTT + DK * SS, O_PM = O_VT + 64 * SS, O_ST = O_PM + 64 * SS, O_T = O_ST + 64 * QS, O_GD = O_T + 8192, O_VT1 = O_GD + 512, O_PM1 = O_VT1 + 64 * SS, O_END = O_PM1 + 64 * SS;
    static_assert(SCR_OFF + O_END <= LDS_BYTES, "scan LDS");
    LAS unsigned char* L = F.lds + SCR_OFF;
    LAS unsigned char* Qi = L + O_QI; LAS unsigned char* Qt = L + O_QT; LAS unsigned char* Kij = L + O_KIJ; LAS unsigned char* Ktt = L + O_KTT;
    LAS unsigned char* Vt0 = L + O_VT; LAS unsigned char* Pm0 = L + O_PM; LAS unsigned char* Vt1 = L + O_VT1; LAS unsigned char* Pm1 = L + O_PM1; LAS unsigned char* St = L + O_ST;
    LAS float* T = (LAS float*)(L + O_T); LAS float* GD = (LAS float*)(L + O_GD);
    int tid = F.tid; asm volatile("" : "+v"(tid));
    const int lane = tid & 63, w = F.wave;
    const bf16* P = (const bf16*)(F.ws + WS_P);
    bf16* O = (bf16*)(F.ws + (dir ? WS_OB : WS_OF));
    const int qcol = HG ? 1536 + 128 * h : 64 * h;
    const int kcol = HG ? 2048 + 512 * dir + 128 * h : 256 + 64 * h;
    const int vcol = (HG ? 3072 : 512) + 128 * h + 64 * dvh;
    const int ocol = (HG ? 512 : 0) + 128 * h + 64 * dvh;
    const float lg = HG ? 0.f : log1pf(-exp2f(-(float)(dir ? 6 : 5) - 2.f * (float)h));
    for (int i = tid; i < (64 * SS) / 4; i += NWAVES * 64) { ((LAS unsigned*)Pm0)[i] = 0u; ((LAS unsigned*)Pm1)[i] = 0u; }
    for (int i = tid; i < (64 * QS) / 4; i += NWAVES * 64) ((LAS unsigned*)St)[i] = 0u;
    constexpr int NVB = HG ? 4 : 2;
    f32x4 accS[NVB];
#pragma unroll
    for (int i = 0; i < NVB; ++i) accS[i] = (f32x4){0.f, 0.f, 0.f, 0.f};
    const int db = HG ? w : (w & 3);
    const int tb = w & 3, vb0 = 2 * (w >> 2);
    constexpr int TPT = HG ? 8 : 4;
    const int cp = HG ? lane : (tid & 31);
    const int tg = HG ? w : (tid >> 5);
    const int vp = tid >> 3, vs = tid & 7;
    unsigned qreg[TPT], kreg[TPT]; v4u vreg;
    unsigned knx[TPT];
#define SCAN_ROW0(s) ((s) < 4 ? (NX + b * CTX + (dir ? 255 - 64 * (s) : 64 * (s))) : (b * SEQ + (dir ? 2047 - 64 * ((s) - 4) : 64 * ((s) - 4))))
#define SCAN_LOAD_K(s, KR) do { const int r0_ = SCAN_ROW0(s); const int sg_ = dir ? -1 : 1; \
        _Pragma("unroll") for (int j = 0; j < TPT; ++j) KR[j] = *(const unsigned*)(P + (size_t)(r0_ + sg_ * (TPT * tg + j)) * PW + kcol + 2 * cp); } while (0)
#define SCAN_LOAD_QV(s) do { const int r0_ = SCAN_ROW0(s); const int sg_ = dir ? -1 : 1; \
        _Pragma("unroll") for (int j = 0; j < TPT; ++j) qreg[j] = ((s) >= 4) ? *(const unsigned*)(P + (size_t)(r0_ + sg_ * (TPT * tg + j)) * PW + qcol + 2 * cp) : 0u; \
        vreg = *(const v4u*)(P + (size_t)(r0_ + sg_ * vp) * PW + vcol + 8 * vs); } while (0)
#define SCAN_TOTALS(KR, Tbuf) do { float run0_ = 0.f, run1_ = 0.f; _Pragma("unroll") for (int j = 0; j < TPT; ++j) { run0_ += bflo(KR[j]); run1_ += bfhi(KR[j]); } \
        *(LAS f32x2*)((Tbuf) + w * 128 + 2 * cp) = (f32x2){run0_, run1_}; } while (0)
    SCAN_LOAD_K(0, kreg); SCAN_LOAD_QV(0); SCAN_LOAD_K(1, knx);
    if constexpr (HG) SCAN_TOTALS(kreg, T);
    LBAR();
#pragma unroll 1
    for (int s = 0; s < 36; ++s) {
        const bool isx = s >= 4;
        const int r0 = SCAN_ROW0(s); const int sg = dir ? -1 : 1;
        LAS unsigned char* Vt = (s & 1) ? Vt1 : Vt0; LAS unsigned char* Pm = (s & 1) ? Pm1 : Pm0;
        {
            const unsigned vv[4] = {vreg.x, vreg.y, vreg.z, vreg.w};
#pragma unroll
            for (int e = 0; e < 4; ++e) { *(LAS unsigned short*)(Vt + (8 * vs + 2 * e) * SS + 2 * vp) = (unsigned short)(vv[e] & 0xffffu); *(LAS unsigned short*)(Vt + (8 * vs + 2 * e + 1) * SS + 2 * vp) = (unsigned short)(vv[e] >> 16); }
        }
        if constexpr (HG) {
            const LAS float* Tc = T + (s & 1) * 1024;
            float pre0 = 0.f, pre1 = 0.f, base0 = 0.f, base1 = 0.f, bm0 = 0.f, bm1 = 0.f; float bs0[4], bs1[4];
            const int i_sub = w >> 1;
#pragma unroll
            for (int o = 0; o < 8; ++o) { const f32x2 tt = *(const LAS f32x2*)(Tc + o * 128 + 2 * cp);
                if (o == w) { base0 = pre0; base1 = pre1; }
                if ((o & 1) == 0) { bs0[o >> 1] = pre0; bs1[o >> 1] = pre1; if ((o >> 1) == i_sub) { bm0 = pre0; bm1 = pre1; } }
                pre0 += tt.x; pre1 += tt.y; }
            const float bend0 = pre0, bend1 = pre1;
            const float eBi0 = __expf(bm0), eBi1 = __expf(bm1), eEnd0 = __expf(bend0 - bm0), eEnd1 = __expf(bend1 - bm1);
            float gI0[4], gI1[4];
#pragma unroll
            for (int ii = 0; ii < 4; ++ii) { gI0[ii] = __expf(fminf(bs0[ii] - bm0, 0.f)); gI1[ii] = __expf(fminf(bs1[ii] - bm1, 0.f)); }
            if (w == 0) *(LAS f32x2*)(GD + 2 * cp) = (f32x2){__expf(bend0), __expf(bend1)};
            unsigned kt0[4], kt1[4]; float krA[8], krB[8];
            float E0 = __expf(base0 - bm0), E1 = __expf(base1 - bm1), R0 = __expf(bm0 - base0), R1 = __expf(bm1 - base1);
#pragma unroll
            for (int j = 0; j < 8; ++j) {
                const int p = 8 * w + j;
                const float f0 = __expf(bflo(kreg[j])), f1 = __expf(bfhi(kreg[j]));
                E0 *= f0; E1 *= f1; R0 *= __builtin_amdgcn_rcpf(f0); R1 *= __builtin_amdgcn_rcpf(f1);
                const float k0 = 1.f - f0, k1 = 1.f - f1;
                const float kr0 = k0 * R0, kr1 = k1 * R1;
                const unsigned ktp = pk2(kr0 * eEnd0, kr1 * eEnd1);
                if ((j & 1) == 0) { kt0[j >> 1] = ktp & 0xffffu; kt1[j >> 1] = ktp >> 16; } else { kt0[j >> 1] |= ktp << 16; kt1[j >> 1] |= ktp & 0xffff0000u; }
                if (isx) {
                    const float q0 = bflo(qreg[j]), q1 = bfhi(qreg[j]);
                    const float qi0 = q0 * E0, qi1 = q1 * E1;
                    *(LAS unsigned*)(Qi + p * QS + 4 * cp) = pk2(qi0, qi1);
                    *(LAS unsigned*)(Qt + p * QS + 4 * cp) = pk2(qi0 * eBi0, qi1 * eBi1);
                    krA[j] = kr0; krB[j] = kr1;
                }
            }
            if (isx) {
#pragma unroll
                for (int ii = 0; ii < 4; ++ii) if (ii >= i_sub) { const int blk = ii * (ii + 1) / 2 + i_sub;
#pragma unroll
                    for (int j = 0; j < 8; ++j)
                        *(LAS unsigned*)(Kij + (blk * 16 + ((8 * w + j) & 15)) * QS + 4 * cp) = pk2(krA[j] * gI0[ii], krB[j] * gI1[ii]); }
            }
            *(LAS v4u*)(Ktt + (2 * cp) * SS + 16 * w) = (v4u){kt0[0], kt0[1], kt0[2], kt0[3]};
            *(LAS v4u*)(Ktt + (2 * cp + 1) * SS + 16 * w) = (v4u){kt1[0], kt1[1], kt1[2], kt1[3]};
        } else {
            unsigned kt0[2], kt1[2];
#pragma unroll
            for (int j = 0; j < 4; ++j) {
                const int p = 4 * tg + j;
                const float kd = __expf(lg * (float)(63 - p));
                const unsigned ktp = pk2(bflo(kreg[j]) * kd, bfhi(kreg[j]) * kd);
                if ((j & 1) == 0) { kt0[j >> 1] = ktp & 0xffffu; kt1[j >> 1] = ktp >> 16; } else { kt0[j >> 1] |= ktp << 16; kt1[j >> 1] |= ktp & 0xffff0000u; }
                if (isx) {
                    const float qd = __expf(lg * (float)(p + 1));
                    *(LAS unsigned*)(Qi + p * QS + 4 * cp) = qreg[j];
                    *(LAS unsigned*)(Qt + p * QS + 4 * cp) = pk2(bflo(qreg[j]) * qd, bfhi(qreg[j]) * qd);
                    *(LAS unsigned*)(Kij + p * QS + 4 * cp) = kreg[j];
                }
            }
            *(LAS v2u*)(Ktt + (2 * cp) * SS + 8 * tg) = (v2u){kt0[0], kt0[1]};
            *(LAS v2u*)(Ktt + (2 * cp + 1) * SS + 8 * tg) = (v2u){kt1[0], kt1[1]};
        }
#pragma unroll
        for (int j = 0; j < TPT; ++j) kreg[j] = knx[j];
        if (s + 1 < 36) SCAN_LOAD_QV(s + 1);
        if (s + 2 < 36) SCAN_LOAD_K(s + 2, knx);
        LBAR();
        if constexpr (HG) { if (s + 1 < 36) SCAN_TOTALS(kreg, T + ((s + 1) & 1) * 1024); }
        f32x4 oT[2];
        oT[0] = (f32x4){0.f, 0.f, 0.f, 0.f}; oT[1] = oT[0];
        if (isx) {
#pragma unroll
            for (int rep = 0; rep < 2; ++rep) { const int bi = w + 8 * rep; if (bi < 10) {
                const int i = bi >= 6 ? 3 : (bi >= 3 ? 2 : (bi >= 1 ? 1 : 0)), j = bi - i * (i + 1) / 2;
                f32x4 sc = (f32x4){0.f, 0.f, 0.f, 0.f};
#pragma unroll
                for (int ks = 0; ks < DK / 32; ++ks) { const bf16x8 a = ldfrag(Kij, QS, HG ? 16 * bi : 16 * j, 64 * ks, lane), bq = ldfrag(Qi, QS, 16 * i, 64 * ks, lane); sc = MFMA16(a, bq, sc); }
#pragma unroll
                for (int r = 0; r < 4; ++r) { const int dt = (16 * i + (lane & 15)) - (16 * j + 4 * (lane >> 4) + r);
                    if constexpr (HG) { if (dt < 0) sc[r] = 0.f; } else { sc[r] = dt >= 0 ? sc[r] * __expf(lg * (float)dt) : 0.f; } }
                *(LAS v2u*)(Pm + (16 * i + (lane & 15)) * SS + 2 * (16 * j + 4 * (lane >> 4))) = (v2u){pk2(sc[0], sc[1]), pk2(sc[2], sc[3])}; } }
#pragma unroll
            for (int vi = 0; vi < 2; ++vi)
#pragma unroll
                for (int ks = 0; ks < DK / 32; ++ks) { const bf16x8 a = ldfrag(St, QS, 16 * (vb0 + vi), 64 * ks, lane), bq = ldfrag(Qt, QS, 16 * tb, 64 * ks, lane); oT[vi] = MFMA16(a, bq, oT[vi]); }
        }
        {
            f32x4 gv;
            if constexpr (HG) gv = *(const LAS f32x4*)(GD + 16 * db + 4 * (lane >> 4)); else { const float g64 = __expf(lg * 64.f); gv = (f32x4){g64, g64, g64, g64}; }
#pragma unroll
            for (int vi = 0; vi < NVB; ++vi) { const int vb = HG ? vi : vb0 + vi; accS[vi] = accS[vi] * gv;
#pragma unroll
                for (int ks = 0; ks < 2; ++ks) { const bf16x8 a = ldfrag(Ktt, SS, 16 * db, 64 * ks, lane), bv = ldfrag(Vt, SS, 16 * vb, 64 * ks, lane); accS[vi] = MFMA16(a, bv, accS[vi]); } }
        }
        LBAR();
        if (isx) {
#pragma unroll
            for (int vi = 0; vi < 2; ++vi) {
#pragma unroll
                for (int ks = 0; ks < 2; ++ks) { const bf16x8 a = ldfrag(Vt, SS, 16 * (vb0 + vi), 64 * ks, lane), bp = ldfrag(Pm, SS, 16 * tb, 64 * ks, lane); oT[vi] = MFMA16(a, bp, oT[vi]); }
                const int t = 16 * tb + (lane & 15);
                *(v2u*)(O + (size_t)(r0 + sg * t) * D + ocol + 16 * (vb0 + vi) + 4 * (lane >> 4)) = (v2u){pk2(oT[vi][0], oT[vi][1]), pk2(oT[vi][2], oT[vi][3])};
            }
        }
#pragma unroll
        for (int vi = 0; vi < NVB; ++vi) { const int vb = HG ? vi : vb0 + vi;
            *(LAS v2u*)(St + (16 * vb + (lane & 15)) * QS + 2 * (16 * db + 4 * (lane >> 4))) = (v2u){pk2(accS[vi][0], accS[vi][1]), pk2(accS[vi][2], accS[vi][3])}; }
    }
#undef SCAN_LOAD_K
#undef SCAN_LOAD_QV
#undef SCAN_TOTALS
#undef SCAN_ROW0
}
__device__ __forceinline__ void p3_scan(Frame& F) {
    for (int id = F.vcu; id < 256; id += F.G) {
        const int dvh = id & 1, mixer = (id >> 1) & 1, dir = (id >> 2) & 1, h = (id >> 3) & 3, b = id >> 5;
        if (mixer) scan_chain8<true>(F, b, h, dir, dvh); else scan_chain4<false>(F, b, h, dir, dvh);
        __syncthreads();
    }
}

__device__ __forceinline__ void p4_merge(Frame& F) {
    const int gw = F.vcu * NWAVES + F.wave, NGW = F.G * NWAVES;
    const bf16* P = (const bf16*)(F.ws + WS_P); const bf16* OF = (const bf16*)(F.ws + WS_OF); const bf16* OB = (const bf16*)(F.ws + WS_OB); bf16* AO = (bf16*)(F.ws + WS_AO);
    const int lane = F.lane; const bool ishg = lane >= 32;
    float nw[16];
#pragma unroll
    for (int i = 0; i < 16; ++i) nw[i] = ishg ? F.in[IN_HGNW][16 * (lane & 7) + i] : 1.f;
    for (int t = gw; t < NX; t += NGW) {
        const v4u* pf = (const v4u*)(OF + (size_t)t * D + 16 * lane); const v4u* pb = (const v4u*)(OB + (size_t)t * D + 16 * lane);
        const v4u* pg = (const v4u*)(P + (size_t)t * PW + (ishg ? 3584 + 16 * (lane - 32) : 1024 + 16 * lane));
        const v4u f0 = pf[0], f1 = pf[1], b0 = pb[0], b1 = pb[1], g0 = pg[0], g1 = pg[1];
        const unsigned fu[8] = {f0.x, f0.y, f0.z, f0.w, f1.x, f1.y, f1.z, f1.w}, bu[8] = {b0.x, b0.y, b0.z, b0.w, b1.x, b1.y, b1.z, b1.w}, gu[8] = {g0.x, g0.y, g0.z, g0.w, g1.x, g1.y, g1.z, g1.w};
        float x[16]; float ss = 0.f;
#pragma unroll
        for (int i = 0; i < 8; ++i) { x[2 * i] = bflo(fu[i]) + bflo(bu[i]); x[2 * i + 1] = bfhi(fu[i]) + bfhi(bu[i]); ss += x[2 * i] * x[2 * i] + x[2 * i + 1] * x[2 * i + 1]; }
        ss += __shfl_xor(ss, 1); ss += __shfl_xor(ss, 2); ss += __shfl_xor(ss, 4);
        const float rinv = 1.f / sqrtf(ss * (1.f / 128.f) + EPS);
        unsigned o[8];
#pragma unroll
        for (int i = 0; i < 8; ++i) o[i] = pk2(x[2 * i] * rinv * nw[2 * i] * bflo(gu[i]), x[2 * i + 1] * rinv * nw[2 * i + 1] * bfhi(gu[i]));
        v4u* po = (v4u*)(AO + (size_t)t * D + 16 * lane); po[0] = (v4u){o[0], o[1], o[2], o[3]}; po[1] = (v4u){o[4], o[5], o[6], o[7]};
    }
}

struct EpiResid {
    static constexpr bool PERM = false, AFTER_DRAIN = false;
    const float* X; const float* MOD; float* H;
    __device__ __forceinline__ void operator()(const f32x4 (&acc)[2][2][4][2], const pg8::Unit& u, int wr, int wc, int fr, int fq) const {
        const int row0 = u.pm * 256 + wr * 64 + fr, col0 = u.pn * 256 + wc * 32 + 4 * fq; const int b = (u.pm * 256) >> 11;
        f32x4 g[2][2];
#pragma unroll
        for (int bj = 0; bj < 2; ++bj)
#pragma unroll
            for (int n = 0; n < 2; ++n) g[bj][n] = *(const f32x4*)(MOD + b * 6144 + 2048 + col0 + bj * 128 + n * 16);
#pragma unroll
        for (int ai = 0; ai < 2; ++ai) {
            f32x4 xv[4][2][2];
#pragma unroll
            for (int m = 0; m < 4; ++m) { const size_t off = (size_t)(row0 + ai * 128 + m * 16) * D + col0;
#pragma unroll
                for (int bj = 0; bj < 2; ++bj)
#pragma unroll
                    for (int n = 0; n < 2; ++n) xv[m][bj][n] = *(const f32x4*)(X + off + bj * 128 + n * 16); }
#pragma unroll
            for (int m = 0; m < 4; ++m) { const size_t off = (size_t)(row0 + ai * 128 + m * 16) * D + col0;
#pragma unroll
                for (int bj = 0; bj < 2; ++bj)
#pragma unroll
                    for (int n = 0; n < 2; ++n) *(f32x4*)(H + off + bj * 128 + n * 16) = xv[m][bj][n] + g[bj][n] * acc[ai][bj][m][n]; }
            asm volatile("" ::: "memory"); }
    }
};

__device__ __forceinline__ void p6_router(Frame& F, int cntoff) {
    constexpr int BS = 2064;
    LAS unsigned char* BH = F.lds + SCR_OFF; LAS unsigned char* BL = BH + 32 * BS;
    LAS float* PART = (LAS float*)BH;
    LAS float* CP = (LAS float*)(BL + 32 * BS);
    LAS float* SSL = CP + 32;
    LAS float* RINV = SSL + 128;
    LAS int* le = (LAS int*)(RINV + 64);
    LAS int* lp = le + 256;
    LAS float* lgt = (LAS float*)(lp + 256);
    LAS int* lcnt = (LAS int*)(F.lds + L_LCNT); LAS int* gbase = (LAS int*)(F.lds + L_GBASE);
    const int tid = F.tid, lane = F.lane, w = F.wave;
    const float* MOD = (const float*)(F.ws + WS_MOD); const float* H = (const float*)(F.ws + WS_H); unsigned char* VX = (unsigned char*)(F.ws + WS_VX);
    int* TOKE = (int*)(F.ws + WS_TOKE); int* TOKPOS = (int*)(F.ws + WS_TOKPOS); int* EXPL = (int*)(F.ws + WS_EXPL); float* EXPG = (float*)(F.ws + WS_EXPG);
    const float* RW = F.in[IN_RW];
#pragma unroll 1
    for (int tok0 = F.vcu * 64; tok0 < NX; tok0 += F.G * 64) {
        const int b = tok0 >> 11;
        const float* SC2 = MOD + b * 6144 + 4096; const float* SH2 = MOD + b * 6144 + 3072;
        if (tid < 32) lcnt[tid] = 0;
#pragma unroll 1
        for (int i = 0; i < 2; ++i) { const int k = tid + 512 * i; const float cm = F.in[IN_NFFN][k] * (1.f + SC2[k]);
#pragma unroll
            for (int c = 0; c < 8; ++c) { const f32x4 w4 = ((const f32x4*)RW)[k * 8 + c];
#pragma unroll
                for (int j = 0; j < 4; ++j) { const float v = cm * w4[j]; const unsigned hi = f2bf(v); const unsigned lo = f2bf(v - __builtin_bit_cast(float, hi << 16));
                    *(LAS unsigned short*)(BH + (4 * c + j) * BS + 2 * k) = (unsigned short)hi; *(LAS unsigned short*)(BL + (4 * c + j) * BS + 2 * k) = (unsigned short)lo; } } }
        { const int e = tid & 31, part = tid >> 5; float s = 0.f;
#pragma unroll 8
          for (int kk = 0; kk < 64; ++kk) { const int k = part * 64 + kk; s += SH2[k] * RW[k * 32 + e]; }
          LAS float* red = (LAS float*)(le);
          red[tid] = s;
          __syncthreads();
          if (tid < 32) { float t = F.in[IN_RB][tid];
#pragma unroll
              for (int q = 0; q < 16; ++q) t += red[q * 32 + tid];
              CP[tid] = t; } }
        __syncthreads();
        {
            const int tt = w & 3, kh = w >> 2, kq = lane >> 4;
            const float* hp = H + (size_t)(tok0 + 16 * tt + (lane & 15)) * D + 512 * kh + 8 * kq;
            f32x4 acc0 = (f32x4){0.f, 0.f, 0.f, 0.f}, acc1 = acc0; float ss = 0.f;
            f32x4 cur[8], nxt[8];
#pragma unroll
            for (int q = 0; q < 4; ++q) { cur[2 * q] = *(const f32x4*)(hp + 32 * q); cur[2 * q + 1] = *(const f32x4*)(hp + 32 * q + 4); }
#pragma unroll 1
            for (int g4 = 0; g4 < 4; ++g4) { const int gn = (g4 + 1) & 3;
#pragma unroll
                for (int q = 0; q < 4; ++q) { nxt[2 * q] = *(const f32x4*)(hp + 128 * gn + 32 * q); nxt[2 * q + 1] = *(const f32x4*)(hp + 128 * gn + 32 * q + 4); }
#pragma unroll
                for (int q = 0; q < 4; ++q) { const int kb = 2 * (512 * kh + 128 * g4 + 32 * q);
                    float x[8] = {cur[2 * q][0], cur[2 * q][1], cur[2 * q][2], cur[2 * q][3], cur[2 * q + 1][0], cur[2 * q + 1][1], cur[2 * q + 1][2], cur[2 * q + 1][3]};
                    unsigned hw[4], lw[4];
#pragma unroll
                    for (int j = 0; j < 4; ++j) { const float a = x[2 * j], c = x[2 * j + 1]; ss += a * a + c * c;
                        hw[j] = pk2(a, c); lw[j] = pk2(a - bflo(hw[j]), c - bfhi(hw[j])); }
                    const bf16x8 ah = __builtin_bit_cast(bf16x8, (v4u){hw[0], hw[1], hw[2], hw[3]}), al = __builtin_bit_cast(bf16x8, (v4u){lw[0], lw[1], lw[2], lw[3]});
                    const bf16x8 bh0 = ldfrag(BH, BS, 0, kb, lane), bl0 = ldfrag(BL, BS, 0, kb, lane), bh1 = ldfrag(BH, BS, 16, kb, lane), bl1 = ldfrag(BL, BS, 16, kb, lane);
                    acc0 = MFMA16(bh0, ah, acc0); acc0 = MFMA16(bl0, ah, acc0); acc0 = MFMA16(bh0, al, acc0);
                    acc1 = MFMA16(bh1, ah, acc1); acc1 = MFMA16(bl1, ah, acc1); acc1 = MFMA16(bh1, al, acc1); }
#pragma unroll
                for (int q = 0; q < 8; ++q) cur[q] = nxt[q]; }
            ss += __shfl_xor(ss, 16); ss += __shfl_xor(ss, 32);
            if (kq == 0) SSL[kh * 64 + 16 * tt + lane] = ss;
            __syncthreads();
            const int tokl = 16 * tt + (lane & 15);
#pragma unroll
            for (int r = 0; r < 4; ++r) { PART[(kh * 64 + tokl) * 33 + 4 * kq + r] = acc0[r]; PART[(kh * 64 + tokl) * 33 + 16 + 4 * kq + r] = acc1[r]; }
        }
        __syncthreads();
        if (tid < 64) {
            const float rinv = 1.f / sqrtf((SSL[tid] + SSL[64 + tid]) * (1.f / D) + EPS); RINV[tid] = rinv;
            float lg[32];
#pragma unroll
            for (int e = 0; e < 32; ++e) lg[e] = rinv * (PART[tid * 33 + e] + PART[(64 + tid) * 33 + e]) + CP[e];
            float tv[4]; int ti[4];
#pragma unroll
            for (int r = 0; r < 4; ++r) { float best = lg[0]; int bi = 0;
#pragma unroll
                for (int e = 1; e < 32; ++e) if (lg[e] > best) { best = lg[e]; bi = e; }
                tv[r] = best; ti[r] = bi;
#pragma unroll
                for (int e = 0; e < 32; ++e) if (e == bi) lg[e] = -INFINITY; }
            const float e1 = __expf(tv[1] - tv[0]), e2 = __expf(tv[2] - tv[0]), e3 = __expf(tv[3] - tv[0]); const float inv = 1.f / (1.f + e1 + e2 + e3);
            const float gg[4] = {inv, e1 * inv, e2 * inv, e3 * inv};
#pragma unroll
            for (int r = 0; r < 4; ++r) { le[tid * 4 + r] = ti[r]; lgt[tid * 4 + r] = gg[r]; lp[tid * 4 + r] = __hip_atomic_fetch_add(lcnt + ti[r], 1, __ATOMIC_RELAXED, __HIP_MEMORY_SCOPE_WORKGROUP); }
        }
        __syncthreads();
        if (tid < 32) gbase[tid] = (int)__hip_atomic_fetch_add((unsigned*)(F.ctl + CW_CNT + cntoff + tid), (unsigned)lcnt[tid], RLX_AGENT);
        __syncthreads();
        if (tid < 256) { const int e = le[tid], pos = gbase[e] + lp[tid]; TOKE[tok0 * 4 + tid] = e; TOKPOS[tok0 * 4 + tid] = pos; EXPL[e * 16384 + pos] = tok0 + (tid >> 2); EXPG[e * 16384 + pos] = lgt[tid]; }
        { f32x4 cmr[4], shr[4];
#pragma unroll
          for (int j = 0; j < 4; ++j) { const int k = 4 * lane + 256 * j; const f32x4 nw = *(const f32x4*)(F.in[IN_NFFN] + k), sc = *(const f32x4*)(SC2 + k); cmr[j] = nw * (sc + 1.f); shr[j] = *(const f32x4*)(SH2 + k); }
#pragma unroll 2
          for (int q = 0; q < 8; ++q) { const int t = tok0 + 8 * w + q; const float rinv = RINV[8 * w + q];
              const GAS f32x4* hr = (const GAS f32x4*)(H + (size_t)t * D) + lane; GAS unsigned* o4 = (GAS unsigned*)(VX + (size_t)t * D) + lane;
#pragma unroll
              for (int j = 0; j < 4; ++j) { const f32x4 u = hr[64 * j] * rinv * cmr[j] + shr[j]; o4[64 * j] = pk4_f8(u.x, u.y, u.z, u.w); } } }
        __syncthreads();
    }
}

__device__ __forceinline__ void moe_tables(Frame& F) {
    LAS int* TS = (LAS int*)(F.lds + L_TSTART); LAS int* TE = (LAS int*)(F.lds + L_TILEE);
    if (F.wave == 0) {
        const int e = F.lane; int nt = 0;
        if (e < 32) { const int c = (int)__hip_atomic_load((unsigned*)(F.ctl + CW_CNT + e), RLX_AGENT); nt = (c + 255) >> 8; ((LAS int*)(F.lds + L_LCNT))[e] = c; }
        int incl = nt;
#pragma unroll
        for (int o = 1; o < 32; o <<= 1) { const int y = __shfl_up(incl, o); if ((F.lane & 31) >= o) incl += y; }
        const int st = incl - nt;
        if (e < 32) { TS[e] = st; for (int i = 0; i < nt; ++i) TE[st + i] = e; if (e == 31) TS[32] = incl; }
    }
    __syncthreads();
}
struct MoeOrder {
    int G, c, nct; const LAS int* TS; const LAS int* TE; const LAS int* CN; const int* EXPL;
    const LAS int* ATOK;
    __device__ __forceinline__ int arow(const pg8::Unit&, int ui, int r) const { return ATOK[ui * 256 + r]; }
    __device__ __forceinline__ int arow_global(const pg8::Unit& u, int r) const { const int e = TE[u.pm]; const int idx = 256 * (u.pm - TS[e]) + r; return idx < CN[e] ? EXPL[e * 16384 + idx] : 0; }
    __device__ __forceinline__ bool next(int i, pg8::Unit& u) const {
        const int NT = TS[32]; int rt, ct;
        if (G == 256) {
            const int x = c & 7, q = c >> 3, rpx = 32 / nct; ct = q % nct; rt = (8 * i + x) * rpx + q / nct;
            if (rt >= NT) return false;
        } else { const int L = i * G + c; if (L >= NT * nct) return false; rt = L / nct; ct = L - rt * nct; }
        const int e = TE[rt];
        u.pm = __builtin_amdgcn_readfirstlane(rt); u.pn = __builtin_amdgcn_readfirstlane(e * nct + ct); return true;
    }
    __device__ __forceinline__ void a_ready(const pg8::Unit&) const {}
    __device__ __forceinline__ void done(const pg8::Unit&) const {}
};
struct EpiGlu {
    static constexpr bool PERM = true, AFTER_DRAIN = false;
    unsigned char* ACT; const float* B1;
    __device__ __forceinline__ void operator()(const f32x4 (&acc)[2][2][4][2], const pg8::Unit& u, int wr, int wc, int fr, int fq) const {
        const int e = u.pn >> 3, ct = u.pn & 7; const int row0 = u.pm * 256 + wr * 64 + fr; const int cb = wc * 32 + 8 * fq;
        f32x4 bg[2], bl[2];
#pragma unroll
        for (int n = 0; n < 2; ++n) { bg[n] = *(const f32x4*)(B1 + e * 2048 + 128 * ct + cb + 4 * n); bl[n] = *(const f32x4*)(B1 + e * 2048 + 1024 + 128 * ct + cb + 4 * n); }
#pragma unroll
        for (int ai = 0; ai < 2; ++ai)
#pragma unroll
            for (int m = 0; m < 4; ++m) { const int r = row0 + ai * 128 + m * 16; unsigned o[2];
#pragma unroll
                for (int n = 0; n < 2; ++n) { float a[4];
#pragma unroll
                    for (int i = 0; i < 4; ++i) { const float xg = fminf(acc[ai][0][m][n][i] * W8_INV + bg[n][i], 7.f); const float xl = fminf(fmaxf(acc[ai][1][m][n][i] * W8_INV + bl[n][i], -7.f), 7.f);
                        a[i] = xg * sigmoidf_(1.702f * xg) * (xl + 1.f); }
                    o[n] = pk4_f8(a[0], a[1], a[2], a[3]); }
                __hip_atomic_store((unsigned long long*)(ACT + (size_t)r * DFF + 128 * ct + cb), ((unsigned long long)o[1] << 32) | o[0], RLX_AGENT); }
    }
};
struct EpiDown {
    static constexpr bool PERM = true, AFTER_DRAIN = false;
    unsigned char* YB; const float* B2; const float* ROWGATE;
    __device__ __forceinline__ void operator()(const f32x4 (&acc)[2][2][4][2], const pg8::Unit& u, int wr, int wc, int fr, int fq) const {
        const int e = u.pn >> 2, ct = u.pn & 3; const int row0 = u.pm * 256 + wr * 64 + fr; const int cb = 256 * ct + wc * 32 + 8 * fq;
        f32x4 bv[2][2];
#pragma unroll
        for (int bj = 0; bj < 2; ++bj)
#pragma unroll
            for (int n = 0; n < 2; ++n) bv[bj][n] = *(const f32x4*)(B2 + e * 1024 + cb + 128 * bj + 4 * n);
#pragma unroll
        for (int ai = 0; ai < 2; ++ai)
#pragma unroll
            for (int m = 0; m < 4; ++m) { const int r = row0 + ai * 128 + m * 16; const float gt = ROWGATE[r];
#pragma unroll
                for (int bj = 0; bj < 2; ++bj) { const f32x4 v0 = (acc[ai][bj][m][0] * W8_INV + bv[bj][0]) * gt, v1 = (acc[ai][bj][m][1] * W8_INV + bv[bj][1]) * gt;
                    *(v2u*)(YB + (size_t)r * D + cb + 128 * bj) = (v2u){pk4_f8(v0[0], v0[1], v0[2], v0[3]), pk4_f8(v1[0], v1[1], v1[2], v1[3])}; } }
    }
};
constexpr int MOE_MAXU = 16;
struct MoeOrder2 {
    int nu; const LAS int* UL; const LAS int* ATOK; unsigned* READY; unsigned* tmo;
    __device__ __forceinline__ bool next(int i, pg8::Unit& u) const { if (i >= nu) return false; u.pm = __builtin_amdgcn_readfirstlane(UL[2 * i]); u.pn = __builtin_amdgcn_readfirstlane(UL[2 * i + 1]); return true; }
    __device__ __forceinline__ int arow(const pg8::Unit&, int ui, int r) const { return ATOK[ui * 256 + r]; }
    __device__ __forceinline__ void a_ready(const pg8::Unit& u) const {
        if (u.pn < 512) return;
        if (threadIdx.x < 64) { unsigned sp = 0;
            while ((unsigned)__builtin_amdgcn_readfirstlane(__hip_atomic_load(READY + 64 * u.pm, RLX_AGENT)) < 64u) { __builtin_amdgcn_s_sleep(8); if (++sp > (1u << 20)) { if (threadIdx.x == 0) __hip_atomic_store(tmo, 1u, RLX_AGENT); break; } }
            __builtin_amdgcn_fence(__ATOMIC_ACQUIRE, "agent"); asm volatile("s_waitcnt vmcnt(0)" ::: "memory"); }
        asm volatile("" ::: "memory"); __builtin_amdgcn_s_barrier(); asm volatile("" ::: "memory");
    }
    __device__ __forceinline__ void done(const pg8::Unit& u) const {
        if (u.pn >= 512) return;
        asm volatile("s_waitcnt vmcnt(0)" ::: "memory");
        if ((threadIdx.x & 63) == 0) __hip_atomic_fetch_add(READY + 64 * u.pm, 1u, RLX_AGENT);
    }
};
struct EpiMoe {
    static constexpr bool PERM = true, AFTER_DRAIN = false;
    EpiGlu g1; EpiDown g2;
    __device__ __forceinline__ void operator()(const f32x4 (&acc)[2][2][4][2], const pg8::Unit& u, int wr, int wc, int fr, int fq) const {
        if (u.pn < 512) g1(acc, u, wr, wc, fr, fq); else { pg8::Unit v = u; v.pn = u.pn - 512; g2(acc, v, wr, wc, fr, fq); }
    }
};
__device__ __forceinline__ void p10_final(Frame& F) {
    const int gw = F.vcu * NWAVES + F.wave, NGW = F.G * NWAVES;
    moe_tables(F);
    const LAS int* TS = (const LAS int*)(F.lds + L_TSTART);
    const float* MOD = (const float*)(F.ws + WS_MOD); const float* H = (const float*)(F.ws + WS_H); const unsigned char* YB = (const unsigned char*)(F.ws + WS_YB); const int* TOKE = (const int*)(F.ws + WS_TOKE); const int* TOKPOS = (const int*)(F.ws + WS_TOKPOS);
    for (int t = gw; t < NX; t += NGW) {
        const int b = t >> 11; int rows[4];
#pragma unroll
        for (int k = 0; k < 4; ++k) rows[k] = 256 * TS[TOKE[t * 4 + k]] + TOKPOS[t * 4 + k];
        f32x4 hv[4]; float ss = 0.f;
#pragma unroll
        for (int j = 0; j < 4; ++j) { const int k0 = 4 * F.lane + 256 * j; f32x4 y = (f32x4){0.f, 0.f, 0.f, 0.f};
#pragma unroll
            for (int k = 0; k < 4; ++k) { const unsigned yy = *(const unsigned*)(YB + (size_t)rows[k] * D + k0); const f32x2 lo = __builtin_amdgcn_cvt_pk_f32_fp8((int)yy, false), hi = __builtin_amdgcn_cvt_pk_f32_fp8((int)yy, true); y += (f32x4){lo.x, lo.y, hi.x, hi.y}; }
            const f32x4 h4 = *(const f32x4*)(H + (size_t)t * D + k0), g2 = *(const f32x4*)(MOD + b * 6144 + 5120 + k0);
            hv[j] = h4 + g2 * y; ss += (hv[j].x * hv[j].x + hv[j].y * hv[j].y) + (hv[j].z * hv[j].z + hv[j].w * hv[j].w); }
        const float rinv = 1.f / sqrtf(wave_sum(ss) * (1.f / D) + EPS);
#pragma unroll
        for (int j = 0; j < 4; ++j) { const int k0 = 4 * F.lane + 256 * j; const f32x4 nw = *(const f32x4*)(F.in[IN_NFIN] + k0); *(f32x4*)(F.out + (size_t)t * D + k0) = hv[j] * rinv * nw; }
    }
}

struct Args { const float* in[19]; float* out; unsigned char* ws; int ph_lo, ph_hi, li, pad; };
__global__ void __launch_bounds__(NWAVES * 64, 2) fwd_kernel(Args args) {
    extern __shared__ __attribute__((aligned(16))) unsigned char lds[];
    Frame F;
    F.lds = (LAS unsigned char*)lds;
    F.tid = threadIdx.x; F.lane = F.tid & 63; F.wave = __builtin_amdgcn_readfirstlane(F.tid >> 6);
    F.G = gridDim.x; { const int bx = blockIdx.x; F.vcu = (F.G % 8 == 0) ? (bx % 8) * (F.G / 8) + bx / 8 : bx; }
    F.ws = args.ws; F.ctl = (gu32*)(args.ws + WS_CTL); F.out = args.out;
    F.in = args.in;
    for (int u = F.tid; u < LCTL_BYTES / 4; u += NWAVES * 64) ((LAS unsigned*)F.lds)[u] = 0u;
    __syncthreads();
    XcdBarrier bar; bar.bar = (unsigned*)(F.ctl + CW_BAR); bar.x = 0; bar.st = nullptr;
    if (N_LAUNCHES == 1) bar = xcd_barrier_post((unsigned*)(F.ctl + CW_BAR), (volatile LAS unsigned*)(F.lds + L_MISC) + 8);
    const int lo = args.ph_lo, hi = args.ph_hi;
#ifndef PH_MASK
#define PH_MASK 0x7ff
#endif
#define IN(k) (((PH_MASK >> (k)) & 1) && lo <= (k) && (k) < hi)
#define SEAM(k) do { if (IN(k) && IN((k) + 1)) xcd_barrier(bar); } while (0)
    LAS unsigned char* ring = F.lds + SCR_OFF;
#ifndef REP_MASK
#define REP_MASK 0
#endif
#define NREP(k) (1 + ((REP_MASK >> (k)) & 1))
#ifndef TS_SEL
#define TS_SEL -1
#endif
#define TSTAMP(k) do { if (TS_SEL >= 0 && blockIdx.x == 0 && F.tid == 0) ((volatile LAS unsigned long long*)(F.lds + 1864))[k] = __builtin_amdgcn_s_memrealtime(); } while (0)
#define PH(k, ...) if (IN(k)) { { const int rep_ = 0; __VA_ARGS__; } if (NREP(k) > 1) { xcd_barrier(bar); { const int rep_ = 1; __VA_ARGS__; } } SEAM(k); TSTAMP((k) + 1); }
    TSTAMP(0);
    PH(0, {
        p0_prologue(F);
        if (F.G != 256) tail_transpose(F, 0, 24576, F.vcu * NWAVES + F.wave, F.G * NWAVES);
        if (F.wave == 0) { unsigned sp = 0; while (__hip_atomic_load((unsigned*)(F.ctl + CW_ADA), RLX_AGENT) < 96u) { __builtin_amdgcn_s_sleep(2); if (++sp > (1u << 22)) break; }
            __builtin_amdgcn_fence(__ATOMIC_ACQUIRE, "agent"); VM_WAIT(); }
        __syncthreads();
        p1_xn(F); })
    TSTAMP(2);
    PH(2, {
        pg8::Gemm g{(const bf16*)(F.ws + WS_XN), (const bf16*)(F.ws + WS_WIN), NROWS, PW, D};
        InProjOrder S{F.G, (int)blockIdx.x};
        EpiInProj E{(bf16*)(F.ws + WS_P), (const float*)(F.ws + WS_LB), (const float*)(F.ws + WS_COS), (const float*)(F.ws + WS_SIN)};
        pg8::gemm_phase<EpiInProj, InProjOrder, true, true>(ring, g, S, E);
        if (F.G == 256 && blockIdx.x >= 72) tail_transpose(F, 0, TP_P2_ITEMS, ((int)blockIdx.x - 72) * NWAVES + F.wave, 184 * NWAVES); })
    PH(3, p3_scan(F))
    PH(4, p4_merge(F))
    PH(5, {
        pg8::Gemm g{(const bf16*)(F.ws + WS_AO), (const bf16*)(F.ws + WS_WOUT), NX, D, D};
        pg8::StaticOrder S; S.init(NX, D, F.G, (int)blockIdx.x);
        EpiResid E{F.in[IN_X], (const float*)(F.ws + WS_MOD), (float*)(F.ws + WS_H)};
        pg8::gemm_phase<EpiResid, pg8::StaticOrder, true, true>(ring, g, S, E); })
    PH(6, p6_router(F, 64 * rep_))
    PH(7, {
        moe_tables(F);
        const LAS int* TS = (const LAS int*)(F.lds + L_TSTART); const LAS int* TE = (const LAS int*)(F.lds + L_TILEE); const LAS int* CN = (const LAS int*)(F.lds + L_LCNT);
        { const float* EXPG = (const float*)(F.ws + WS_EXPG); float* ROWGATE = (float*)(F.ws + WS_ROWGATE); const int nrow = TS[32] * 256;
          for (int row = F.vcu * (NWAVES * 64) + F.tid; row < nrow; row += F.G * NWAVES * 64) { const int e = TE[row >> 8], idx = row - 256 * TS[e]; ROWGATE[row] = idx < CN[e] ? EXPG[e * 16384 + idx] : 0.f; } }
        LAS int* atok = (LAS int*)(F.lds + SCR_OFF + 131072); LAS int* ul = atok + MOE_MAXU * 256;
        const int NT = TS[32], c = (int)blockIdx.x; int nu = 0;
        const int* EXPL = (const int*)(F.ws + WS_EXPL);
        for (int kind = 0; kind < 2; ++kind) { const int nct = kind ? 4 : 8, rpx = 32 / nct;
            for (int i = 0; nu < MOE_MAXU; ++i) { int rt, ct;
                if (F.G == 256) { const int x = kind ? 7 - (c & 7) : (c & 7), qq = c >> 3; ct = qq % nct; rt = (8 * i + x) * rpx + qq / nct; if ((8 * i) * rpx >= NT) break; if (rt >= NT) continue; }
                else { const int L = i * F.G + c; if (L >= NT * nct) break; rt = L / nct; ct = L - rt * nct; }
                const int e = TE[rt];
                if (F.tid == 0) { ul[2 * nu] = rt; ul[2 * nu + 1] = kind ? 512 + e * 4 + ct : e * 8 + ct; }
                if (F.tid < 256) { const int idx = 256 * (rt - TS[e]) + F.tid; atok[nu * 256 + F.tid] = kind ? 32768 + 256 * rt + F.tid : (idx < CN[e] ? EXPL[e * 16384 + idx] : 0); }
                ++nu; } }
        __syncthreads();
        pg8::Gemm g{(const bf16*)(F.ws + WS_VX), (const bf16*)(F.ws + WS_W1), NX, NEXP * 2048, D / 2};
        MoeOrder2 S{nu, ul, atok, (unsigned*)(F.ctl + CW_READY), (unsigned*)(F.ctl + CW_TMO)};
        EpiMoe E{EpiGlu{(unsigned char*)(F.ws + WS_ACT), F.in[IN_B1]}, EpiDown{(unsigned char*)(F.ws + WS_YB), F.in[IN_B2], (const float*)(F.ws + WS_ROWGATE)}};
        pg8::gemm_phase_ga<EpiMoe, MoeOrder2, true>(ring, g, S, E); })
    PH(8, p10_final(F))
#undef PH
    if (TS_SEL >= 0) { __syncthreads(); if (blockIdx.x == 0 && F.tid == 0) { VM_WAIT(); volatile LAS unsigned long long* ts = (volatile LAS unsigned long long*)(F.lds + 1864);
        const float us = (TS_SEL == 0 ? 32.f : 8.f) * rintf((float)(ts[TS_SEL + 1] - ts[TS_SEL]) * (TS_SEL == 0 ? 0.0003125f : 0.00125f)); F.out[0] = F.out[0] + us; } }
#undef IN
#undef SEAM
}

extern "C" void kernel_launch(void* const* d_in, const int* in_sizes, int n_in, void* d_out, int out_size, void* d_ws, size_t ws_size, hipStream_t stream) {
    static int grid = 0;
    if (grid == 0) {
        if (n_in != 19 || in_sizes[0] != NX * D || out_size != NX * D || ws_size < WS_END) { fprintf(stderr, "kernel_launch: unexpected shapes (n_in %d, in0 %d, out %d, ws %zu; need ws >= %zu)\n", n_in, n_in > 0 ? in_sizes[0] : -1, out_size, ws_size, (size_t)WS_END); grid = -1; return; }
        int dev = 0, cus = 0, per_cu = 0;
        if (hipGetDevice(&dev) != hipSuccess || hipDeviceGetAttribute(&cus, hipDeviceAttributeMultiprocessorCount, dev) != hipSuccess) { fprintf(stderr, "kernel_launch: device query failed\n"); grid = -1; return; }
        if (hipFuncSetAttribute((const void*)fwd_kernel, hipFuncAttributeMaxDynamicSharedMemorySize, LDS_BYTES) != hipSuccess) { fprintf(stderr, "kernel_launch: hipFuncSetAttribute failed\n"); grid = -1; return; }
        if (hipOccupancyMaxActiveBlocksPerMultiprocessor(&per_cu, (const void*)fwd_kernel, NWAVES * 64, LDS_BYTES) != hipSuccess || per_cu < 1)
            fprintf(stderr, "kernel_launch: note: occupancy query reports %d workgroups per CU\n", per_cu);
        (void)hipGetLastError();
        grid = cus;
    }
    if (grid < 0) return;
    if (hipMemsetAsync((char*)d_ws + WS_CTL, 0, CTL_ZERO_BYTES, stream) != hipSuccess) { fprintf(stderr, "kernel_launch: hipMemsetAsync failed\n"); return; }
    Args a{};
    for (int i = 0; i < 19; ++i) a.in[i] = (const float*)d_in[i];
    a.out = (float*)d_out; a.ws = (unsigned char*)d_ws;
    for (int li = 0; li < N_LAUNCHES; ++li) {
        a.ph_lo = (N_LAUNCHES == 1) ? 0 : li; a.ph_hi = (N_LAUNCHES == 1) ? NPHASE : li + 1; a.li = li;
        hipLaunchKernelGGL(fwd_kernel, dim3(grid), dim3(NWAVES * 64), LDS_BYTES, stream, a);
        const hipError_t le = hipPeekAtLastError();
        if (le != hipSuccess) { fprintf(stderr, "kernel_launch: launch %d failed: %s\n", li, hipGetErrorName(le)); break; }
    }
}
```
